# Optimizing an MI355X kernel written in HIP

```python
import jax, jax.numpy as jnp
from jax import lax
import numpy as np

D_MODEL = 1024
BATCH = 8
SEQ = 2048
DEPTH = 1
DEC_BATCH = 128
DEC_SEQ = 4
PAST_LEN = 16384
PAGE_SIZE = 128

D_CONV = D_MODEL
CONV_A_W = 3
N_HEADS = 8
HEAD_K = 128
HEAD_V = 128
KEY_W = N_HEADS * HEAD_K
VAL_W = N_HEADS * HEAD_V
QKV_W = 2 * KEY_W + VAL_W
CONV_B_W = 4
CHUNK = 64
EPS = 1e-6
SPLITS = (D_CONV, D_CONV, D_CONV, D_CONV, QKV_W, VAL_W, N_HEADS, N_HEADS, D_MODEL, D_MODEL)
N_IN = sum(SPLITS)

kernel_name = 'hybrid_shortconv_gdn_parallel_step'


def _split_points():
    pts, s = [], 0
    for w in SPLITS[:-1]:
        s += w
        pts.append(s)
    return pts


def _rmsnorm(x, w):
    xf = x.astype(jnp.float32)
    y = xf * lax.rsqrt(jnp.mean(xf * xf, axis=-1, keepdims=True) + EPS) * w.astype(jnp.float32)
    return y.astype(x.dtype)


def _l2norm(x):
    return x * lax.rsqrt(jnp.sum(x * x, axis=-1, keepdims=True) + EPS)


def _causal_conv(u, past, w):
    W = w.shape[0]
    T = u.shape[1]
    ext = jnp.concatenate([past.astype(u.dtype), u], axis=1)
    out = ext[:, 0:T] * w[0]
    for j in range(1, W):
        out = out + ext[:, j:j + T] * w[j]
    return out, ext[:, ext.shape[1] - (W - 1):]


def _gated_delta(q, k, v, beta, g, S0):
    Bn, T, H, K = q.shape
    V = v.shape[-1]
    C = min(CHUNK, T)
    pad = (-T) % C
    if pad:
        pw = ((0, 0), (0, pad), (0, 0), (0, 0))
        q, k, v = jnp.pad(q, pw), jnp.pad(k, pw), jnp.pad(v, pw)
        beta = jnp.pad(beta, pw[:3])
        g = jnp.pad(g, pw[:3])
    Tp = T + pad
    N = Tp // C
    def chunks(a):
        a = a.reshape((Bn, N, C) + a.shape[2:])
        return jnp.moveaxis(a, 3, 1)
    q, k, v, beta, g = chunks(q), chunks(k), chunks(v), chunks(beta), chunks(g)
    gc = jnp.cumsum(g, axis=-1)
    idx = jnp.arange(C)
    causal = idx[:, None] >= idx[None, :]
    strict = idx[:, None] > idx[None, :]
    L = jnp.exp(jnp.where(causal, gc[..., :, None] - gc[..., None, :], -jnp.inf))
    kb = k * beta[..., None]
    vb = v * beta[..., None]
    M = jnp.where(strict, jnp.einsum('bhnik,bhnjk->bhnij', kb, k) * L, 0.0)
    eye = jnp.broadcast_to(jnp.eye(C, dtype=M.dtype), M.shape)
    Tm = lax.linalg.triangular_solve(eye + M, eye, left_side=True, lower=True)
    u_pre = jnp.einsum('bhnij,bhnjv->bhniv', Tm, vb)
    w_dec = jnp.einsum('bhnij,bhnjk->bhnik', Tm, kb * jnp.exp(gc)[..., None])
    a_qk = jnp.where(causal, jnp.einsum('bhnik,bhnjk->bhnij', q, k) * L, 0.0)
    q_dec = q * jnp.exp(gc)[..., None]
    g_last = gc[..., -1]
    k_dec = k * jnp.exp(g_last[..., None] - gc)[..., None]
    xs = tuple(jnp.moveaxis(a, 2, 0) for a in (q_dec, a_qk, k_dec, u_pre, w_dec, jnp.exp(g_last)))

    def step(S, inp):
        qd, aqk, kd, up, wd, dl = inp
        u = up - jnp.einsum('bhck,bhkv->bhcv', wd, S)
        o = jnp.einsum('bhck,bhkv->bhcv', qd, S) + jnp.einsum('bhij,bhjv->bhiv', aqk, u)
        S = S * dl[..., None, None] + jnp.einsum('bhck,bhcv->bhkv', kd, u)
        return S, o

    S_new, o = lax.scan(step, S0, xs)
    o = jnp.transpose(o, (1, 0, 3, 2, 4)).reshape(Bn, Tp, H, V)[:, :T]
    return o, S_new


def _layer(x, conv_a_buf, conv_qkv_buf, S0, w_in, conv_a_w, conv_b_w, a_log, dt_bias,
           onorm_w, w_out_a, w_out_b, w_o, norm_w):
    Bn, T, _ = x.shape
    u = _rmsnorm(x, norm_w)
    proj = jnp.einsum('btd,dn->btn', u, w_in)
    a_b, a_c, a_h, a_z, qkv, b_z, b_beta, b_alpha, g_a, g_b = jnp.split(proj, _split_points(), axis=-1)
    conv_out, new_a_buf = _causal_conv(a_c * a_h, conv_a_buf, conv_a_w)
    y_a = jnp.einsum('btc,cd->btd', jax.nn.silu(a_z) * a_b * conv_out, w_out_a)
    qkv_c, new_qkv_buf = _causal_conv(qkv, conv_qkv_buf, conv_b_w)
    qkv_c = jax.nn.silu(qkv_c).astype(jnp.float32)
    q = qkv_c[..., :KEY_W].reshape(Bn, T, N_HEADS, HEAD_K)
    k = qkv_c[..., KEY_W:2 * KEY_W].reshape(Bn, T, N_HEADS, HEAD_K)
    v = qkv_c[..., 2 * KEY_W:].reshape(Bn, T, N_HEADS, HEAD_V)
    q = _l2norm(q) * (HEAD_K ** -0.5)
    k = _l2norm(k)
    beta = jax.nn.sigmoid(b_beta.astype(jnp.float32))
    g = -jnp.exp(a_log.astype(jnp.float32)) * jax.nn.softplus(b_alpha.astype(jnp.float32) + dt_bias.astype(jnp.float32))
    o, S_new = _gated_delta(q, k, v, beta, g, S0.astype(jnp.float32))
    o = _rmsnorm(o, onorm_w) * jax.nn.silu(b_z.astype(jnp.float32).reshape(Bn, T, N_HEADS, HEAD_V))
    y_b = jnp.einsum('btc,cd->btd', o.reshape(Bn, T, VAL_W).astype(x.dtype), w_out_b)
    m = jax.nn.sigmoid(g_a) * y_a + jax.nn.sigmoid(g_b) * y_b
    return x + jnp.einsum('btd,de->bte', m, w_o), new_a_buf, new_qkv_buf, S_new


def setup_inputs(seed: int = 0) -> dict:
    key = jax.random.key(seed)
    ks = jax.random.split(key, 20)
    f = jnp.float32
    nrm = lambda k, s: jax.random.normal(k, s, f)
    A = jax.random.uniform(ks[8], (DEPTH, N_HEADS), f, 1.0, 16.0)
    dt = jnp.exp(jax.random.uniform(ks[9], (DEPTH, N_HEADS), f, np.log(1e-3), np.log(1e-1)))
    return {
        'x_prompt': nrm(ks[0], (BATCH, SEQ, D_MODEL)),
        'x_sample': nrm(ks[1], (DEC_BATCH, DEC_SEQ, D_MODEL)),
        'state_conv_a': nrm(ks[2], (DEPTH, DEC_BATCH, CONV_A_W - 1, D_CONV)),
        'state_conv_qkv': nrm(ks[3], (DEPTH, DEC_BATCH, CONV_B_W - 1, QKV_W)),
        'state_delta': 0.1 * nrm(ks[4], (DEPTH, DEC_BATCH, N_HEADS, HEAD_K, HEAD_V)),
        'w_in': nrm(ks[5], (DEPTH, D_MODEL, N_IN)) * D_MODEL ** -0.5,
        'conv_a_w': nrm(ks[6], (DEPTH, CONV_A_W, D_CONV)) * CONV_A_W ** -0.5,
        'conv_b_w': nrm(ks[7], (DEPTH, CONV_B_W, QKV_W)) * CONV_B_W ** -0.5,
        'a_log': jnp.log(A),
        'dt_bias': dt + jnp.log(-jnp.expm1(-dt)),
        'onorm_w': 1.0 + 0.02 * nrm(ks[10], (DEPTH, HEAD_V)),
        'w_out_a': nrm(ks[11], (DEPTH, D_CONV, D_MODEL)) * D_CONV ** -0.5,
        'w_out_b': nrm(ks[12], (DEPTH, VAL_W, D_MODEL)) * VAL_W ** -0.5,
        'w_o': nrm(ks[13], (DEPTH, D_MODEL, D_MODEL)) * D_MODEL ** -0.5,
        'norm_w': 1.0 + 0.02 * nrm(ks[14], (DEPTH, D_MODEL)),
        'final_norm_w': 1.0 + 0.02 * nrm(ks[15], (D_MODEL,)),
    }


def reference(x_prompt, x_sample, state_conv_a, state_conv_qkv, state_delta, w_in, conv_a_w,
              conv_b_w, a_log, dt_bias, onorm_w, w_out_a, w_out_b, w_o, norm_w, final_norm_w):
    hp, hs = x_prompt, x_sample
    pa, pq, pd, sa, sq, sd = [], [], [], [], [], []
    for l in range(DEPTH):
        params = (w_in[l], conv_a_w[l], conv_b_w[l], a_log[l], dt_bias[l], onorm_w[l],
                  w_out_a[l], w_out_b[l], w_o[l], norm_w[l])
        z_a = jnp.zeros((BATCH, CONV_A_W - 1, D_CONV), hp.dtype)
        z_q = jnp.zeros((BATCH, CONV_B_W - 1, QKV_W), hp.dtype)
        z_s = jnp.zeros((BATCH, N_HEADS, HEAD_K, HEAD_V), jnp.float32)
        hp, ba, bq, bs = _layer(hp, z_a, z_q, z_s, *params)
        pa.append(ba); pq.append(bq); pd.append(bs)
        hs, ba, bq, bs = _layer(hs, state_conv_a[l], state_conv_qkv[l], state_delta[l], *params)
        sa.append(ba); sq.append(bq); sd.append(bs)
    y_prompt = _rmsnorm(hp, final_norm_w)
    y_sample = _rmsnorm(hs, final_norm_w)
    new_conv_a_prompt = jnp.stack(pa)
    new_conv_qkv_prompt = jnp.stack(pq)
    new_delta_prompt = jnp.stack(pd)
    new_conv_a_sample = jnp.stack(sa)
    new_conv_qkv_sample = jnp.stack(sq)
    new_delta_sample = jnp.stack(sd)
    return (y_prompt, y_sample, new_conv_a_prompt, new_conv_qkv_prompt, new_delta_prompt,
            new_conv_a_sample, new_conv_qkv_sample, new_delta_sample)
```

```cpp
#include <hip/hip_runtime.h>
#include <hip/hip_cooperative_groups.h>
#include <cstdio>
#include <cstdint>
namespace cg = cooperative_groups;

#ifndef COOP
#define COOP 1
#endif
#ifndef DUP
#define DUP -1
#endif

typedef unsigned short bf16_t;
typedef short bf16x8 __attribute__((ext_vector_type(8)));
typedef float f32x4 __attribute__((ext_vector_type(4)));
typedef float f32x2 __attribute__((ext_vector_type(2)));
typedef float f32x16 __attribute__((ext_vector_type(16)));
typedef unsigned u32x4 __attribute__((ext_vector_type(4)));
typedef unsigned u32x2 __attribute__((ext_vector_type(2)));
typedef __bf16 bf16x2_t __attribute__((ext_vector_type(2)));

#define DI __device__ __forceinline__

constexpr int NT = 16896, NTP = 16384, DM = 1024, QW = 3072, NIN = 10256;
constexpr float EPS = 1e-6f;
constexpr size_t OFF_NCA_P = 17301504, OFF_NCQ_P = 17317888, OFF_ND_P = 17391616, OFF_NCA_S = 18440192, OFF_NCQ_S = 18702336, OFF_ND_S = 19881984;
constexpr int LDS_BYTES = 149504 + 16;

struct Params {
  const float *x_p, *x_s, *sca, *scq, *sd, *w_in, *caw, *cbw, *a_log, *dt_bias, *onw, *w_oa, *w_ob, *w_o, *nw, *fnw;
  float* out;
  bf16_t *QKV, *SBZ, *GATE, *UW, *AQK, *WOA, *WOB, *WO, *WB16;
  float *BG, *DL;
  bf16_t *SGA, *SGB, *WIN, *P, *HALO;
  unsigned* bar;
  float* RS;
};

DI unsigned pk2(float a, float b) { bf16x2_t v = __builtin_convertvector((f32x2){a, b}, bf16x2_t); return __builtin_bit_cast(unsigned, v); }
DI float bflo(unsigned w) { return __uint_as_float(w << 16); }
DI float bfhi(unsigned w) { return __uint_as_float(w & 0xffff0000u); }
DI float bf2f(bf16_t v) { return __uint_as_float(((unsigned)v) << 16); }
DI float siluf(float x) { return x * __builtin_amdgcn_rcpf(1.f + __expf(-x)); }
DI float sigmf(float x) { return __builtin_amdgcn_rcpf(1.f + __expf(-x)); }
DI f32x4 ldnt4(const float* q) { return __builtin_nontemporal_load((const f32x4*)q); }
DI void stnt4(float* q, f32x4 v) { __builtin_nontemporal_store(v, (f32x4*)q); }
DI float wave_sum(float v) {
#pragma unroll
  for (int o = 1; o < 64; o <<= 1) v += __shfl_xor(v, o);
  return v;
}
DI void unpack8(u32x4 w, float* f) { f[0] = bflo(w.x); f[1] = bfhi(w.x); f[2] = bflo(w.y); f[3] = bfhi(w.y); f[4] = bflo(w.z); f[5] = bfhi(w.z); f[6] = bflo(w.w); f[7] = bfhi(w.w); }
DI u32x4 pack8(const float* f) { u32x4 w; w.x = pk2(f[0], f[1]); w.y = pk2(f[2], f[3]); w.z = pk2(f[4], f[5]); w.w = pk2(f[6], f[7]); return w; }

DI int perm32(int rho) { const int n = rho >> 4, i = rho & 15; return 8 * (i >> 2) + 4 * n + (i & 3); }
DI int colmap_in(int R) {
  const int pn = R >> 8, l = R & 255, bj = l >> 7, wc = (l & 127) >> 5, rho = l & 31;
  if (pn < 16) { const int n = rho >> 4, i = rho & 15; return (bj * 2 + n) * 1024 + 64 * pn + wc * 16 + i; }
  const int base = pn < 32 ? 4096 + (pn - 16) * 256 : 8208 + (pn - 32) * 256;
  return base + bj * 128 + wc * 32 + perm32(rho);
}
DI int colmap_sq(int R) { return (R & ~31) + perm32(R & 31); }

constexpr int BM = 256, BK = 64, HALF = 128, NXCD = 8, WGM = 8, HT = HALF * BK;
DI void lds_barrier() { asm volatile("s_waitcnt lgkmcnt(0)" ::: "memory"); __builtin_amdgcn_s_barrier(); asm volatile("" ::: "memory"); }
DI int launder(int x) { asm volatile("" : "+v"(x)); return x; }
DI int lds_byte(int r, int c) { const int st = (r >> 4) * 2 + (c >> 5), rr = r & 15, cc = c & 31, ob = rr * 64 + cc * 2; return st * 1024 + (ob ^ (((ob >> 9) & 1) << 5)); }
DI void stage_rc(int b, int& R, int& C) { const int st = b / 1024, sb = b % 1024, swz = sb ^ (((sb >> 9) & 1) << 5); R = (st >> 1) * 16 + swz / 64; C = (st & 1) * 32 + (swz % 64) / 2; }

struct TileOrder {
  int nM, nN, nwg, G, c;
  DI void init(int M, int N, int G_, int c_) { nM = M / BM; nN = N / BM; nwg = nM * nN; G = G_; c = c_; }
  DI bool next(int i, int& pm, int& pn) const {
    const long L = (long)i * G + c; if (L >= nwg) return false;
    int wgid = (int)L; { const int q = nwg / NXCD, r = nwg % NXCD, xcd = wgid % NXCD, off = wgid / NXCD; wgid = (xcd < r ? xcd * (q + 1) : r * (q + 1) + (xcd - r) * q) + off; }
    const int nig = WGM * nN, gid = wgid / nig, fm = gid * WGM, gsz = (nM - fm) < WGM ? (nM - fm) : WGM;
    pm = fm + ((wgid % nig) % gsz); pn = (wgid % nig) / gsz; return true;
  }
};

#define FN_CNT(pm) (XCD_BAR_WORDS_C + 64 * (pm))
constexpr int XCD_BAR_WORDS_C = 3456;
DI void epilogue_final(const Params& p, f32x4 (&acc)[2][2][4][2], int pm, int pn, int wr, int wc, int fr, int fq, unsigned char* smem_, int tid) {
  float* PS = (float*)(smem_ + 131072);
  float* RSTD = (float*)(smem_ + 131072 + 4096);
  const int col0 = pn * BM + wc * 32 + 8 * fq;
#pragma unroll
  for (int ai = 0; ai < 2; ++ai)
#pragma unroll
    for (int m = 0; m < 4; ++m) {
      const int rl = ai * HALF + wr * 64 + m * 16 + fr; const size_t row = (size_t)pm * BM + rl;
      const float* xr = p.x_p + row * DM;
      float ss = 0.f;
#pragma unroll
      for (int bj = 0; bj < 2; ++bj) {
        const f32x4 x0 = ldnt4(xr + col0 + bj * HALF), x1 = ldnt4(xr + col0 + bj * HALF + 4);
        acc[ai][bj][m][0] += x0; acc[ai][bj][m][1] += x1;
        const f32x4 a = acc[ai][bj][m][0], b = acc[ai][bj][m][1];
        ss += (a.x * a.x + a.y * a.y) + (a.z * a.z + a.w * a.w) + (b.x * b.x + b.y * b.y) + (b.z * b.z + b.w * b.w);
      }
      ss += __shfl_xor(ss, 16); ss += __shfl_xor(ss, 32);
      if (fq == 0) PS[rl * 4 + wc] = ss;
      __builtin_amdgcn_sched_barrier(0);
    }
  lds_barrier();
  unsigned* cnt = p.bar + FN_CNT(pm);
  if (tid < 256) {
    const f32x4 s4 = *(const f32x4*)(PS + tid * 4);
    __hip_atomic_store((unsigned*)p.RS + ((size_t)(pm * 4 + pn) * 256 + tid), __float_as_uint((s4.x + s4.y) + (s4.z + s4.w)), __ATOMIC_RELAXED, __HIP_MEMORY_SCOPE_AGENT);
  }
  asm volatile("s_waitcnt vmcnt(0)" ::: "memory");
  lds_barrier();
  if (tid == 0) __hip_atomic_fetch_add(cnt, 1u, __ATOMIC_RELAXED, __HIP_MEMORY_SCOPE_AGENT);
  if (tid < 64) {
    unsigned sp = 0;
    while ((unsigned)__builtin_amdgcn_readfirstlane(__hip_atomic_load(cnt, __ATOMIC_RELAXED, __HIP_MEMORY_SCOPE_AGENT)) < 4u) { __builtin_amdgcn_s_sleep(2); if (++sp > (1u << 20)) break; }
    __builtin_amdgcn_fence(__ATOMIC_ACQUIRE, "agent");
  }
  asm volatile("s_waitcnt vmcnt(0) lgkmcnt(0)" ::: "memory");
  lds_barrier();
  if (tid < 256) {
    float tot = 0.f;
#pragma unroll
    for (int t = 0; t < 4; ++t) tot += __uint_as_float(__hip_atomic_load((unsigned*)p.RS + ((size_t)(pm * 4 + t) * 256 + tid), __ATOMIC_RELAXED, __HIP_MEMORY_SCOPE_AGENT));
    RSTD[tid] = rsqrtf(tot * (1.f / DM) + EPS);
  }
  lds_barrier();
#pragma unroll
  for (int bj = 0; bj < 2; ++bj) {
    const f32x4 fw0 = *(const f32x4*)(p.fnw + col0 + bj * HALF), fw1 = *(const f32x4*)(p.fnw + col0 + bj * HALF + 4);
#pragma unroll
    for (int ai = 0; ai < 2; ++ai)
#pragma unroll
      for (int m = 0; m < 4; ++m) {
        const int rl = ai * HALF + wr * 64 + m * 16 + fr; const size_t row = (size_t)pm * BM + rl; const float r = RSTD[rl];
        float* o = p.out + row * DM + col0 + bj * HALF;
        stnt4(o, acc[ai][bj][m][0] * r * fw0); stnt4(o + 4, acc[ai][bj][m][1] * r * fw1);
        __builtin_amdgcn_sched_barrier(0);
      }
  }
}

template <int EPI>
DI void epilogue(const Params& p, const f32x4 (&acc)[2][2][4][2], int pm, int pn, int wr, int wc, int fr, int fq) {
  const int row0 = pm * BM + wr * 64 + fr;
  if (EPI == 0) {
    if (pn < 16) {
      const int ch = pn * 64 + wc * 16 + fq * 4;
#pragma unroll
      for (int ai = 0; ai < 2; ++ai)
#pragma unroll
        for (int m = 0; m < 4; ++m) {
          const size_t row = row0 + ai * HALF + m * 16;
          const f32x4 b = acc[ai][0][m][0], c = acc[ai][0][m][1], h = acc[ai][1][m][0], z = acc[ai][1][m][1];
          u32x2 pp, gg;
          pp.x = pk2(c[0] * h[0], c[1] * h[1]); pp.y = pk2(c[2] * h[2], c[3] * h[3]);
          gg.x = pk2(siluf(z[0]) * b[0], siluf(z[1]) * b[1]); gg.y = pk2(siluf(z[2]) * b[2], siluf(z[3]) * b[3]);
          *(u32x2*)(p.P + row * DM + ch) = pp;
          *(u32x2*)(p.GATE + row * DM + ch) = gg;
        }
    } else {
      const int kind = pn < 28 ? 0 : (pn < 32 ? 1 : 2);
      bf16_t* dst; int ld, colt;
      if (kind == 0) { dst = p.QKV; ld = QW; colt = (pn - 16) * 256; }
      else if (kind == 1) { dst = p.SBZ; ld = DM; colt = (pn - 28) * 256; }
      else { dst = pn < 36 ? p.SGA : p.SGB; ld = DM; colt = ((pn - 32) & 3) * 256; }
      const int col0 = colt + wc * 32 + 8 * fq;
#pragma unroll
      for (int ai = 0; ai < 2; ++ai)
#pragma unroll
        for (int m = 0; m < 4; ++m) {
          const int row = row0 + ai * HALF + m * 16;
#pragma unroll
          for (int bj = 0; bj < 2; ++bj) {
            f32x4 v0 = acc[ai][bj][m][0], v1 = acc[ai][bj][m][1];
            if (kind == 1) { for (int j = 0; j < 4; ++j) { v0[j] = siluf(v0[j]); v1[j] = siluf(v1[j]); } }
            if (kind == 2) { for (int j = 0; j < 4; ++j) { v0[j] = sigmf(v0[j]); v1[j] = sigmf(v1[j]); } }
            u32x4 w; w.x = pk2(v0[0], v0[1]); w.y = pk2(v0[2], v0[3]); w.z = pk2(v1[0], v1[1]); w.w = pk2(v1[2], v1[3]);
            *(u32x4*)(dst + (size_t)row * ld + col0 + bj * HALF) = w;
            if (kind == 0 && row < NTP && (row & 63) >= 61)
              *(u32x4*)(p.HALO + ((size_t)(row >> 6) * 3 + ((row & 63) - 61)) * QW + col0 + bj * HALF) = w;
          }
        }
    }
  } else {
    const int col0 = pn * BM + wc * 32 + 8 * fq;
#pragma unroll
    for (int ai = 0; ai < 2; ++ai)
#pragma unroll
      for (int m = 0; m < 4; ++m) {
        const size_t row = row0 + ai * HALF + m * 16;
#pragma unroll
        for (int bj = 0; bj < 2; ++bj) {
          const f32x4 v0 = acc[ai][bj][m][0], v1 = acc[ai][bj][m][1];
          const size_t o = row * DM + col0 + bj * HALF;
          if (EPI == 1) {
            float s[8]; unpack8(*(const u32x4*)(p.SGA + o), s);
            u32x4 w; w.x = pk2(s[0] * v0[0], s[1] * v0[1]); w.y = pk2(s[2] * v0[2], s[3] * v0[3]); w.z = pk2(s[4] * v1[0], s[5] * v1[1]); w.w = pk2(s[6] * v1[2], s[7] * v1[3]);
            *(u32x4*)(p.SGA + o) = w;
          } else if (EPI == 2) {
            float s[8], a[8]; unpack8(*(const u32x4*)(p.SGB + o), s); unpack8(*(const u32x4*)(p.SGA + o), a);
            u32x4 w; w.x = pk2(a[0] + s[0] * v0[0], a[1] + s[1] * v0[1]); w.y = pk2(a[2] + s[2] * v0[2], a[3] + s[3] * v0[3]);
            w.z = pk2(a[4] + s[4] * v1[0], a[5] + s[5] * v1[1]); w.w = pk2(a[6] + s[6] * v1[2], a[7] + s[7] * v1[3]);
            *(u32x4*)(p.UW + o) = w;
          } else {
            const float* xr = row < NTP ? p.x_p + row * DM : p.x_s + (row - NTP) * DM;
            const f32x4 x0 = *(const f32x4*)(xr + col0 + bj * HALF), x1 = *(const f32x4*)(xr + col0 + bj * HALF + 4);
            *(f32x4*)(p.out + o) = x0 + v0; *(f32x4*)(p.out + o + 4) = x1 + v1;
          }
        }
      }
  }
}

#define LAS __attribute__((address_space(3)))
struct Sched {
  int mode, nM, nN, nwg, G, c, start, stride, count;
  DI void init_static(int M, int N, int G_, int c_) { mode = 0; nM = M / BM; nN = N / BM; nwg = nM * nN; G = G_; c = c_; start = stride = count = 0; }
  DI void init_strided(int start_, int stride_, int count_) { mode = 1; start = start_; stride = stride_; count = count_; nM = nN = nwg = G = c = 0; }
  DI bool next(int i, int& pm, int& pn) const {
    if (mode == 0) {
      const long L = (long)i * G + c; if (L >= nwg) return false;
      int wgid = (int)L; { const int q = nwg / NXCD, r = nwg % NXCD, xcd = wgid % NXCD, off = wgid / NXCD; wgid = (xcd < r ? xcd * (q + 1) : r * (q + 1) + (xcd - r) * q) + off; }
      const int nig = WGM * nN, gid = wgid / nig, fm = gid * WGM, gsz = (nM - fm) < WGM ? (nM - fm) : WGM;
      pm = fm + ((wgid % nig) % gsz); pn = (wgid % nig) / gsz; return true;
    }
    const int t = start + i * stride; if (t >= count) return false;
    pm = t >> 2; pn = t & 3; return true;
  }
};

template <int EPI>
DI void gemm_phase(const Params& p, LAS unsigned char* lds, const bf16_t* A, int lda, const bf16_t* Bt, const Sched& S) {
  constexpr int K = 1024, nt = K / BK, HTB = HALF * BK * 2;
  const int tid = launder(threadIdx.x), wid = __builtin_amdgcn_readfirstlane(tid >> 6), lane = tid & 63, wr = wid >> 2, wc = wid & 3, fr = lane & 15, fq = lane >> 4;
  unsigned voffA[2], voffB[2];
#pragma unroll
  for (int i = 0; i < 2; ++i) { int R, C; stage_rc(tid * 16 + i * 8192, R, C); voffA[i] = (unsigned)(R * lda + C) * 2u; voffB[i] = (unsigned)(R * K + C) * 2u; }
  const size_t kstep = (size_t)(BK * 2);
  const size_t hstepA = (size_t)HALF * lda * 2, tstepA = 2 * hstepA, hstepB = (size_t)HALF * K * 2, tstepB = 2 * hstepB;
  const unsigned ldsw = (unsigned)wid * 1024u;
  const int aoff = lds_byte(wr * 64 + fr, fq * 8), boff = lds_byte(wc * 32 + fr, fq * 8);
#define PG8_SA(b, h) (((b) * 2 + (h)) * HTB)
#define PG8_SB(b, h) ((4 + (b) * 2 + (h)) * HTB)
#define PG8_STAGE(bufoff, gbase, voff) do { _Pragma("unroll") for (int _i = 0; _i < 2; ++_i) \
    __builtin_amdgcn_global_load_lds((const unsigned*)((const char*)(gbase) + (voff)[_i]), (LAS unsigned*)(lds + (bufoff) + ldsw + _i * 8192), 16, 0, 0); } while (0)
#define PG8_LDA(dst, b, h) do { _Pragma("unroll") for (int m = 0; m < 4; ++m) _Pragma("unroll") for (int k = 0; k < 2; ++k) dst[m][k] = *(const LAS bf16x8*)(lds + PG8_SA(b, h) + aoff + m * 2048 + k * 1024); } while (0)
#define PG8_LDB(dst, b, h) do { _Pragma("unroll") for (int n = 0; n < 2; ++n) _Pragma("unroll") for (int k = 0; k < 2; ++k) dst[n][k] = *(const LAS bf16x8*)(lds + PG8_SB(b, h) + boff + n * 2048 + k * 1024); } while (0)
#define PG8_MMA(ai, bj, At, Bt_) do { __builtin_amdgcn_s_setprio(1); _Pragma("unroll") for (int m = 0; m < 4; ++m) _Pragma("unroll") for (int n = 0; n < 2; ++n) _Pragma("unroll") for (int k = 0; k < 2; ++k) \
    acc[ai][bj][m][n] = __builtin_amdgcn_mfma_f32_16x16x32_bf16(Bt_[n][k], At[m][k], acc[ai][bj][m][n], 0, 0, 0); __builtin_amdgcn_s_setprio(0); } while (0)
#define PG8_WAIT_V(n) asm volatile("s_waitcnt vmcnt(" #n ")" ::: "memory")
#define PG8_WAIT_L(n) asm volatile("s_waitcnt lgkmcnt(" #n ")" ::: "memory")
#define PG8_BAR __builtin_amdgcn_s_barrier()
#define PG8_SCHED __builtin_amdgcn_sched_barrier(0)
  int cpm, cpn, npm = 0, npn = 0; int ui = 0;
  if (!S.next(0, cpm, cpn)) return;
  f32x4 acc[2][2][4][2];
#pragma unroll
  for (int a = 0; a < 2; ++a)
#pragma unroll
    for (int b = 0; b < 2; ++b)
#pragma unroll
      for (int m = 0; m < 4; ++m)
#pragma unroll
        for (int n = 0; n < 2; ++n) acc[a][b][m][n] = (f32x4){0.f, 0.f, 0.f, 0.f};
  bf16x8 At[4][2], B0[2][2], B1[2][2];
  const char* cA = (const char*)A + (size_t)cpm * tstepA; const char* cB = (const char*)Bt + (size_t)cpn * tstepB;
  PG8_STAGE(PG8_SB(0, 0), cB, voffB); PG8_STAGE(PG8_SB(0, 1), cB + hstepB, voffB); PG8_STAGE(PG8_SA(0, 0), cA, voffA); PG8_STAGE(PG8_SA(0, 1), cA + hstepA, voffA);
  if (wr == 1) PG8_BAR;
  PG8_WAIT_V(2); PG8_BAR;
  PG8_STAGE(PG8_SB(1, 0), cB + kstep, voffB); PG8_STAGE(PG8_SA(1, 0), cA + kstep, voffA); PG8_STAGE(PG8_SB(1, 1), cB + hstepB + kstep, voffB);
  PG8_WAIT_V(6); PG8_BAR;
  for (;;) {
    const bool has_next = S.next(ui + 1, npm, npn);
    const char* nA = has_next ? (const char*)A + (size_t)npm * tstepA : cA; const char* nB = has_next ? (const char*)Bt + (size_t)npn * tstepB : cB;
#pragma unroll 1
    for (int t = 0; t < nt; t += 2) {
      const bool last = (t == nt - 2);
      const char* a1 = cA + (size_t)(t + 1) * kstep;
      const char* a2 = last ? nA : cA + (size_t)(t + 2) * kstep; const char* b2 = last ? nB : cB + (size_t)(t + 2) * kstep;
      const char* a3 = a2 + kstep; const char* b3 = b2 + kstep;
      PG8_LDB(B0, 0, 0); PG8_LDB(B1, 0, 1); PG8_SCHED; PG8_LDA(At, 0, 0); PG8_STAGE(PG8_SA(1, 1), a1 + hstepA, voffA);
      PG8_WAIT_V(8); PG8_WAIT_L(0); PG8_BAR; PG8_MMA(0, 0, At, B0); PG8_MMA(0, 1, At, B1); PG8_BAR; PG8_SCHED;
      PG8_LDA(At, 0, 1); PG8_STAGE(PG8_SB(0, 0), b2, voffB); PG8_STAGE(PG8_SB(0, 1), b2 + hstepB, voffB); PG8_STAGE(PG8_SA(0, 0), a2, voffA);
      PG8_WAIT_V(8); PG8_WAIT_L(0); PG8_BAR; PG8_MMA(1, 0, At, B0); PG8_MMA(1, 1, At, B1); PG8_BAR; PG8_SCHED;
      PG8_LDB(B0, 1, 0); PG8_LDB(B1, 1, 1); PG8_SCHED; PG8_LDA(At, 1, 0); PG8_STAGE(PG8_SA(0, 1), a2 + hstepA, voffA);
      PG8_WAIT_V(8); PG8_WAIT_L(0); PG8_BAR; PG8_MMA(0, 0, At, B0); PG8_MMA(0, 1, At, B1); PG8_BAR; PG8_SCHED;
      PG8_LDA(At, 1, 1); PG8_STAGE(PG8_SB(1, 0), b3, voffB); PG8_STAGE(PG8_SB(1, 1), b3 + hstepB, voffB); PG8_STAGE(PG8_SA(1, 0), a3, voffA);
      PG8_WAIT_V(8); PG8_WAIT_L(0); PG8_BAR; PG8_MMA(1, 0, At, B0); PG8_MMA(1, 1, At, B1); PG8_BAR; PG8_SCHED;
    }
    if (wr == 0) PG8_BAR;
    if (!(EPI == 4 && gridDim.x == 256)) epilogue<EPI == 4 ? 3 : EPI>(p, acc, cpm, cpn, wr, wc, fr, fq);
    if (!has_next) break;
#pragma unroll
    for (int a = 0; a < 2; ++a)
#pragma unroll
      for (int b = 0; b < 2; ++b)
#pragma unroll
        for (int m = 0; m < 4; ++m)
#pragma unroll
          for (int n = 0; n < 2; ++n) acc[a][b][m][n] = (f32x4){0.f, 0.f, 0.f, 0.f};
    cpm = npm; cpn = npn; cA = nA; cB = nB; ++ui;
    if (wr == 1) PG8_BAR;
  }
  PG8_WAIT_V(0);
  PG8_BAR;
  if (EPI == 4 && gridDim.x == 256) epilogue_final(p, acc, cpm, cpn, wr, wc, fr, fq, (unsigned char*)lds, tid);
#undef PG8_SA
#undef PG8_SB
#undef PG8_STAGE
#undef PG8_LDA
#undef PG8_LDB
#undef PG8_MMA
}

template <int EPI>
DI void gemm_tail(const Params& p, const bf16_t* A, int lda, const bf16_t* Bt, int tile0, int ntiles) {
  const int tid = launder(threadIdx.x), wid = tid >> 6, lane = tid & 63, fr = lane & 15, fq = lane >> 4;
  for (int q = blockIdx.x; q < ntiles * 32; q += gridDim.x) {
    const int t = tile0 + (q >> 5), sub = q & 31, pm = t >> 2, pn = t & 3;
    const int row0 = pm * 256 + (sub >> 3) * 64 + (wid >> 1) * 16, R0 = pn * 256 + (sub & 7) * 32 + (wid & 1) * 16;
    const bf16_t* ap = A + (size_t)(row0 + fr) * lda + fq * 8; const bf16_t* bp = Bt + (size_t)(R0 + fr) * DM + fq * 8;
    f32x4 acc = {0.f, 0.f, 0.f, 0.f};
#pragma unroll 16
    for (int ks = 0; ks < 32; ++ks) { const bf16x8 a = *(const bf16x8*)(ap + ks * 32), b = *(const bf16x8*)(bp + ks * 32); acc = __builtin_amdgcn_mfma_f32_16x16x32_bf16(b, a, acc, 0, 0, 0); }
    const size_t row = row0 + fr; const int col0 = (R0 & ~31) + 8 * fq + 4 * ((R0 >> 4) & 1);
    const size_t o = row * DM + col0;
    if (EPI == 2) {
      const u32x2 sw = *(const u32x2*)(p.SGB + o), aw = *(const u32x2*)(p.SGA + o);
      u32x2 w; w.x = pk2(bflo(aw.x) + bflo(sw.x) * acc[0], bfhi(aw.x) + bfhi(sw.x) * acc[1]); w.y = pk2(bflo(aw.y) + bflo(sw.y) * acc[2], bfhi(aw.y) + bfhi(sw.y) * acc[3]);
      *(u32x2*)(p.UW + o) = w;
    } else {
      const float* xr = row < NTP ? p.x_p + row * DM : p.x_s + (row - NTP) * DM;
      *(f32x4*)(p.out + o) = *(const f32x4*)(xr + col0) + acc;
    }
  }
}

DI void wtile_desc(const Params& p, int tile, const float*& src, bf16_t*& dst, int& N, int& kt, int& R0, int& kind) {
  if (tile < 2560) { src = p.w_in; dst = p.WIN; N = NIN; kt = tile & 15; R0 = (tile >> 4) * 64; kind = 0; }
  else { const int t2 = tile - 2560, mat = t2 >> 8; src = mat == 0 ? p.w_oa : (mat == 1 ? p.w_ob : p.w_o); dst = mat == 0 ? p.WOA : (mat == 1 ? p.WOB : p.WO); N = DM; kt = t2 & 15; R0 = ((t2 & 255) >> 4) * 64; kind = 1; }
}
DI void convert_tiles(const Params& p, int first, int end, int stride) {
  extern __shared__ __attribute__((aligned(16))) unsigned char smem[];
  float* lds = (float*)smem;
  const int tid = launder(threadIdx.x);
#pragma unroll 1
  for (int t0 = first; t0 < end; t0 += 4 * stride) {
    f32x4 v[4][2];
#pragma unroll
    for (int q = 0; q < 4; ++q) {
      const int tile = t0 + q * stride;
      if (tile < end) {
        const float* src; bf16_t* dst; int N, kt, R0, kind; wtile_desc(p, tile, src, dst, N, kt, R0, kind);
        const int r4 = tid & 15, R = R0 + r4 * 4, c = kind == 0 ? colmap_in(R) : colmap_sq(R);
#pragma unroll
        for (int ps = 0; ps < 2; ++ps) v[q][ps] = ldnt4(src + (size_t)(kt * 64 + ps * 32 + (tid >> 4)) * N + c);
      }
    }
#pragma unroll
    for (int q = 0; q < 4; ++q) {
      if (t0 + q * stride < end) {
#pragma unroll
        for (int ps = 0; ps < 2; ++ps) { float* d = lds + q * (64 * 65) + (ps * 32 + (tid >> 4)) * 65 + (tid & 15) * 4; d[0] = v[q][ps].x; d[1] = v[q][ps].y; d[2] = v[q][ps].z; d[3] = v[q][ps].w; }
      }
    }
    lds_barrier();
#pragma unroll
    for (int q = 0; q < 4; ++q) {
      const int tile = t0 + q * stride;
      if (tile < end) {
        const float* src; bf16_t* dst; int N, kt, R0, kind; wtile_desc(p, tile, src, dst, N, kt, R0, kind);
        const int R = tid >> 3, kg = tid & 7; float f[8];
#pragma unroll
        for (int i = 0; i < 8; ++i) f[i] = lds[q * (64 * 65) + (kg * 8 + i) * 65 + R];
        *(u32x4*)(dst + (size_t)(R0 + R) * DM + kt * 64 + kg * 8) = pack8(f);
      }
    }
    lds_barrier();
  }
}

__device__ void phase0(const Params& p) {
  extern __shared__ __attribute__((aligned(16))) unsigned char smem[];
  float* lds = (float*)smem;
  const int tid = threadIdx.x, wid = tid >> 6, lane = tid & 63, G = gridDim.x;
  {
    f32x4 w[4];
#pragma unroll
    for (int i = 0; i < 4; ++i) w[i] = *(const f32x4*)(p.nw + i * 256 + lane * 4);
#pragma unroll 1
    for (int row = (blockIdx.x * 8 + wid) * 4; row < NT; row += G * 8 * 4) {
      f32x4 v[4][4];
#pragma unroll
      for (int q = 0; q < 4; ++q) { const int r = row + q; const float* xr = r < NTP ? p.x_p + (size_t)r * DM : p.x_s + (size_t)(r - NTP) * DM;
#pragma unroll
        for (int i = 0; i < 4; ++i) v[q][i] = ldnt4(xr + i * 256 + lane * 4); }
#pragma unroll
      for (int q = 0; q < 4; ++q) {
        float ss = 0.f;
#pragma unroll
        for (int i = 0; i < 4; ++i) ss += (v[q][i].x * v[q][i].x + v[q][i].y * v[q][i].y) + (v[q][i].z * v[q][i].z + v[q][i].w * v[q][i].w);
        ss = wave_sum(ss);
        const float rstd = rsqrtf(ss * (1.f / DM) + EPS);
#pragma unroll
        for (int i = 0; i < 4; ++i) { u32x2 o; o.x = pk2(v[q][i].x * rstd * w[i].x, v[q][i].y * rstd * w[i].y); o.y = pk2(v[q][i].z * rstd * w[i].z, v[q][i].w * rstd * w[i].w);
          *(u32x2*)(p.UW + (size_t)(row + q) * DM + i * 256 + lane * 4) = o; }
      }
    }
  }
  convert_tiles(p, blockIdx.x, 2560, G);
  for (int idx = blockIdx.x * 512 + tid; idx < 16 * DM; idx += G * 512) { const int c = idx >> 10, k = idx & 1023; p.WB16[idx] = (bf16_t)(pk2(p.w_in[(size_t)k * NIN + 8192 + c], 0.f) & 0xffffu); }
}

__device__ void phase1(const Params& p) {
  const int G = gridDim.x;
  { extern __shared__ __attribute__((aligned(16))) unsigned char smem[];
    Sched S; S.init_static(NT, 10240, G, blockIdx.x); gemm_phase<0>(p, (LAS unsigned char*)smem, p.UW, DM, p.WIN, S); }
  const int nfull = G == 256 ? 80 : 0, nside = G - nfull, sidx = (int)blockIdx.x - nfull;
  if (sidx >= 0) convert_tiles(p, 2560 + sidx, 2560 + 768, nside);
  const int tid = launder(threadIdx.x), wid = tid >> 6, lane = tid & 63, fr = lane & 15, fq = lane >> 4;
  if (sidx >= 0)
  for (int task = sidx * 8 + wid; task < NT / 16; task += nside * 8) {
    const int base = task * 16; f32x4 acc = {0.f, 0.f, 0.f, 0.f};
    const bf16_t* ap = p.UW + (size_t)(base + fr) * DM + fq * 8; const bf16_t* bp = p.WB16 + fr * DM + fq * 8;
#pragma unroll 8
    for (int ks = 0; ks < 32; ++ks) { const bf16x8 a = *(const bf16x8*)(ap + ks * 32), b = *(const bf16x8*)(bp + ks * 32); acc = __builtin_amdgcn_mfma_f32_16x16x32_bf16(a, b, acc, 0, 0, 0); }
    const int c = fr, h = c & 7; const float na = -__expf(p.a_log[h]), db = p.dt_bias[h];
#pragma unroll
    for (int j = 0; j < 4; ++j) {
      const int tok = base + fq * 4 + j; const float v = acc[j]; float r;
      if (c < 8) r = sigmf(v); else { const float xx = v + db; r = na * (xx > 20.f ? xx : log1pf(__expf(xx))); }
      p.BG[(size_t)tok * 16 + c] = r;
    }
  }
}

DI u32x4 raw_unit_load(const Params& p, int cgi, int h, int u) {
  const int r = u / 48, rem = u % 48, part = rem >> 4, c8 = rem & 15;
  u32x4 v = {0u, 0u, 0u, 0u};
  if (r < 3) { if ((cgi & 31) > 0) v = *(const u32x4*)(p.HALO + ((size_t)(cgi - 1) * 3 + r) * QW + part * 1024 + h * 128 + c8 * 8); }
  else v = *(const u32x4*)(p.QKV + (size_t)(cgi * 64 + r - 3) * QW + part * 1024 + h * 128 + c8 * 8);
  return v;
}
DI int crow(int r, int lh) { return (r & 3) + 8 * (r >> 2) + 4 * lh; }
DI bf16x8 packfrag(const f32x16& x, int s) {
  u32x4 w; w.x = pk2(x[8 * s], x[8 * s + 1]); w.y = pk2(x[8 * s + 2], x[8 * s + 3]); w.z = pk2(x[8 * s + 4], x[8 * s + 5]); w.w = pk2(x[8 * s + 6], x[8 * s + 7]);
  return __builtin_bit_cast(bf16x8, w);
}
DI bf16x8 ld_permk(const bf16_t* rowp, int s, int lh) {
  const u32x2 a = *(const u32x2*)(rowp + 16 * s + 4 * lh), b = *(const u32x2*)(rowp + 16 * s + 8 + 4 * lh);
  u32x4 w; w.x = a.x; w.y = a.y; w.z = b.x; w.w = b.y; return __builtin_bit_cast(bf16x8, w);
}

DI void chunk_task(const Params& p, int cgi, int h, u32x4 (&pre)[7], float& pg, float& pb, int next_cgi, int next_h, bool has_next) {
  extern __shared__ __attribute__((aligned(16))) unsigned char smem[];
  bf16_t* raw = (bf16_t*)smem;
  bf16_t* qh = (bf16_t*)(smem + 52736);
  bf16_t* kh = (bf16_t*)(smem + 70144);
  bf16_t* vh = (bf16_t*)(smem + 87552);
  float* Mm = (float*)(smem + 104960);
  bf16_t* M10n = (bf16_t*)(smem + 121344);
  bf16_t* Tb = (bf16_t*)(smem + 123904);
  float* gcs = (float*)(smem + 129024);
  float* bet = (float*)(smem + 129280);
  float* rsk = (float*)(smem + 129536);
  const float* cw = (const float*)(smem + 129792);
  const int tid = launder(threadIdx.x), wid = tid >> 6, lane = tid & 63;
  const int n = cgi & 31, b = cgi >> 5, T0 = cgi * 64, ci = cgi * 8 + h;
#pragma unroll
  for (int k = 0; k < 7; ++k) { const int u = k * 512 + tid; if (u < 67 * 48) { const int r = u / 48, rem = u % 48; *(u32x4*)(raw + r * 392 + (rem >> 4) * 128 + (rem & 15) * 8) = pre[k]; } }
  if (has_next) {
#pragma unroll
    for (int k = 0; k < 7; ++k) { const int u = k * 512 + tid; if (u < 67 * 48) pre[k] = raw_unit_load(p, next_cgi, next_h, u); }
  }
  if (wid == 0) {
    float g = pg; const float be = pb;
    if (has_next) { pg = p.BG[(size_t)(next_cgi * 64 + lane) * 16 + 8 + next_h]; pb = p.BG[(size_t)(next_cgi * 64 + lane) * 16 + next_h]; }
#pragma unroll
    for (int o = 1; o < 64; o <<= 1) { const float t = __shfl_up(g, o); if (lane >= o) g += t; }
    gcs[lane] = g; bet[lane] = be; rsk[lane] = be * __expf(g);
  }
  lds_barrier();
  const float glast = gcs[63];
#pragma unroll 1
  for (int part = 0; part < 3; ++part) {
    const int c8 = tid & 15, row = (tid >> 4) * 2;
    f32x2 w2[4][4];
#pragma unroll
    for (int j = 0; j < 4; ++j) { const f32x4 wa = *(const f32x4*)(cw + (part * 4 + j) * 128 + c8 * 8), wb = *(const f32x4*)(cw + (part * 4 + j) * 128 + c8 * 8 + 4);
      w2[j][0] = (f32x2){wa.x, wa.y}; w2[j][1] = (f32x2){wa.z, wa.w}; w2[j][2] = (f32x2){wb.x, wb.y}; w2[j][3] = (f32x2){wb.z, wb.w}; }
    f32x2 a2[2][4];
#pragma unroll
    for (int k = 0; k < 4; ++k) { a2[0][k] = (f32x2){0.f, 0.f}; a2[1][k] = (f32x2){0.f, 0.f}; }
#pragma unroll
    for (int rr = 0; rr < 5; ++rr) {
      const u32x4 xw = *(const u32x4*)(raw + (row + rr) * 392 + part * 128 + c8 * 8);
      f32x2 x2[4]; x2[0] = (f32x2){bflo(xw.x), bfhi(xw.x)}; x2[1] = (f32x2){bflo(xw.y), bfhi(xw.y)}; x2[2] = (f32x2){bflo(xw.z), bfhi(xw.z)}; x2[3] = (f32x2){bflo(xw.w), bfhi(xw.w)};
#pragma unroll
      for (int q = 0; q < 2; ++q) { const int j = rr - q; if (j >= 0 && j < 4) {
#pragma unroll
        for (int k = 0; k < 4; ++k) a2[q][k] = x2[k] * w2[j][k] + a2[q][k]; } }
    }
#pragma unroll
    for (int q = 0; q < 2; ++q) {
      f32x2 s2 = {0.f, 0.f};
#pragma unroll
      for (int k = 0; k < 4; ++k) {
        const f32x2 t = a2[q][k] * (-1.4426950408889634f);
        f32x2 d; d.x = __builtin_amdgcn_exp2f(t.x); d.y = __builtin_amdgcn_exp2f(t.y); d = d + 1.0f;
        f32x2 r; r.x = __builtin_amdgcn_rcpf(d.x); r.y = __builtin_amdgcn_rcpf(d.y);
        a2[q][k] = a2[q][k] * r; s2 = a2[q][k] * a2[q][k] + s2;
      }
      float ss = s2.x + s2.y;
      ss += __shfl_xor(ss, 1); ss += __shfl_xor(ss, 2); ss += __shfl_xor(ss, 4); ss += __shfl_xor(ss, 8);
      if (part < 2) { const float sc = rsqrtf(ss + EPS) * (part == 0 ? 0.08838834764831845f : 1.f);
#pragma unroll
        for (int k = 0; k < 4; ++k) a2[q][k] = a2[q][k] * sc; }
      bf16_t* dstl = part == 0 ? qh : (part == 1 ? kh : vh);
      { u32x4 o; o.x = pk2(a2[q][0].x, a2[q][0].y); o.y = pk2(a2[q][1].x, a2[q][1].y); o.z = pk2(a2[q][2].x, a2[q][2].y); o.w = pk2(a2[q][3].x, a2[q][3].y);
        *(u32x4*)(dstl + (row + q) * 136 + c8 * 8) = o; }
      if (part == 0) { const float eg = __expf(gcs[row + q]);
#pragma unroll
        for (int k = 0; k < 4; ++k) a2[q][k] = a2[q][k] * eg;
        u32x4 o; o.x = pk2(a2[q][0].x, a2[q][0].y); o.y = pk2(a2[q][1].x, a2[q][1].y); o.z = pk2(a2[q][2].x, a2[q][2].y); o.w = pk2(a2[q][3].x, a2[q][3].y);
        *(u32x4*)(p.QKV + (size_t)(T0 + row + q) * QW + h * 128 + c8 * 8) = o; }
    }
  }
  if (n == 31) {
    for (int u = tid; u < 3 * 384; u += 512) { const int j = u / 384, cc = u % 384, part = cc >> 7, col = cc & 127;
      p.out[OFF_NCQ_P + ((size_t)b * 3 + j) * QW + part * 1024 + h * 128 + col] = bf2f(raw[(64 + j) * 392 + cc]); }
  }
  lds_barrier();
  {
    const int fr = lane & 15, fq = lane >> 4, wq = wid & 3; const bool isq = wid >= 4;
    const bf16_t* Y = isq ? qh : kh;
#pragma unroll 1
    for (int bidx = wq; bidx < 10; bidx += 4) {
      const int ib = bidx >= 6 ? 3 : (bidx >= 3 ? 2 : (bidx >= 1 ? 1 : 0)), jb = bidx - (ib * (ib + 1)) / 2;
      const int i = ib * 16 + fr; const float gi = gcs[i], bi = bet[i];
      f32x4 d = {0.f, 0.f, 0.f, 0.f};
#pragma unroll
      for (int ks = 0; ks < 4; ++ks) {
        const bf16x8 xa = *(const bf16x8*)(kh + (jb * 16 + fr) * 136 + ks * 32 + fq * 8), yb = *(const bf16x8*)(Y + (ib * 16 + fr) * 136 + ks * 32 + fq * 8);
        d = __builtin_amdgcn_mfma_f32_16x16x32_bf16(xa, yb, d, 0, 0, 0);
      }
      const int j0 = jb * 16 + fq * 4; float r[4];
#pragma unroll
      for (int jj = 0; jj < 4; ++jj) { const int j = j0 + jj; const bool keep = isq ? (i >= j) : (i > j); r[jj] = keep ? d[jj] * __expf(gi - gcs[j]) * (isq ? 1.f : bi) : 0.f; }
      if (isq) { u32x2 w; w.x = pk2(r[0], r[1]); w.y = pk2(r[2], r[3]); *(u32x2*)(p.AQK + (size_t)ci * 4096 + i * 64 + j0) = w; }
      else {
        *(f32x4*)(Mm + i * 64 + j0) = (f32x4){r[0], r[1], r[2], r[3]};
        if (ib >= 2 && jb < 2) { u32x2 w; w.x = pk2(-r[0], -r[1]); w.y = pk2(-r[2], -r[3]); *(u32x2*)(M10n + (i - 32) * 40 + j0) = w; }
      }
    }
    if (isq) {
      for (int u = wq; u < 6; u += 4) { const int ib = u < 3 ? 0 : (u < 5 ? 1 : 2), jb = u < 3 ? u + 1 : (u < 5 ? u - 1 : 3);
        *(u32x2*)(p.AQK + (size_t)ci * 4096 + (ib * 16 + fr) * 64 + jb * 16 + fq * 4) = (u32x2){0u, 0u}; }
    }
  }
  lds_barrier();
  if (wid == 0) {
    const int blk = lane >> 5, c = lane & 31; const float* Mb = Mm + (blk * 32) * 64 + blk * 32;
    float X[32];
    f32x4 mb[2][8];
#pragma unroll
    for (int r = 0; r < 32; ++r) {
      if (r + 1 < 32) {
#pragma unroll
        for (int j4 = 0; j4 < (r + 4) / 4; ++j4) mb[(r + 1) & 1][j4] = *(const f32x4*)(Mb + (r + 1) * 64 + j4 * 4);
      }
      float s0 = (r == c) ? 1.f : 0.f, s1 = 0.f;
#pragma unroll
      for (int j4 = 0; j4 < (r + 3) / 4; ++j4) {
        const f32x4 m = mb[r & 1][j4];
        if (j4 * 4 + 0 < r) s0 -= m.x * X[j4 * 4 + 0];
        if (j4 * 4 + 1 < r) s1 -= m.y * X[j4 * 4 + 1];
        if (j4 * 4 + 2 < r) s0 -= m.z * X[j4 * 4 + 2];
        if (j4 * 4 + 3 < r) s1 -= m.w * X[j4 * 4 + 3];
      }
      X[r] = s0 + s1;
    }
#pragma unroll
    for (int r = 0; r < 32; ++r) Tb[(blk * 32 + r) * 40 + c] = (bf16_t)(pk2(X[r], 0.f) & 0xffffu);
  } else {
    for (int u = tid - 64; u < 1024; u += 448) {
      const int i8 = u & 7, d = u >> 3; float f[8];
#pragma unroll
      for (int e = 0; e < 8; ++e) { const int i = i8 * 8 + e; f[e] = bf2f(kh[i * 136 + d]) * __expf(glast - gcs[i]); }
      *(u32x4*)(p.QKV + (size_t)(T0 + (d >> 1)) * QW + 1024 + h * 128 + (d & 1) * 64 + i8 * 8) = pack8(f);
    }
    if (tid == 64) p.DL[ci] = __expf(glast);
  }
  lds_barrier();
  {
    const int l32 = lane & 31, lh = lane >> 5; const bool isV = wid >= 4;
    const bf16_t* srcl = (isV ? vh : kh) + (wid & 3) * 32 + l32; const float* rs = isV ? bet : rsk;
    bf16x8 r0[2];
#pragma unroll
    for (int s = 0; s < 2; ++s) { float f[8];
#pragma unroll
      for (int e = 0; e < 8; ++e) { const int k = 16 * s + 8 * lh + e; f[e] = bf2f(srcl[k * 136]) * rs[k]; }
      r0[s] = __builtin_bit_cast(bf16x8, pack8(f)); }
    f32x16 x0 = {};
#pragma unroll
    for (int s = 0; s < 2; ++s) x0 = __builtin_amdgcn_mfma_f32_32x32x16_bf16(*(const bf16x8*)(Tb + l32 * 40 + 16 * s + 8 * lh), r0[s], x0, 0, 0, 0);
    f32x16 y1;
#pragma unroll
    for (int r = 0; r < 16; ++r) { const int k = 32 + crow(r, lh); y1[r] = bf2f(srcl[k * 136]) * rs[k]; }
#pragma unroll
    for (int s = 0; s < 2; ++s) y1 = __builtin_amdgcn_mfma_f32_32x32x16_bf16(ld_permk(M10n + l32 * 40, s, lh), packfrag(x0, s), y1, 0, 0, 0);
    f32x16 x1 = {};
#pragma unroll
    for (int s = 0; s < 2; ++s) x1 = __builtin_amdgcn_mfma_f32_32x32x16_bf16(ld_permk(Tb + (32 + l32) * 40, s, lh), packfrag(y1, s), x1, 0, 0, 0);
    const int col = (wid & 3) * 32 + l32;
    if (!isV) {
      bf16_t* wp = p.UW + (size_t)ci * 8192 + col;
#pragma unroll
      for (int r = 0; r < 16; ++r) { const int i = crow(r, lh); wp[i * 128] = (bf16_t)(pk2(-x0[r], 0.f) & 0xffffu); wp[(32 + i) * 128] = (bf16_t)(pk2(-x1[r], 0.f) & 0xffffu); }
    } else {
      bf16_t* up = p.QKV + (size_t)(T0 + (col >> 1)) * QW + 2048 + h * 128 + (col & 1) * 64;
#pragma unroll
      for (int q = 0; q < 4; ++q) {
        u32x2 w0, w1; w0.x = pk2(x0[q * 4], x0[q * 4 + 1]); w0.y = pk2(x0[q * 4 + 2], x0[q * 4 + 3]); w1.x = pk2(x1[q * 4], x1[q * 4 + 1]); w1.y = pk2(x1[q * 4 + 2], x1[q * 4 + 3]);
        *(u32x2*)(up + q * 8 + lh * 4) = w0; *(u32x2*)(up + 32 + q * 8 + lh * 4) = w1;
      }
    }
  }
  lds_barrier();
}

__device__ void phase2(const Params& p) {
  const int G = gridDim.x;
  {
    extern __shared__ __attribute__((aligned(16))) unsigned char smem[];
    float* cw = (float*)(smem + 129792);
    const int tid0 = launder(threadIdx.x);
    int cur_h = -1; u32x4 pre[7];
    int task = blockIdx.x;
#pragma unroll
    for (int k = 0; k < 7; ++k) { const int u = k * 512 + tid0; pre[k] = (u32x4){0u, 0u, 0u, 0u}; if (task < 2048 && u < 67 * 48) pre[k] = raw_unit_load(p, task >> 3, task & 7, u); }
    float pg = 0.f, pb = 0.f;
    if (task < 2048 && tid0 < 64) { pg = p.BG[(size_t)((task >> 3) * 64 + tid0) * 16 + 8 + (task & 7)]; pb = p.BG[(size_t)((task >> 3) * 64 + tid0) * 16 + (task & 7)]; }
    for (; task < 2048; task += G) {
      const int h = task & 7;
      if (h != cur_h) {
        lds_barrier();
        for (int u = tid0; u < 3 * 4 * 128; u += 512) { const int part = u / 512, j = (u >> 7) & 3, col = u & 127; cw[u] = p.cbw[(size_t)j * QW + part * 1024 + h * 128 + col]; }
        cur_h = h;
      }
      const int nt = task + G;
      chunk_task(p, task >> 3, h, pre, pg, pb, nt >> 3, nt & 7, nt < 2048);
    }
  }
  const int tid = launder(threadIdx.x);
  {
    const int c8 = (tid & 127) * 8;
    float w0[8], w1[8], w2[8];
#pragma unroll
    for (int e = 0; e < 8; ++e) { w0[e] = p.caw[c8 + e]; w1[e] = p.caw[DM + c8 + e]; w2[e] = p.caw[2 * DM + c8 + e]; }
#pragma unroll 1
    for (int grp = blockIdx.x * 4 + (tid >> 7); grp < NT / 8; grp += G * 4) {
      const int r0 = grp * 8;
      u32x4 pw[10], gw[8];
#pragma unroll
      for (int k = 0; k < 10; ++k) { const int r = r0 - 2 + k; pw[k] = (u32x4){0u, 0u, 0u, 0u}; if (r >= 0) pw[k] = *(const u32x4*)(p.P + (size_t)r * DM + c8); }
#pragma unroll
      for (int k = 0; k < 8; ++k) gw[k] = *(const u32x4*)(p.GATE + (size_t)(r0 + k) * DM + c8);
#pragma unroll
      for (int k = 0; k < 8; ++k) {
        const int r = r0 + k;
        float cur[8], p1[8], p2[8], g[8];
        unpack8(pw[k + 2], cur); unpack8(pw[k + 1], p1); unpack8(pw[k], p2); unpack8(gw[k], g);
        if (r < NTP) {
          const int t = r & 2047;
          if (t < 1) { for (int e = 0; e < 8; ++e) p1[e] = 0.f; }
          if (t < 2) { for (int e = 0; e < 8; ++e) p2[e] = 0.f; }
          if (t >= 2046) { float* o = p.out + OFF_NCA_P + ((size_t)(r >> 11) * 2 + (t - 2046)) * DM + c8; *(f32x4*)o = (f32x4){cur[0], cur[1], cur[2], cur[3]}; *(f32x4*)(o + 4) = (f32x4){cur[4], cur[5], cur[6], cur[7]}; }
        } else {
          const int bs = (r - NTP) >> 2, t = (r - NTP) & 3;
          const float* past = p.sca + (size_t)bs * 2 * DM + c8;
          if (t < 1) { for (int e = 0; e < 8; ++e) p1[e] = past[DM + e]; }
          if (t < 2) { for (int e = 0; e < 8; ++e) p2[e] = past[(t == 1 ? DM : 0) + e]; }
          if (t >= 2) { float* o = p.out + OFF_NCA_S + ((size_t)bs * 2 + (t - 2)) * DM + c8; *(f32x4*)o = (f32x4){cur[0], cur[1], cur[2], cur[3]}; *(f32x4*)(o + 4) = (f32x4){cur[4], cur[5], cur[6], cur[7]}; }
        }
        float o8[8];
#pragma unroll
        for (int e = 0; e < 8; ++e) o8[e] = g[e] * (w0[e] * p2[e] + w1[e] * p1[e] + w2[e] * cur[e]);
        *(u32x4*)(p.GATE + (size_t)r * DM + c8) = pack8(o8);
      }
    }
  }
}

DI void cvt16(f32x16& a, int q, u32x2 w) { a[q * 4 + 0] = bflo(w.x); a[q * 4 + 1] = bfhi(w.x); a[q * 4 + 2] = bflo(w.y); a[q * 4 + 3] = bfhi(w.y); }
__device__ __forceinline__ void scan_seq(const Params& p, int seq) {
  extern __shared__ __attribute__((aligned(16))) unsigned char smem[];
  bf16_t* A1 = (bf16_t*)smem;
  bf16_t* AQ = (bf16_t*)(smem + 34816);
  bf16_t* KT = (bf16_t*)(smem + 44032);
  bf16_t* ST = (bf16_t*)(smem + 62464);
  bf16_t* UT = (bf16_t*)(smem + 97280);
  float* OS = (float*)(smem + 115712);
  const int tid = launder(threadIdx.x), wid = tid >> 6, lane = tid & 63, vb = wid & 3, hw = wid >> 2, l32 = lane & 31, lh = lane >> 5;
  const int b = seq >> 3, h = seq & 7;
  f32x16 S0 = {}, S1 = {};
  for (int i = tid; i < 128 * 136 / 8; i += 512) ((u32x4*)ST)[i] = (u32x4){0u, 0u, 0u, 0u};
  const int v = vb * 32 + l32;
  u32x4 pA[4], pQ, pK[2]; u32x2 pU[8]; float pdl;
  float onw16[16];
  { const int seg = tid & 7;
#pragma unroll
    for (int e = 0; e < 16; ++e) onw16[e] = p.onw[seg * 16 + e]; }
#define SCAN_SRC_A(nn, it) ({ const int ci_ = (b * 32 + (nn)) * 8 + h, T0_ = (b * 32 + (nn)) * 64; const int u_ = (it) * 512 + tid, r_ = u_ >> 4, c_ = (u_ & 15) * 8; \
    (const u32x4*)(r_ < 64 ? p.UW + ((size_t)ci_ * 64 + r_) * 128 + c_ : p.QKV + (size_t)(T0_ + r_ - 64) * QW + h * 128 + c_); })
#define SCAN_LOAD_A(nn) do { _Pragma("unroll") for (int it = 0; it < 4; ++it) pA[it] = *SCAN_SRC_A(nn, it); } while (0)
#define SCAN_LOAD_QK(nn) do { const int ci_ = (b * 32 + (nn)) * 8 + h, T0_ = (b * 32 + (nn)) * 64; \
    { const int r = tid >> 3, c = (tid & 7) * 8; pQ = *(const u32x4*)(p.AQK + (size_t)ci_ * 4096 + r * 64 + c); } \
    _Pragma("unroll") for (int it = 0; it < 2; ++it) { const int u = it * 512 + tid, d = u >> 3, c = (u & 7) * 8; \
      pK[it] = *(const u32x4*)(p.QKV + (size_t)(T0_ + (d >> 1)) * QW + 1024 + h * 128 + (d & 1) * 64 + c); } } while (0)
#define SCAN_LOAD_U(nn) do { const int ci_ = (b * 32 + (nn)) * 8 + h, T0_ = (b * 32 + (nn)) * 64; \
    if (hw == 0) { const bf16_t* base_ = p.QKV + (size_t)(T0_ + (v >> 1)) * QW + 2048 + h * 128 + (v & 1) * 64; \
      _Pragma("unroll") for (int q = 0; q < 4; ++q) { pU[q] = *(const u32x2*)(base_ + q * 8 + lh * 4); pU[4 + q] = *(const u32x2*)(base_ + 32 + q * 8 + lh * 4); } } \
    pdl = p.DL[ci_]; } while (0)
#define SCAN_FILL_A() do { _Pragma("unroll") for (int it = 0; it < 4; ++it) { const int u = it * 512 + tid, r = u >> 4, c = (u & 15) * 8; *(u32x4*)(A1 + r * 136 + c) = pA[it]; } } while (0)
#define SCAN_FILL_QK() do { { const int r = tid >> 3, c = (tid & 7) * 8; *(u32x4*)(AQ + r * 72 + c) = pQ; } \
    _Pragma("unroll") for (int it = 0; it < 2; ++it) { const int u = it * 512 + tid, d = u >> 3, c = (u & 7) * 8; *(u32x4*)(KT + d * 72 + c) = pK[it]; } } while (0)
  SCAN_LOAD_A(0); SCAN_LOAD_QK(0); SCAN_LOAD_U(0);
  SCAN_FILL_A(); SCAN_FILL_QK();
  SCAN_LOAD_A(1); SCAN_LOAD_QK(1);
  lds_barrier();
#pragma unroll 1
  for (int n = 0; n < 32; ++n) {
    const int cgi = b * 32 + n, T0 = cgi * 64;
    f32x16 a0 = {}, a1 = {};
    if (hw == 0) {
#pragma unroll
      for (int q = 0; q < 4; ++q) { cvt16(a0, q, pU[q]); cvt16(a1, q, pU[4 + q]); }
    }
    const float dl = pdl;
    if (n + 1 < 32) SCAN_LOAD_U(n + 1);
    u32x4 zz0, zz1;
    { const int i = tid >> 3, seg = tid & 7; const size_t tok = (size_t)T0 + i; zz0 = *(const u32x4*)(p.SBZ + tok * DM + h * 128 + seg * 16); zz1 = *(const u32x4*)(p.SBZ + tok * DM + h * 128 + seg * 16 + 8); }
#pragma unroll
    for (int ks = 0; ks < 8; ++ks) {
      const bf16x8 bfr = *(const bf16x8*)(ST + v * 136 + ks * 16 + lh * 8);
      const bf16x8 x0 = *(const bf16x8*)(A1 + (hw * 64 + l32) * 136 + ks * 16 + lh * 8), x1 = *(const bf16x8*)(A1 + (hw * 64 + 32 + l32) * 136 + ks * 16 + lh * 8);
      a0 = __builtin_amdgcn_mfma_f32_32x32x16_bf16(x0, bfr, a0, 0, 0, 0);
      a1 = __builtin_amdgcn_mfma_f32_32x32x16_bf16(x1, bfr, a1, 0, 0, 0);
    }
    if (hw == 0) {
#pragma unroll
      for (int q = 0; q < 4; ++q) {
        u32x2 w0, w1; w0.x = pk2(a0[q * 4], a0[q * 4 + 1]); w0.y = pk2(a0[q * 4 + 2], a0[q * 4 + 3]); w1.x = pk2(a1[q * 4], a1[q * 4 + 1]); w1.y = pk2(a1[q * 4 + 2], a1[q * 4 + 3]);
        *(u32x2*)(UT + v * 72 + q * 8 + lh * 4) = w0; *(u32x2*)(UT + v * 72 + 32 + q * 8 + lh * 4) = w1;
      }
    }
    lds_barrier();
    S0 *= dl; S1 *= dl;
#pragma unroll
    for (int ks = 0; ks < 4; ++ks) {
      const bf16x8 bfr = *(const bf16x8*)(UT + v * 72 + ks * 16 + lh * 8);
      if (hw == 1) {
        const bf16x8 x0 = *(const bf16x8*)(AQ + l32 * 72 + ks * 16 + lh * 8), x1 = *(const bf16x8*)(AQ + (32 + l32) * 72 + ks * 16 + lh * 8);
        a0 = __builtin_amdgcn_mfma_f32_32x32x16_bf16(x0, bfr, a0, 0, 0, 0);
        a1 = __builtin_amdgcn_mfma_f32_32x32x16_bf16(x1, bfr, a1, 0, 0, 0);
      }
      const bf16x8 k0 = *(const bf16x8*)(KT + ((2 * hw) * 32 + l32) * 72 + ks * 16 + lh * 8), k1 = *(const bf16x8*)(KT + ((2 * hw + 1) * 32 + l32) * 72 + ks * 16 + lh * 8);
      S0 = __builtin_amdgcn_mfma_f32_32x32x16_bf16(k0, bfr, S0, 0, 0, 0);
      S1 = __builtin_amdgcn_mfma_f32_32x32x16_bf16(k1, bfr, S1, 0, 0, 0);
    }
    if (n + 1 < 32) { SCAN_FILL_A(); if (n + 2 < 32) SCAN_LOAD_A(n + 2); }
#pragma unroll
    for (int q = 0; q < 4; ++q) {
      u32x2 w0, w1; w0.x = pk2(S0[q * 4], S0[q * 4 + 1]); w0.y = pk2(S0[q * 4 + 2], S0[q * 4 + 3]); w1.x = pk2(S1[q * 4], S1[q * 4 + 1]); w1.y = pk2(S1[q * 4 + 2], S1[q * 4 + 3]);
      *(u32x2*)(ST + v * 136 + (2 * hw) * 32 + q * 8 + lh * 4) = w0; *(u32x2*)(ST + v * 136 + (2 * hw + 1) * 32 + q * 8 + lh * 4) = w1;
    }
    if (hw == 1) {
#pragma unroll
      for (int r = 0; r < 16; ++r) { const int i = (r & 3) + 8 * (r >> 2) + 4 * lh; OS[i * 132 + v] = a0[r]; OS[(32 + i) * 132 + v] = a1[r]; }
    }
    lds_barrier();
    {
      const int i = tid >> 3, seg = tid & 7; const float* orow = OS + i * 132 + seg * 16; float o[16]; float ss = 0.f;
#pragma unroll
      for (int e4 = 0; e4 < 4; ++e4) { const f32x4 t = *(const f32x4*)(orow + e4 * 4); o[e4 * 4] = t.x; o[e4 * 4 + 1] = t.y; o[e4 * 4 + 2] = t.z; o[e4 * 4 + 3] = t.w; ss += (t.x * t.x + t.y * t.y) + (t.z * t.z + t.w * t.w); }
      ss += __shfl_xor(ss, 1); ss += __shfl_xor(ss, 2); ss += __shfl_xor(ss, 4);
      const float rstd = rsqrtf(ss * (1.f / 128.f) + EPS);
      const size_t tok = (size_t)T0 + i; float z[16];
      unpack8(zz0, z); unpack8(zz1, z + 8);
#pragma unroll
      for (int e = 0; e < 16; ++e) o[e] = o[e] * rstd * onw16[e] * z[e];
      bf16_t* dst = p.QKV + tok * QW + 2048 + h * 128 + seg * 16;
      *(u32x4*)dst = pack8(o); *(u32x4*)(dst + 8) = pack8(o + 8);
    }
    if (n + 1 < 32) { SCAN_FILL_QK(); if (n + 2 < 32) SCAN_LOAD_QK(n + 2); }
  }
  float* sp = p.out + OFF_ND_P + (size_t)(b * 8 + h) * 16384;
#pragma unroll
  for (int r = 0; r < 16; ++r) { const int dd = (r & 3) + 8 * (r >> 2) + 4 * lh; sp[(size_t)((2 * hw) * 32 + dd) * 128 + v] = S0[r]; sp[(size_t)((2 * hw + 1) * 32 + dd) * 128 + v] = S1[r]; }
  lds_barrier();
}

__device__ __forceinline__ void sample_seq(const Params& p, int s, f32x4 (&Sn)[8], int s_next) {
  extern __shared__ __attribute__((aligned(16))) unsigned char smem[];
  float* qs = (float*)smem;
  float* ks = qs + 512;
  float* vs = ks + 512;
  float* os = vs + 512;
  float* red = os + 512;
  const int tid = launder(threadIdx.x), bs = s >> 3, h = s & 7;
  const size_t Tb = (size_t)NTP + bs * 4;
  const int kg = tid >> 5, vg = tid & 31;
  f32x4 S[8];
#pragma unroll
  for (int kk = 0; kk < 8; ++kk) S[kk] = Sn[kk];
  if (s_next >= 0) { const float* sn = p.sd + ((size_t)s_next * 128 + kg * 8) * 128 + vg * 4;
#pragma unroll
    for (int kk = 0; kk < 8; ++kk) Sn[kk] = ldnt4(sn + kk * 128); }
  float ga[4], be[4];
#pragma unroll
  for (int t = 0; t < 4; ++t) { ga[t] = p.BG[(Tb + t) * 16 + 8 + h]; be[t] = p.BG[(Tb + t) * 16 + h]; }
  u32x4 zt = {0u, 0u, 0u, 0u}; float ow[8];
  { const int t = (tid >> 4) & 3, seg = tid & 15; zt = *(const u32x4*)(p.SBZ + (Tb + t) * DM + h * 128 + seg * 8);
#pragma unroll
    for (int e = 0; e < 8; ++e) ow[e] = p.onw[seg * 8 + e]; }
  if (tid < 192) {
    const int c8 = tid & 15, grp = tid >> 4, part = grp % 3, t = grp / 3;
    const int colw = part * 1024 + h * 128 + c8 * 8;
    float a[8] = {0.f, 0.f, 0.f, 0.f, 0.f, 0.f, 0.f, 0.f};
#pragma unroll
    for (int j = 0; j < 4; ++j) {
      const int e_ = t + j; float x[8];
      if (e_ < 3) { const float* ps = p.scq + ((size_t)bs * 3 + e_) * QW + colw; for (int e = 0; e < 8; ++e) x[e] = ps[e]; }
      else unpack8(*(const u32x4*)(p.QKV + (Tb + e_ - 3) * QW + colw), x);
      const float* w = p.cbw + j * QW + colw;
#pragma unroll
      for (int e = 0; e < 8; ++e) a[e] += x[e] * w[e];
      if (j == 3 && t >= 1) { float* o = p.out + OFF_NCQ_S + ((size_t)bs * 3 + (t - 1)) * QW + colw; for (int e = 0; e < 8; ++e) o[e] = x[e]; }
    }
    float ss = 0.f;
#pragma unroll
    for (int e = 0; e < 8; ++e) { a[e] = siluf(a[e]); ss += a[e] * a[e]; }
    ss += __shfl_xor(ss, 1); ss += __shfl_xor(ss, 2); ss += __shfl_xor(ss, 4); ss += __shfl_xor(ss, 8);
    if (part < 2) { const float sc = rsqrtf(ss + EPS) * (part == 0 ? 0.08838834764831845f : 1.f); for (int e = 0; e < 8; ++e) a[e] *= sc; }
    float* d = (part == 0 ? qs : (part == 1 ? ks : vs)) + t * 128 + c8 * 8;
#pragma unroll
    for (int e = 0; e < 8; ++e) d[e] = a[e];
  }
  lds_barrier();
#pragma unroll
  for (int t = 0; t < 4; ++t) {
    const float a = __expf(ga[t]), beta = be[t];
    f32x4 part = {0.f, 0.f, 0.f, 0.f};
#pragma unroll
    for (int kk = 0; kk < 8; ++kk) { S[kk] *= a; part += S[kk] * ks[t * 128 + kg * 8 + kk]; }
    *(f32x4*)(red + kg * 128 + vg * 4) = part;
    lds_barrier();
    f32x4 r = {0.f, 0.f, 0.f, 0.f};
#pragma unroll
    for (int g2 = 0; g2 < 16; ++g2) r += *(const f32x4*)(red + g2 * 128 + vg * 4);
    const f32x4 dlt = (*(const f32x4*)(vs + t * 128 + vg * 4) - r) * beta;
    f32x4 po = {0.f, 0.f, 0.f, 0.f};
#pragma unroll
    for (int kk = 0; kk < 8; ++kk) { S[kk] += dlt * ks[t * 128 + kg * 8 + kk]; po += S[kk] * qs[t * 128 + kg * 8 + kk]; }
    lds_barrier();
    *(f32x4*)(red + kg * 128 + vg * 4) = po;
    lds_barrier();
    if (tid < 128) { float o = 0.f; for (int g2 = 0; g2 < 16; ++g2) o += red[g2 * 128 + tid]; os[t * 128 + tid] = o; }
    lds_barrier();
  }
  float* so = p.out + OFF_ND_S + ((size_t)s * 128 + kg * 8) * 128 + vg * 4;
#pragma unroll
  for (int kk = 0; kk < 8; ++kk) stnt4(so + kk * 128, S[kk]);
  if (tid < 64) {
    const int t = tid >> 4, seg = tid & 15; float o[8]; float ss = 0.f;
#pragma unroll
    for (int e = 0; e < 8; ++e) { o[e] = os[t * 128 + seg * 8 + e]; ss += o[e] * o[e]; }
    ss += __shfl_xor(ss, 1); ss += __shfl_xor(ss, 2); ss += __shfl_xor(ss, 4); ss += __shfl_xor(ss, 8);
    const float rstd = rsqrtf(ss * (1.f / 128.f) + EPS); float z[8];
    unpack8(zt, z);
#pragma unroll
    for (int e = 0; e < 8; ++e) o[e] = o[e] * rstd * ow[e] * z[e];
    *(u32x4*)(p.QKV + (Tb + t) * QW + 2048 + h * 128 + seg * 8) = pack8(o);
  }
  lds_barrier();
}

__device__ void phase3(const Params& p) {
  const int G = gridDim.x, bid = blockIdx.x;
  const bool split = G > 64;
#ifndef P3_NO_SCAN
  if (!split || bid < 64) for (int seq = bid; seq < 64; seq += (split ? 64 : G)) scan_seq(p, seq);
#endif
  if (!split || bid >= 64) {
    const int wk = split ? bid - 64 : bid, NW = split ? G - 64 : G;
#ifndef P3_NO_GEMM
    { extern __shared__ __attribute__((aligned(16))) unsigned char smem[];
      Sched S; S.init_strided(wk, NW, 264); gemm_phase<1>(p, (LAS unsigned char*)smem, p.GATE, DM, p.WOA, S); }
#endif
#ifndef P3_NO_SAMPLE
    {
      const int n2 = (264 > NW && 264 < 2 * NW) ? 264 - NW : 0, n1 = NW - n2;
      const int s_first = wk < n2 ? 2 * wk : 2 * n2 + (wk - n2), s_step = wk < n2 ? 1 : n1, s_end = wk < n2 ? 2 * wk + 2 : 1024;
      f32x4 Sn[8];
      if (s_first < s_end) { const int tid_ = launder(threadIdx.x); const float* sn = p.sd + ((size_t)s_first * 128 + (tid_ >> 5) * 8) * 128 + (tid_ & 31) * 4;
#pragma unroll
        for (int kk = 0; kk < 8; ++kk) Sn[kk] = ldnt4(sn + kk * 128); }
      for (int s = s_first; s < s_end; s += s_step) sample_seq(p, s, Sn, s + s_step < s_end ? s + s_step : -1);
    }
#endif
  }
}

__device__ void phase4(const Params& p) {
  extern __shared__ __attribute__((aligned(16))) unsigned char smem[];
  Sched S; S.init_strided(blockIdx.x, gridDim.x, 256); gemm_phase<2>(p, (LAS unsigned char*)smem, p.QKV + 2048, QW, p.WOB, S);
  gemm_tail<2>(p, p.QKV + 2048, QW, p.WOB, 256, 8);
}
__device__ void phase5(const Params& p) {
  extern __shared__ __attribute__((aligned(16))) unsigned char smem[];
  Sched S; S.init_strided(blockIdx.x, gridDim.x, 256);
  gemm_phase<4>(p, (LAS unsigned char*)smem, p.UW, DM, p.WO, S);
  gemm_tail<3>(p, p.UW, DM, p.WO, 256, 8);
}
__device__ void phase6(const Params& p) {
  const int tid = launder(threadIdx.x), wid = tid >> 6, lane = tid & 63, G = gridDim.x;
  f32x4 w[4];
#pragma unroll
  for (int i = 0; i < 4; ++i) w[i] = *(const f32x4*)(p.fnw + i * 256 + lane * 4);
  const int row_lo = (G == 256) ? NTP : 0;
#pragma unroll 1
  for (int row = row_lo + (blockIdx.x * 8 + wid) * 4; row < NT; row += G * 8 * 4) {
    f32x4 v[4][4];
#pragma unroll
    for (int q = 0; q < 4; ++q)
#pragma unroll
      for (int i = 0; i < 4; ++i) v[q][i] = *(const f32x4*)(p.out + (size_t)(row + q) * DM + i * 256 + lane * 4);
#pragma unroll
    for (int q = 0; q < 4; ++q) {
      float ss = 0.f;
#pragma unroll
      for (int i = 0; i < 4; ++i) ss += (v[q][i].x * v[q][i].x + v[q][i].y * v[q][i].y) + (v[q][i].z * v[q][i].z + v[q][i].w * v[q][i].w);
      ss = wave_sum(ss);
      const float rstd = rsqrtf(ss * (1.f / DM) + EPS);
#pragma unroll
      for (int i = 0; i < 4; ++i) *(f32x4*)(p.out + (size_t)(row + q) * DM + i * 256 + lane * 4) = v[q][i] * rstd * w[i];
    }
  }
}

#define XB_TMO      128
#define XB_XCNT(j)  (256  + 64 * (j))
#define XB_XSUB(j)  (1280 + 64 * (j))
#define XB_XGEN(j)  (2304 + 64 * (j))
#define XB_TOP      3328
#define XB_TOPGEN   3392
#define XCD_BAR_WORDS 3456
#define XB_SPIN_CAP (1u << 18)
DI unsigned xb_ld(unsigned* p) { return __hip_atomic_load(p, __ATOMIC_RELAXED, __HIP_MEMORY_SCOPE_AGENT); }
DI unsigned xb_add(unsigned* p, unsigned v) { return __hip_atomic_fetch_add(p, v, __ATOMIC_RELAXED, __HIP_MEMORY_SCOPE_AGENT); }
DI unsigned xb_xcc_id() { return (unsigned)__builtin_amdgcn_s_getreg((3 << 11) | 20) & 0xFu; }
#define XB_SPIN(cond, bar) do { unsigned _sp = 0; while (cond) { __builtin_amdgcn_s_sleep(1); \
    if ((++_sp & 255u) == 0u) { if (xb_ld(&(bar)[XB_TMO])) break; if (_sp > XB_SPIN_CAP) { atomicAdd(&(bar)[XB_TMO], 1u); break; } } } } while (0)
struct XcdBarrier { unsigned* bar; unsigned x; volatile LAS unsigned* st; };
DI XcdBarrier xcd_barrier_post(unsigned* bar, volatile LAS unsigned* st) {
  XcdBarrier b; b.bar = bar; b.x = xb_xcc_id(); b.st = st;
  if (threadIdx.x == 0) (void)xb_add(&bar[XB_XCNT(b.x)], 1u);
  return b;
}
DI void xcd_barrier_complete(unsigned* bar, unsigned x, unsigned& nloc, unsigned& nx) {
  const unsigned G = gridDim.x * gridDim.y * gridDim.z;
  unsigned sum, cnt, mine, sp = 0u;
  for (;;) {
    sum = 0u; cnt = 0u; mine = 0u;
#pragma unroll
    for (unsigned j = 0; j < 16; ++j) { const unsigned c = xb_ld(&bar[XB_XCNT(j)]); sum += c; cnt += (c > 0u) ? 1u : 0u; mine = (j == x) ? c : mine; }
    if (sum == G) break;
    __builtin_amdgcn_s_sleep(1);
    if ((++sp & 255u) == 0u) { if (xb_ld(&bar[XB_TMO])) break; if (sp > XB_SPIN_CAP) { atomicAdd(&bar[XB_TMO], 1u); break; } }
  }
  nloc = mine > 0u ? mine : 1u; nx = cnt > 0u ? cnt : 1u;
}
DI void xcd_barrier(const XcdBarrier& b) {
  asm volatile("s_waitcnt vmcnt(0)" ::: "memory");
  __syncthreads();
  if (threadIdx.x == 0) {
    unsigned* bar = b.bar;
    __builtin_amdgcn_s_waitcnt(0);
    unsigned nloc = b.st[0], nx = b.st[1];
    if (nloc == 0u) { xcd_barrier_complete(bar, b.x, nloc, nx); b.st[0] = nloc; b.st[1] = nx; }
    const unsigned old = xb_add(&bar[XB_XSUB(b.x)], 1u);
    const unsigned gen = old / nloc;
    if (old + 1u == (gen + 1u) * nloc) {
      __builtin_amdgcn_fence(__ATOMIC_RELEASE, "agent");
      asm volatile("s_waitcnt vmcnt(0)" ::: "memory");
      const unsigned og = xb_add(&bar[XB_TOP], 1u);
      const unsigned tg = og / nx;
      if (og + 1u == (tg + 1u) * nx) xb_add(&bar[XB_TOPGEN], 1u);
      else XB_SPIN(xb_ld(&bar[XB_TOPGEN]) == tg, bar);
      __builtin_amdgcn_fence(__ATOMIC_ACQUIRE, "agent");
      xb_add(&bar[XB_XGEN(b.x)], 1u);
      asm volatile("s_waitcnt vmcnt(0)" ::: "memory");
    } else {
      XB_SPIN(xb_ld(&bar[XB_XGEN(b.x)]) == gen, bar);
      __builtin_amdgcn_fence(__ATOMIC_ACQUIRE, "agent");
      asm volatile("s_waitcnt vmcnt(0)" ::: "memory");
    }
  }
  __syncthreads();
}

__global__ void __launch_bounds__(512, 2) mega(Params p, int ph_lo, int ph_hi) {
  cg::grid_group grid = cg::this_grid();
  const int lo = ph_lo, hi = ph_hi;
  extern __shared__ __attribute__((aligned(16))) unsigned char smem[];
  volatile LAS unsigned* st = (volatile LAS unsigned*)((LAS unsigned char*)smem + 149504);
  if (threadIdx.x < 4) st[threadIdx.x] = 0u;
  __syncthreads();
  XcdBarrier xb; xb.bar = p.bar; xb.x = 0; xb.st = st;
  if (hi - lo > 1) xb = xcd_barrier_post(p.bar, st);
  if (hi > 100) grid.sync();
#define GRID_SYNC() xcd_barrier(xb)
#define IN(k) (lo <= (k) && (k) < hi)
#define BOTH(k) (IN(k) && IN((k) + 1))
  if (IN(0)) { phase0(p); if (BOTH(0)) GRID_SYNC(); }
  if (IN(1)) { phase1(p); if (BOTH(1)) GRID_SYNC(); }
  if (IN(2)) { phase2(p); if (BOTH(2)) GRID_SYNC(); }
  if (IN(3)) { phase3(p); if (BOTH(3)) GRID_SYNC(); }
  if (IN(4)) { phase4(p); if (BOTH(4)) GRID_SYNC(); }
  if (IN(5)) { phase5(p); if (BOTH(5)) GRID_SYNC(); }
  if (IN(6)) { phase6(p); }
}

extern "C" void kernel_launch(void* const* d_in, const int* in_sizes, int n_in, void* d_out, int out_size, void* d_ws, size_t ws_size, hipStream_t stream) {
  static int grid = 0;
  if (grid == 0) {
    int dev = 0, cus = 0, per_cu = 0;
    hipGetDevice(&dev);
    hipDeviceGetAttribute(&cus, hipDeviceAttributeMultiprocessorCount, dev);
    if (hipFuncSetAttribute((const void*)mega, hipFuncAttributeMaxDynamicSharedMemorySize, LDS_BYTES) != hipSuccess) fprintf(stderr, "hipFuncSetAttribute failed\n");
    hipOccupancyMaxActiveBlocksPerMultiprocessor(&per_cu, (const void*)mega, 512, LDS_BYTES);
    if (per_cu < 1) { fprintf(stderr, "occupancy query says %d\n", per_cu); per_cu = 1; }
    (void)hipGetLastError();
    grid = cus;
  }
  Params p{};
  p.x_p = (const float*)d_in[0]; p.x_s = (const float*)d_in[1]; p.sca = (const float*)d_in[2]; p.scq = (const float*)d_in[3]; p.sd = (const float*)d_in[4];
  p.w_in = (const float*)d_in[5]; p.caw = (const float*)d_in[6]; p.cbw = (const float*)d_in[7]; p.a_log = (const float*)d_in[8]; p.dt_bias = (const float*)d_in[9];
  p.onw = (const float*)d_in[10]; p.w_oa = (const float*)d_in[11]; p.w_ob = (const float*)d_in[12]; p.w_o = (const float*)d_in[13]; p.nw = (const float*)d_in[14]; p.fnw = (const float*)d_in[15];
  p.out = (float*)d_out;
  unsigned char* ws = (unsigned char*)d_ws; size_t o = 0;
  auto take = [&](size_t bytes) { unsigned char* r = ws + o; o += (bytes + 255) & ~(size_t)255; return r; };
  p.QKV = (bf16_t*)take((size_t)NT * QW * 2);
  p.SBZ = (bf16_t*)take((size_t)NT * DM * 2);
  p.GATE = (bf16_t*)take((size_t)NT * DM * 2);
  p.UW = (bf16_t*)take((size_t)NT * DM * 2);
  p.AQK = (bf16_t*)take((size_t)2048 * 4096 * 2);
  p.WOA = (bf16_t*)take((size_t)DM * DM * 2); p.WOB = (bf16_t*)take((size_t)DM * DM * 2); p.WO = (bf16_t*)take((size_t)DM * DM * 2);
  p.WB16 = (bf16_t*)take(16 * DM * 2);
  p.BG = (float*)take((size_t)NT * 16 * 4);
  p.DL = (float*)take(2048 * 4);
  p.bar = (unsigned*)take((XCD_BAR_WORDS + 64 * 64) * 4);
  p.RS = (float*)take(64 * 4 * 256 * 4);
  if (o > ws_size) { fprintf(stderr, "workspace too small: need %zu have %zu\n", o, ws_size); return; }
  p.SGA = (bf16_t*)d_out; p.SGB = p.SGA + (size_t)NT * DM;
  unsigned char* nds = (unsigned char*)((float*)d_out + OFF_ND_S);
  p.WIN = (bf16_t*)nds; p.P = (bf16_t*)(nds + (size_t)10240 * DM * 2); p.HALO = (bf16_t*)(nds + (size_t)10240 * DM * 2 + (size_t)NT * DM * 2);
#if COOP
  if (hipMemsetAsync(p.bar, 0, (XCD_BAR_WORDS + 64 * 64) * 4, stream) != hipSuccess) fprintf(stderr, "memset of barrier words failed\n");
  int lo = 0, hi = 7; void* args[] = {&p, &lo, &hi};
  hipError_t e = hipLaunchCooperativeKernel((const void*)mega, dim3(grid), dim3(512), args, LDS_BYTES, stream);
  if (e != hipSuccess) fprintf(stderr, "cooperative launch failed: %s\n", hipGetErrorString(e));
#else
  for (int ph = 0; ph < 7; ++ph) { hipLaunchKernelGGL(mega, dim3(grid), dim3(512), LDS_BYTES, stream, p, ph, ph + 1); if (ph == DUP) hipLaunchKernelGGL(mega, dim3(grid), dim3(512), LDS_BYTES, stream, p, ph, ph + 1); }
#endif
}
```

```cpp
#include <hip/hip_runtime.h>
#include <hip/hip_cooperative_groups.h>
#include <cstdio>
#include <cstdint>
namespace cg = cooperative_groups;

#ifndef COOP
#define COOP 1
#endif
#ifndef DUP
#define DUP -1
#endif

typedef unsigned short bf16_t;
typedef short bf16x8 __attribute__((ext_vector_type(8)));
typedef float f32x4 __attribute__((ext_vector_type(4)));
typedef float f32x2 __attribute__((ext_vector_type(2)));
typedef float f32x16 __attribute__((ext_vector_type(16)));
typedef unsigned u32x4 __attribute__((ext_vector_type(4)));
typedef unsigned u32x2 __attribute__((ext_vector_type(2)));
typedef __bf16 bf16x2_t __attribute__((ext_vector_type(2)));

#define DI __device__ __forceinline__

constexpr int NT = 16896, NTP = 16384, DM = 1024, QW = 3072, NIN = 10256;
constexpr float EPS = 1e-6f;
constexpr size_t OFF_NCA_P = 17301504, OFF_NCQ_P = 17317888, OFF_ND_P = 17391616, OFF_NCA_S = 18440192, OFF_NCQ_S = 18702336, OFF_ND_S = 19881984;
constexpr int LDS_BYTES = 149504 + 16;

struct Params {
  const float *x_p, *x_s, *sca, *scq, *sd, *w_in, *caw, *cbw, *a_log, *dt_bias, *onw, *w_oa, *w_ob, *w_o, *nw, *fnw;
  float* out;
  bf16_t *QKV, *SBZ, *GATE, *UW, *AQK, *WOA, *WOB, *WO, *WB16;
  float *BG, *DL;
  bf16_t *SGA, *SGB, *WIN, *P, *HALO;
  unsigned* bar;
  float* RS;
};

DI unsigned pk2(float a, float b) { bf16x2_t v = __builtin_convertvector((f32x2){a, b}, bf16x2_t); return __builtin_bit_cast(unsigned, v); }
DI float bflo(unsigned w) { return __uint_as_float(w << 16); }
DI float bfhi(unsigned w) { return __uint_as_float(w & 0xffff0000u); }
DI float bf2f(bf16_t v) { return __uint_as_float(((unsigned)v) << 16); }
DI float siluf(float x) { return x * __builtin_amdgcn_rcpf(1.f + __expf(-x)); }
DI float sigmf(float x) { return __builtin_amdgcn_rcpf(1.f + __expf(-x)); }
DI f32x4 ldnt4(const float* q) { return __builtin_nontemporal_load((const f32x4*)q); }
DI void stnt4(float* q, f32x4 v) { __builtin_nontemporal_store(v, (f32x4*)q); }
DI float wave_sum(float v) {
#pragma unroll
  for (int o = 1; o < 64; o <<= 1) v += __shfl_xor(v, o);
  return v;
}
DI void unpack8(u32x4 w, float* f) { f[0] = bflo(w.x); f[1] = bfhi(w.x); f[2] = bflo(w.y); f[3] = bfhi(w.y); f[4] = bflo(w.z); f[5] = bfhi(w.z); f[6] = bflo(w.w); f[7] = bfhi(w.w); }
DI u32x4 pack8(const float* f) { u32x4 w; w.x = pk2(f[0], f[1]); w.y = pk2(f[2], f[3]); w.z = pk2(f[4], f[5]); w.w = pk2(f[6], f[7]); return w; }

DI int perm32(int rho) { const int n = rho >> 4, i = rho & 15; return 8 * (i >> 2) + 4 * n + (i & 3); }
DI int colmap_in(int R) {
  const int pn = R >> 8, l = R & 255, bj = l >> 7, wc = (l & 127) >> 5, rho = l & 31;
  if (pn < 16) { const int n = rho >> 4, i = rho & 15; return (bj * 2 + n) * 1024 + 64 * pn + wc * 16 + i; }
  const int base = pn < 32 ? 4096 + (pn - 16) * 256 : 8208 + (pn - 32) * 256;
  return base + bj * 128 + wc * 32 + perm32(rho);
}
DI int colmap_sq(int R) { return (R & ~31) + perm32(R & 31); }

constexpr int BM = 256, BK = 64, HALF = 128, NXCD = 8, WGM = 8, HT = HALF * BK;
DI void lds_barrier() { asm volatile("s_waitcnt lgkmcnt(0)" ::: "memory"); __builtin_amdgcn_s_barrier(); asm volatile("" ::: "memory"); }
DI int launder(int x) { asm volatile("" : "+v"(x)); return x; }
DI int lds_byte(int r, int c) { const int st = (r >> 4) * 2 + (c >> 5), rr = r & 15, cc = c & 31, ob = rr * 64 + cc * 2; return st * 1024 + (ob ^ (((ob >> 9) & 1) << 5)); }
DI void stage_rc(int b, int& R, int& C) { const int st = b / 1024, sb = b % 1024, swz = sb ^ (((sb >> 9) & 1) << 5); R = (st >> 1) * 16 + swz / 64; C = (st & 1) * 32 + (swz % 64) / 2; }

struct TileOrder {
  int nM, nN, nwg, G, c;
  DI void init(int M, int N, int G_, int c_) { nM = M / BM; nN = N / BM; nwg = nM * nN; G = G_; c = c_; }
  DI bool next(int i, int& pm, int& pn) const {
    const long L = (long)i * G + c; if (L >= nwg) return false;
    int wgid = (int)L; { const int q = nwg / NXCD, r = nwg % NXCD, xcd = wgid % NXCD, off = wgid / NXCD; wgid = (xcd < r ? xcd * (q + 1) : r * (q + 1) + (xcd - r) * q) + off; }
    const int nig = WGM * nN, gid = wgid / nig, fm = gid * WGM, gsz = (nM - fm) < WGM ? (nM - fm) : WGM;
    pm = fm + ((wgid % nig) % gsz); pn = (wgid % nig) / gsz; return true;
  }
};

#define FN_CNT(pm) (XCD_BAR_WORDS_C + 64 * (pm))
constexpr int XCD_BAR_WORDS_C = 3456;
DI void epilogue_final(const Params& p, f32x4 (&acc)[2][2][4][2], int pm, int pn, int wr, int wc, int fr, int fq, unsigned char* smem_, int tid) {
  float* PS = (float*)(smem_ + 131072);
  float* RSTD = (float*)(smem_ + 131072 + 4096);
  const int col0 = pn * BM + wc * 32 + 8 * fq;
#pragma unroll
  for (int ai = 0; ai < 2; ++ai)
#pragma unroll
    for (int m = 0; m < 4; ++m) {
      const int rl = ai * HALF + wr * 64 + m * 16 + fr; const size_t row = (size_t)pm * BM + rl;
      const float* xr = p.x_p + row * DM;
      float ss = 0.f;
#pragma unroll
      for (int bj = 0; bj < 2; ++bj) {
        const f32x4 x0 = ldnt4(xr + col0 + bj * HALF), x1 = ldnt4(xr + col0 + bj * HALF + 4);
        acc[ai][bj][m][0] += x0; acc[ai][bj][m][1] += x1;
        const f32x4 a = acc[ai][bj][m][0], b = acc[ai][bj][m][1];
        ss += (a.x * a.x + a.y * a.y) + (a.z * a.z + a.w * a.w) + (b.x * b.x + b.y * b.y) + (b.z * b.z + b.w * b.w);
      }
      ss += __shfl_xor(ss, 16); ss += __shfl_xor(ss, 32);
      if (fq == 0) PS[rl * 4 + wc] = ss;
      __builtin_amdgcn_sched_barrier(0);
    }
  lds_barrier();
  unsigned* cnt = p.bar + FN_CNT(pm);
  if (tid < 256) {
    const f32x4 s4 = *(const f32x4*)(PS + tid * 4);
    __hip_atomic_store((unsigned*)p.RS + ((size_t)(pm * 4 + pn) * 256 + tid), __float_as_uint((s4.x + s4.y) + (s4.z + s4.w)), __ATOMIC_RELAXED, __HIP_MEMORY_SCOPE_AGENT);
  }
  asm volatile("s_waitcnt vmcnt(0)" ::: "memory");
  lds_barrier();
  if (tid == 0) __hip_atomic_fetch_add(cnt, 1u, __ATOMIC_RELAXED, __HIP_MEMORY_SCOPE_AGENT);
  if (tid < 64) {
    unsigned sp = 0;
    while ((unsigned)__builtin_amdgcn_readfirstlane(__hip_atomic_load(cnt, __ATOMIC_RELAXED, __HIP_MEMORY_SCOPE_AGENT)) < 4u) { __builtin_amdgcn_s_sleep(2); if (++sp > (1u << 20)) break; }
    __builtin_amdgcn_fence(__ATOMIC_ACQUIRE, "agent");
  }
  asm volatile("s_waitcnt vmcnt(0) lgkmcnt(0)" ::: "memory");
  lds_barrier();
  if (tid < 256) {
    float tot = 0.f;
#pragma unroll
    for (int t = 0; t < 4; ++t) tot += __uint_as_float(__hip_atomic_load((unsigned*)p.RS + ((size_t)(pm * 4 + t) * 256 + tid), __ATOMIC_RELAXED, __HIP_MEMORY_SCOPE_AGENT));
    RSTD[tid] = rsqrtf(tot * (1.f / DM) + EPS);
  }
  lds_barrier();
#pragma unroll
  for (int bj = 0; bj < 2; ++bj) {
    const f32x4 fw0 = *(const f32x4*)(p.fnw + col0 + bj * HALF), fw1 = *(const f32x4*)(p.fnw + col0 + bj * HALF + 4);
#pragma unroll
    for (int ai = 0; ai < 2; ++ai)
#pragma unroll
      for (int m = 0; m < 4; ++m) {
        const int rl = ai * HALF + wr * 64 + m * 16 + fr; const size_t row = (size_t)pm * BM + rl; const float r = RSTD[rl];
        float* o = p.out + row * DM + col0 + bj * HALF;
        stnt4(o, acc[ai][bj][m][0] * r * fw0); stnt4(o + 4, acc[ai][bj][m][1] * r * fw1);
        __builtin_amdgcn_sched_barrier(0);
      }
  }
}

template <int EPI>
DI void epilogue(const Params& p, const f32x4 (&acc)[2][2][4][2], int pm, int pn, int wr, int wc, int fr, int fq) {
  const int row0 = pm * BM + wr * 64 + fr;
  if (EPI == 0) {
    if (pn < 16) {
      const int ch = pn * 64 + wc * 16 + fq * 4;
#pragma unroll
      for (int ai = 0; ai < 2; ++ai)
#pragma unroll
        for (int m = 0; m < 4; ++m) {
          const size_t row = row0 + ai * HALF + m * 16;
          const f32x4 b = acc[ai][0][m][0], c = acc[ai][0][m][1], h = acc[ai][1][m][0], z = acc[ai][1][m][1];
          u32x2 pp, gg;
          pp.x = pk2(c[0] * h[0], c[1] * h[1]); pp.y = pk2(c[2] * h[2], c[3] * h[3]);
          gg.x = pk2(siluf(z[0]) * b[0], siluf(z[1]) * b[1]); gg.y = pk2(siluf(z[2]) * b[2], siluf(z[3]) * b[3]);
          *(u32x2*)(p.P + row * DM + ch) = pp;
          *(u32x2*)(p.GATE + row * DM + ch) = gg;
        }
    } else {
      const int kind = pn < 28 ? 0 : (pn < 32 ? 1 : 2);
      bf16_t* dst; int ld, colt;
      if (kind == 0) { dst = p.QKV; ld = QW; colt = (pn - 16) * 256; }
      else if (kind == 1) { dst = p.SBZ; ld = DM; colt = (pn - 28) * 256; }
      else { dst = pn < 36 ? p.SGA : p.SGB; ld = DM; colt = ((pn - 32) & 3) * 256; }
      const int col0 = colt + wc * 32 + 8 * fq;
#pragma unroll
      for (int ai = 0; ai < 2; ++ai)
#pragma unroll
        for (int m = 0; m < 4; ++m) {
          const int row = row0 + ai * HALF + m * 16;
#pragma unroll
          for (int bj = 0; bj < 2; ++bj) {
            f32x4 v0 = acc[ai][bj][m][0], v1 = acc[ai][bj][m][1];
            if (kind == 1) { for (int j = 0; j < 4; ++j) { v0[j] = siluf(v0[j]); v1[j] = siluf(v1[j]); } }
            if (kind == 2) { for (int j = 0; j < 4; ++j) { v0[j] = sigmf(v0[j]); v1[j] = sigmf(v1[j]); } }
            u32x4 w; w.x = pk2(v0[0], v0[1]); w.y = pk2(v0[2], v0[3]); w.z = pk2(v1[0], v1[1]); w.w = pk2(v1[2], v1[3]);
            *(u32x4*)(dst + (size_t)row * ld + col0 + bj * HALF) = w;
            if (kind == 0 && row < NTP && (row & 63) >= 61)
              *(u32x4*)(p.HALO + ((size_t)(row >> 6) * 3 + ((row & 63) - 61)) * QW + col0 + bj * HALF) = w;
          }
        }
    }
  } else {
    const int col0 = pn * BM + wc * 32 + 8 * fq;
#pragma unroll
    for (int ai = 0; ai < 2; ++ai)
#pragma unroll
      for (int m = 0; m < 4; ++m) {
        const size_t row = row0 + ai * HALF + m * 16;
#pragma unroll
        for (int bj = 0; bj < 2; ++bj) {
          const f32x4 v0 = acc[ai][bj][m][0], v1 = acc[ai][bj][m][1];
          const size_t o = row * DM + col0 + bj * HALF;
          if (EPI == 1) {
            float s[8]; unpack8(*(const u32x4*)(p.SGA + o), s);
            u32x4 w; w.x = pk2(s[0] * v0[0], s[1] * v0[1]); w.y = pk2(s[2] * v0[2], s[3] * v0[3]); w.z = pk2(s[4] * v1[0], s[5] * v1[1]); w.w = pk2(s[6] * v1[2], s[7] * v1[3]);
            *(u32x4*)(p.SGA + o) = w;
          } else if (EPI == 2) {
            float s[8], a[8]; unpack8(*(const u32x4*)(p.SGB + o), s); unpack8(*(const u32x4*)(p.SGA + o), a);
            u32x4 w; w.x = pk2(a[0] + s[0] * v0[0], a[1] + s[1] * v0[1]); w.y = pk2(a[2] + s[2] * v0[2], a[3] + s[3] * v0[3]);
            w.z = pk2(a[4] + s[4] * v1[0], a[5] + s[5] * v1[1]); w.w = pk2(a[6] + s[6] * v1[2], a[7] + s[7] * v1[3]);
            *(u32x4*)(p.UW + o) = w;
          } else {
            const float* xr = row < NTP ? p.x_p + row * DM : p.x_s + (row - NTP) * DM;
            const f32x4 x0 = *(const f32x4*)(xr + col0 + bj * HALF), x1 = *(const f32x4*)(xr + col0 + bj * HALF + 4);
            *(f32x4*)(p.out + o) = x0 + v0; *(f32x4*)(p.out + o + 4) = x1 + v1;
          }
        }
      }
  }
}

#define LAS __attribute__((address_space(3)))
struct Sched {
  int mode, nM, nN, nwg, G, c, start, stride, count;
  DI void init_static(int M, int N, int G_, int c_) { mode = 0; nM = M / BM; nN = N / BM; nwg = nM * nN; G = G_; c = c_; start = stride = count = 0; }
  DI void init_strided(int start_, int stride_, int count_) { mode = 1; start = start_; stride = stride_; count = count_; nM = nN = nwg = G = c = 0; }
  DI bool next(int i, int& pm, int& pn) const {
    if (mode == 0) {
      const long L = (long)i * G + c; if (L >= nwg) return false;
      int wgid = (int)L; { const int q = nwg / NXCD, r = nwg % NXCD, xcd = wgid % NXCD, off = wgid / NXCD; wgid = (xcd < r ? xcd * (q + 1) : r * (q + 1) + (xcd - r) * q) + off; }
      const int nig = WGM * nN, gid = wgid / nig, fm = gid * WGM, gsz = (nM - fm) < WGM ? (nM - fm) : WGM;
      pm = fm + ((wgid % nig) % gsz); pn = (wgid % nig) / gsz; return true;
    }
    const int t = start + i * stride; if (t >= count) return false;
    pm = t >> 2; pn = t & 3; return true;
  }
};

template <int EPI>
DI void gemm_phase(const Params& p, LAS unsigned char* lds, const bf16_t* A, int lda, const bf16_t* Bt, const Sched& S) {
  constexpr int K = 1024, nt = K / BK, HTB = HALF * BK * 2;
  const int tid = launder(threadIdx.x), wid = __builtin_amdgcn_readfirstlane(tid >> 6), lane = tid & 63, wr = wid >> 2, wc = wid & 3, fr = lane & 15, fq = lane >> 4;
  unsigned voffA[2], voffB[2];
#pragma unroll
  for (int i = 0; i < 2; ++i) { int R, C; stage_rc(tid * 16 + i * 8192, R, C); voffA[i] = (unsigned)(R * lda + C) * 2u; voffB[i] = (unsigned)(R * K + C) * 2u; }
  const size_t kstep = (size_t)(BK * 2);
  const size_t hstepA = (size_t)HALF * lda * 2, tstepA = 2 * hstepA, hstepB = (size_t)HALF * K * 2, tstepB = 2 * hstepB;
  const unsigned ldsw = (unsigned)wid * 1024u;
  const int aoff = lds_byte(wr * 64 + fr, fq * 8), boff = lds_byte(wc * 32 + fr, fq * 8);
#define PG8_SA(b, h) (((b) * 2 + (h)) * HTB)
#define PG8_SB(b, h) ((4 + (b) * 2 + (h)) * HTB)
#define PG8_STAGE(bufoff, gbase, voff) do { _Pragma("unroll") for (int _i = 0; _i < 2; ++_i) \
    __builtin_amdgcn_global_load_lds((const unsigned*)((const char*)(gbase) + (voff)[_i]), (LAS unsigned*)(lds + (bufoff) + ldsw + _i * 8192), 16, 0, 0); } while (0)
#define PG8_LDA(dst, b, h) do { _Pragma("unroll") for (int m = 0; m < 4; ++m) _Pragma("unroll") for (int k = 0; k < 2; ++k) dst[m][k] = *(const LAS bf16x8*)(lds + PG8_SA(b, h) + aoff + m * 2048 + k * 1024); } while (0)
#define PG8_LDB(dst, b, h) do { _Pragma("unroll") for (int n = 0; n < 2; ++n) _Pragma("unroll") for (int k = 0; k < 2; ++k) dst[n][k] = *(const LAS bf16x8*)(lds + PG8_SB(b, h) + boff + n * 2048 + k * 1024); } while (0)
#define PG8_MMA(ai, bj, At, Bt_) do { __builtin_amdgcn_s_setprio(1); _Pragma("unroll") for (int m = 0; m < 4; ++m) _Pragma("unroll") for (int n = 0; n < 2; ++n) _Pragma("unroll") for (int k = 0; k < 2; ++k) \
    acc[ai][bj][m][n] = __builtin_amdgcn_mfma_f32_16x16x32_bf16(Bt_[n][k], At[m][k], acc[ai][bj][m][n], 0, 0, 0); __builtin_amdgcn_s_setprio(0); } while (0)
#define PG8_WAIT_V(n) asm volatile("s_waitcnt vmcnt(" #n ")" ::: "memory")
#define PG8_WAIT_L(n) asm volatile("s_waitcnt lgkmcnt(" #n ")" ::: "memory")
#define PG8_BAR __builtin_amdgcn_s_barrier()
#define PG8_SCHED __builtin_amdgcn_sched_barrier(0)
  int cpm, cpn, npm = 0, npn = 0; int ui = 0;
  if (!S.next(0, cpm, cpn)) return;
  f32x4 acc[2][2][4][2];
#pragma unroll
  for (int a = 0; a < 2; ++a)
#pragma unroll
    for (int b = 0; b < 2; ++b)
#pragma unroll
      for (int m = 0; m < 4; ++m)
#pragma unroll
        for (int n = 0; n < 2; ++n) acc[a][b][m][n] = (f32x4){0.f, 0.f, 0.f, 0.f};
  bf16x8 At[4][2], B0[2][2], B1[2][2];
  const char* cA = (const char*)A + (size_t)cpm * tstepA; const char* cB = (const char*)Bt + (size_t)cpn * tstepB;
  PG8_STAGE(PG8_SB(0, 0), cB, voffB); PG8_STAGE(PG8_SB(0, 1), cB + hstepB, voffB); PG8_STAGE(PG8_SA(0, 0), cA, voffA); PG8_STAGE(PG8_SA(0, 1), cA + hstepA, voffA);
  if (wr == 1) PG8_BAR;
  PG8_WAIT_V(2); PG8_BAR;
  PG8_STAGE(PG8_SB(1, 0), cB + kstep, voffB); PG8_STAGE(PG8_SA(1, 0), cA + kstep, voffA); PG8_STAGE(PG8_SB(1, 1), cB + hstepB + kstep, voffB);
  PG8_WAIT_V(6); PG8_BAR;
  for (;;) {
    const bool has_next = S.next(ui + 1, npm, npn);
    const char* nA = has_next ? (const char*)A + (size_t)npm * tstepA : cA; const char* nB = has_next ? (const char*)Bt + (size_t)npn * tstepB : cB;
#pragma unroll 1
    for (int t = 0; t < nt; t += 2) {
      const bool last = (t == nt - 2);
      const char* a1 = cA + (size_t)(t + 1) * kstep;
      const char* a2 = last ? nA : cA + (size_t)(t + 2) * kstep; const char* b2 = last ? nB : cB + (size_t)(t + 2) * kstep;
      const char* a3 = a2 + kstep; const char* b3 = b2 + kstep;
      PG8_LDB(B0, 0, 0); PG8_LDB(B1, 0, 1); PG8_SCHED; PG8_LDA(At, 0, 0); PG8_STAGE(PG8_SA(1, 1), a1 + hstepA, voffA);
      PG8_WAIT_V(8); PG8_WAIT_L(0); PG8_BAR; PG8_MMA(0, 0, At, B0); PG8_MMA(0, 1, At, B1); PG8_BAR; PG8_SCHED;
      PG8_LDA(At, 0, 1); PG8_STAGE(PG8_SB(0, 0), b2, voffB); PG8_STAGE(PG8_SB(0, 1), b2 + hstepB, voffB); PG8_STAGE(PG8_SA(0, 0), a2, voffA);
      PG8_WAIT_V(8); PG8_WAIT_L(0); PG8_BAR; PG8_MMA(1, 0, At, B0); PG8_MMA(1, 1, At, B1); PG8_BAR; PG8_SCHED;
      PG8_LDB(B0, 1, 0); PG8_LDB(B1, 1, 1); PG8_SCHED; PG8_LDA(At, 1, 0); PG8_STAGE(PG8_SA(0, 1), a2 + hstepA, voffA);
      PG8_WAIT_V(8); PG8_WAIT_L(0); PG8_BAR; PG8_MMA(0, 0, At, B0); PG8_MMA(0, 1, At, B1); PG8_BAR; PG8_SCHED;
      PG8_LDA(At, 1, 1); PG8_STAGE(PG8_SB(1, 0), b3, voffB); PG8_STAGE(PG8_SB(1, 1), b3 + hstepB, voffB); PG8_STAGE(PG8_SA(1, 0), a3, voffA);
      PG8_WAIT_V(8); PG8_WAIT_L(0); PG8_BAR; PG8_MMA(1, 0, At, B0); PG8_MMA(1, 1, At, B1); PG8_BAR; PG8_SCHED;
    }
    if (wr == 0) PG8_BAR;
    if (!(EPI == 4 && gridDim.x == 256)) epilogue<EPI == 4 ? 3 : EPI>(p, acc, cpm, cpn, wr, wc, fr, fq);
    if (!has_next) break;
#pragma unroll
    for (int a = 0; a < 2; ++a)
#pragma unroll
      for (int b = 0; b < 2; ++b)
#pragma unroll
        for (int m = 0; m < 4; ++m)
#pragma unroll
          for (int n = 0; n < 2; ++n) acc[a][b][m][n] = (f32x4){0.f, 0.f, 0.f, 0.f};
    cpm = npm; cpn = npn; cA = nA; cB = nB; ++ui;
    if (wr == 1) PG8_BAR;
  }
  PG8_WAIT_V(0);
  PG8_BAR;
  if (EPI == 4 && gridDim.x == 256) epilogue_final(p, acc, cpm, cpn, wr, wc, fr, fq, (unsigned char*)lds, tid);
#undef PG8_SA
#undef PG8_SB
#undef PG8_STAGE
#undef PG8_LDA
#undef PG8_LDB
#undef PG8_MMA
}

template <int EPI>
DI void gemm_tail(const Params& p, const bf16_t* A, int lda, const bf16_t* Bt, int tile0, int ntiles) {
  const int tid = launder(threadIdx.x), wid = tid >> 6, lane = tid & 63, fr = lane & 15, fq = lane >> 4;
  for (int q = blockIdx.x; q < ntiles * 32; q += gridDim.x) {
    const int t = tile0 + (q >> 5), sub = q & 31, pm = t >> 2, pn = t & 3;
    const int row0 = pm * 256 + (sub >> 3) * 64 + (wid >> 1) * 16, R0 = pn * 256 + (sub & 7) * 32 + (wid & 1) * 16;
    const bf16_t* ap = A + (size_t)(row0 + fr) * lda + fq * 8; const bf16_t* bp = Bt + (size_t)(R0 + fr) * DM + fq * 8;
    f32x4 acc = {0.f, 0.f, 0.f, 0.f};
#pragma unroll 16
    for (int ks = 0; ks < 32; ++ks) { const bf16x8 a = *(const bf16x8*)(ap + ks * 32), b = *(const bf16x8*)(bp + ks * 32); acc = __builtin_amdgcn_mfma_f32_16x16x32_bf16(b, a, acc, 0, 0, 0); }
    const size_t row = row0 + fr; const int col0 = (R0 & ~31) + 8 * fq + 4 * ((R0 >> 4) & 1);
    const size_t o = row * DM + col0;
    if (EPI == 2) {
      const u32x2 sw = *(const u32x2*)(p.SGB + o), aw = *(const u32x2*)(p.SGA + o);
      u32x2 w; w.x = pk2(bflo(aw.x) + bflo(sw.x) * acc[0], bfhi(aw.x) + bfhi(sw.x) * acc[1]); w.y = pk2(bflo(aw.y) + bflo(sw.y) * acc[2], bfhi(aw.y) + bfhi(sw.y) * acc[3]);
      *(u32x2*)(p.UW + o) = w;
    } else {
      const float* xr = row < NTP ? p.x_p + row * DM : p.x_s + (row - NTP) * DM;
      *(f32x4*)(p.out + o) = *(const f32x4*)(xr + col0) + acc;
    }
  }
}

DI void wtile_desc(const Params& p, int tile, const float*& src, bf16_t*& dst, int& N, int& kt, int& R0, int& kind) {
  if (tile < 2560) { src = p.w_in; dst = p.WIN; N = NIN; kt = tile & 15; R0 = (tile >> 4) * 64; kind = 0; }
  else { const int t2 = tile - 2560, mat = t2 >> 8; src = mat == 0 ? p.w_oa : (mat == 1 ? p.w_ob : p.w_o); dst = mat == 0 ? p.WOA : (mat == 1 ? p.WOB : p.WO); N = DM; kt = t2 & 15; R0 = ((t2 & 255) >> 4) * 64; kind = 1; }
}
DI void convert_tiles(const Params& p, int first, int end, int stride) {
  extern __shared__ __attribute__((aligned(16))) unsigned char smem[];
  float* lds = (float*)smem;
  const int tid = launder(threadIdx.x);
#pragma unroll 1
  for (int t0 = first; t0 < end; t0 += 4 * stride) {
    f32x4 v[4][2];
#pragma unroll
    for (int q = 0; q < 4; ++q) {
      const int tile = t0 + q * stride;
      if (tile < end) {
        const float* src; bf16_t* dst; int N, kt, R0, kind; wtile_desc(p, tile, src, dst, N, kt, R0, kind);
        const int r4 = tid & 15, R = R0 + r4 * 4, c = kind == 0 ? colmap_in(R) : colmap_sq(R);
#pragma unroll
        for (int ps = 0; ps < 2; ++ps) v[q][ps] = ldnt4(src + (size_t)(kt * 64 + ps * 32 + (tid >> 4)) * N + c);
      }
    }
#pragma unroll
    for (int q = 0; q < 4; ++q) {
      if (t0 + q * stride < end) {
#pragma unroll
        for (int ps = 0; ps < 2; ++ps) { float* d = lds + q * (64 * 65) + (ps * 32 + (tid >> 4)) * 65 + (tid & 15) * 4; d[0] = v[q][ps].x; d[1] = v[q][ps].y; d[2] = v[q][ps].z; d[3] = v[q][ps].w; }
      }
    }
    lds_barrier();
#pragma unroll
    for (int q = 0; q < 4; ++q) {
      const int tile = t0 + q * stride;
      if (tile < end) {
        const float* src; bf16_t* dst; int N, kt, R0, kind; wtile_desc(p, tile, src, dst, N, kt, R0, kind);
        const int R = tid >> 3, kg = tid & 7; float f[8];
#pragma unroll
        for (int i = 0; i < 8; ++i) f[i] = lds[q * (64 * 65) + (kg * 8 + i) * 65 + R];
        *(u32x4*)(dst + (size_t)(R0 + R) * DM + kt * 64 + kg * 8) = pack8(f);
      }
    }
    lds_barrier();
  }
}

__device__ void phase0(const Params& p) {
  extern __shared__ __attribute__((aligned(16))) unsigned char smem[];
  float* lds = (float*)smem;
  const int tid = threadIdx.x, wid = tid >> 6, lane = tid & 63, G = gridDim.x;
  {
    f32x4 w[4];
#pragma unroll
    for (int i = 0; i < 4; ++i) w[i] = *(const f32x4*)(p.nw + i * 256 + lane * 4);
#pragma unroll 1
    for (int row = (blockIdx.x * 8 + wid) * 4; row < NT; row += G * 8 * 4) {
      f32x4 v[4][4];
#pragma unroll
      for (int q = 0; q < 4; ++q) { const int r = row + q; const float* xr = r < NTP ? p.x_p + (size_t)r * DM : p.x_s + (size_t)(r - NTP) * DM;
#pragma unroll
        for (int i = 0; i < 4; ++i) v[q][i] = ldnt4(xr + i * 256 + lane * 4); }
#pragma unroll
      for (int q = 0; q < 4; ++q) {
        float ss = 0.f;
#pragma unroll
        for (int i = 0; i < 4; ++i) ss += (v[q][i].x * v[q][i].x + v[q][i].y * v[q][i].y) + (v[q][i].z * v[q][i].z + v[q][i].w * v[q][i].w);
        ss = wave_sum(ss);
        const float rstd = rsqrtf(ss * (1.f / DM) + EPS);
#pragma unroll
        for (int i = 0; i < 4; ++i) { u32x2 o; o.x = pk2(v[q][i].x * rstd * w[i].x, v[q][i].y * rstd * w[i].y); o.y = pk2(v[q][i].z * rstd * w[i].z, v[q][i].w * rstd * w[i].w);
          *(u32x2*)(p.UW + (size_t)(row + q) * DM + i * 256 + lane * 4) = o; }
      }
    }
  }
  convert_tiles(p, blockIdx.x, 2560, G);
  for (int idx = blockIdx.x * 512 + tid; idx < 16 * DM; idx += G * 512) { const int c = idx >> 10, k = idx & 1023; p.WB16[idx] = (bf16_t)(pk2(p.w_in[(size_t)k * NIN + 8192 + c], 0.f) & 0xffffu); }
}

__device__ void phase1(const Params& p) {
  const int G = gridDim.x;
  { extern __shared__ __attribute__((aligned(16))) unsigned char smem[];
    Sched S; S.init_static(NT, 10240, G, blockIdx.x); gemm_phase<0>(p, (LAS unsigned char*)smem, p.UW, DM, p.WIN, S); }
  const int nfull = G == 256 ? 80 : 0, nside = G - nfull, sidx = (int)blockIdx.x - nfull;
  if (sidx >= 0) convert_tiles(p, 2560 + sidx, 2560 + 768, nside);
  const int tid = launder(threadIdx.x), wid = tid >> 6, lane = tid & 63, fr = lane & 15, fq = lane >> 4;
  if (sidx >= 0)
  for (int task = sidx * 8 + wid; task < NT / 16; task += nside * 8) {
    const int base = task * 16; f32x4 acc = {0.f, 0.f, 0.f, 0.f};
    const bf16_t* ap = p.UW + (size_t)(base + fr) * DM + fq * 8; const bf16_t* bp = p.WB16 + fr * DM + fq * 8;
#pragma unroll 8
    for (int ks = 0; ks < 32; ++ks) { const bf16x8 a = *(const bf16x8*)(ap + ks * 32), b = *(const bf16x8*)(bp + ks * 32); acc = __builtin_amdgcn_mfma_f32_16x16x32_bf16(a, b, acc, 0, 0, 0); }
    const int c = fr, h = c & 7; const float na = -__expf(p.a_log[h]), db = p.dt_bias[h];
#pragma unroll
    for (int j = 0; j < 4; ++j) {
      const int tok = base + fq * 4 + j; const float v = acc[j]; float r;
      if (c < 8) r = sigmf(v); else { const float xx = v + db; r = na * (xx > 20.f ? xx : log1pf(__expf(xx))); }
      p.BG[(size_t)tok * 16 + c] = r;
    }
  }
}

DI u32x4 raw_unit_load(const Params& p, int cgi, int h, int u) {
  const int r = u / 48, rem = u % 48, part = rem >> 4, c8 = rem & 15;
  u32x4 v = {0u, 0u, 0u, 0u};
  if (r < 3) { if ((cgi & 31) > 0) v = *(const u32x4*)(p.HALO + ((size_t)(cgi - 1) * 3 + r) * QW + part * 1024 + h * 128 + c8 * 8); }
  else v = *(const u32x4*)(p.QKV + (size_t)(cgi * 64 + r - 3) * QW + part * 1024 + h * 128 + c8 * 8);
  return v;
}
DI int crow(int r, int lh) { return (r & 3) + 8 * (r >> 2) + 4 * lh; }
DI bf16x8 packfrag(const f32x16& x, int s) {
  u32x4 w; w.x = pk2(x[8 * s], x[8 * s + 1]); w.y = pk2(x[8 * s + 2], x[8 * s + 3]); w.z = pk2(x[8 * s + 4], x[8 * s + 5]); w.w = pk2(x[8 * s + 6], x[8 * s + 7]);
  return __builtin_bit_cast(bf16x8, w);
}
DI bf16x8 ld_permk(const bf16_t* rowp, int s, int lh) {
  const u32x2 a = *(const u32x2*)(rowp + 16 * s + 4 * lh), b = *(const u32x2*)(rowp + 16 * s + 8 + 4 * lh);
  u32x4 w; w.x = a.x; w.y = a.y; w.z = b.x; w.w = b.y; return __builtin_bit_cast(bf16x8, w);
}

DI void chunk_task(const Params& p, int cgi, int h, u32x4 (&pre)[7], float& pg, float& pb, int next_cgi, int next_h, bool has_next) {
  extern __shared__ __attribute__((aligned(16))) unsigned char smem[];
  bf16_t* raw = (bf16_t*)smem;
  bf16_t* qh = (bf16_t*)(smem + 52736);
  bf16_t* kh = (bf16_t*)(smem + 70144);
  bf16_t* vh = (bf16_t*)(smem + 87552);
  float* Mm = (float*)(smem + 104960);
  bf16_t* M10n = (bf16_t*)(smem + 121344);
  bf16_t* Tb = (bf16_t*)(smem + 123904);
  float* gcs = (float*)(smem + 129024);
  float* bet = (float*)(smem + 129280);
  float* rsk = (float*)(smem + 129536);
  const float* cw = (const float*)(smem + 129792);
  const int tid = launder(threadIdx.x), wid = tid >> 6, lane = tid & 63;
  const int n = cgi & 31, b = cgi >> 5, T0 = cgi * 64, ci = cgi * 8 + h;
#pragma unroll
  for (int k = 0; k < 7; ++k) { const int u = k * 512 + tid; if (u < 67 * 48) { const int r = u / 48, rem = u % 48; *(u32x4*)(raw + r * 392 + (rem >> 4) * 128 + (rem & 15) * 8) = pre[k]; } }
  if (has_next) {
#pragma unroll
    for (int k = 0; k < 7; ++k) { const int u = k * 512 + tid; if (u < 67 * 48) pre[k] = raw_unit_load(p, next_cgi, next_h, u); }
  }
  if (wid == 0) {
    float g = pg; const float be = pb;
    if (has_next) { pg = p.BG[(size_t)(next_cgi * 64 + lane) * 16 + 8 + next_h]; pb = p.BG[(size_t)(next_cgi * 64 + lane) * 16 + next_h]; }
#pragma unroll
    for (int o = 1; o < 64; o <<= 1) { const float t = __shfl_up(g, o); if (lane >= o) g += t; }
    gcs[lane] = g; bet[lane] = be; rsk[lane] = be * __expf(g);
  }
  lds_barrier();
  const float glast = gcs[63];
#pragma unroll 1
  for (int part = 0; part < 3; ++part) {
    const int c8 = tid & 15, row = (tid >> 4) * 2;
    f32x2 w2[4][4];
#pragma unroll
    for (int j = 0; j < 4; ++j) { const f32x4 wa = *(const f32x4*)(cw + (part * 4 + j) * 128 + c8 * 8), wb = *(const f32x4*)(cw + (part * 4 + j) * 128 + c8 * 8 + 4);
      w2[j][0] = (f32x2){wa.x, wa.y}; w2[j][1] = (f32x2){wa.z, wa.w}; w2[j][2] = (f32x2){wb.x, wb.y}; w2[j][3] = (f32x2){wb.z, wb.w}; }
    f32x2 a2[2][4];
#pragma unroll
    for (int k = 0; k < 4; ++k) { a2[0][k] = (f32x2){0.f, 0.f}; a2[1][k] = (f32x2){0.f, 0.f}; }
#pragma unroll
    for (int rr = 0; rr < 5; ++rr) {
      const u32x4 xw = *(const u32x4*)(raw + (row + rr) * 392 + part * 128 + c8 * 8);
      f32x2 x2[4]; x2[0] = (f32x2){bflo(xw.x), bfhi(xw.x)}; x2[1] = (f32x2){bflo(xw.y), bfhi(xw.y)}; x2[2] = (f32x2){bflo(xw.z), bfhi(xw.z)}; x2[3] = (f32x2){bflo(xw.w), bfhi(xw.w)};
#pragma unroll
      for (int q = 0; q < 2; ++q) { const int j = rr - q; if (j >= 0 && j < 4) {
#pragma unroll
        for (int k = 0; k < 4; ++k) a2[q][k] = x2[k] * w2[j][k] + a2[q][k]; } }
    }
#pragma unroll
    for (int q = 0; q < 2; ++q) {
      f32x2 s2 = {0.f, 0.f};
#pragma unroll
      for (int k = 0; k < 4; ++k) {
        const f32x2 t = a2[q][k] * (-1.4426950408889634f);
        f32x2 d; d.x = __builtin_amdgcn_exp2f(t.x); d.y = __builtin_amdgcn_exp2f(t.y); d = d + 1.0f;
        f32x2 r; r.x = __builtin_amdgcn_rcpf(d.x); r.y = __builtin_amdgcn_rcpf(d.y);
        a2[q][k] = a2[q][k] * r; s2 = a2[q][k] * a2[q][k] + s2;
      }
      float ss = s2.x + s2.y;
      ss += __shfl_xor(ss, 1); ss += __shfl_xor(ss, 2); ss += __shfl_xor(ss, 4); ss += __shfl_xor(ss, 8);
      if (part < 2) { const float sc = rsqrtf(ss + EPS) * (part == 0 ? 0.08838834764831845f : 1.f);
#pragma unroll
        for (int k = 0; k < 4; ++k) a2[q][k] = a2[q][k] * sc; }
      bf16_t* dstl = part == 0 ? qh : (part == 1 ? kh : vh);
      { u32x4 o; o.x = pk2(a2[q][0].x, a2[q][0].y); o.y = pk2(a2[q][1].x, a2[q][1].y); o.z = pk2(a2[q][2].x, a2[q][2].y); o.w = pk2(a2[q][3].x, a2[q][3].y);
        *(u32x4*)(dstl + (row + q) * 136 + c8 * 8) = o; }
      if (part == 0) { const float eg = __expf(gcs[row + q]);
#pragma unroll
        for (int k = 0; k < 4; ++k) a2[q][k] = a2[q][k] * eg;
        u32x4 o; o.x = pk2(a2[q][0].x, a2[q][0].y); o.y = pk2(a2[q][1].x, a2[q][1].y); o.z = pk2(a2[q][2].x, a2[q][2].y); o.w = pk2(a2[q][3].x, a2[q][3].y);
        *(u32x4*)(p.QKV + (size_t)(T0 + row + q) * QW + h * 128 + c8 * 8) = o; }
    }
  }
  if (n == 31) {
    for (int u = tid; u < 3 * 384; u += 512) { const int j = u / 384, cc = u % 384, part = cc >> 7, col = cc & 127;
      p.out[OFF_NCQ_P + ((size_t)b * 3 + j) * QW + part * 1024 + h * 128 + col] = bf2f(raw[(64 + j) * 392 + cc]); }
  }
  lds_barrier();
  {
    const int fr = lane & 15, fq = lane >> 4, wq = wid & 3; const bool isq = wid >= 4;
    const bf16_t* Y = isq ? qh : kh;
#pragma unroll 1
    for (int bidx = wq; bidx < 10; bidx += 4) {
      const int ib = bidx >= 6 ? 3 : (bidx >= 3 ? 2 : (bidx >= 1 ? 1 : 0)), jb = bidx - (ib * (ib + 1)) / 2;
      const int i = ib * 16 + fr; const float gi = gcs[i], bi = bet[i];
      f32x4 d = {0.f, 0.f, 0.f, 0.f};
#pragma unroll
      for (int ks = 0; ks < 4; ++ks) {
        const bf16x8 xa = *(const bf16x8*)(kh + (jb * 16 + fr) * 136 + ks * 32 + fq * 8), yb = *(const bf16x8*)(Y + (ib * 16 + fr) * 136 + ks * 32 + fq * 8);
        d = __builtin_amdgcn_mfma_f32_16x16x32_bf16(xa, yb, d, 0, 0, 0);
      }
      const int j0 = jb * 16 + fq * 4; float r[4];
#pragma unroll
      for (int jj = 0; jj < 4; ++jj) { const int j = j0 + jj; const bool keep = isq ? (i >= j) : (i > j); r[jj] = keep ? d[jj] * __expf(gi - gcs[j]) * (isq ? 1.f : bi) : 0.f; }
      if (isq) { u32x2 w; w.x = pk2(r[0], r[1]); w.y = pk2(r[2], r[3]); *(u32x2*)(p.AQK + (size_t)ci * 4096 + i * 64 + j0) = w; }
      else {
        *(f32x4*)(Mm + i * 64 + j0) = (f32x4){r[0], r[1], r[2], r[3]};
        if (ib >= 2 && jb < 2) { u32x2 w; w.x = pk2(-r[0], -r[1]); w.y = pk2(-r[2], -r[3]); *(u32x2*)(M10n + (i - 32) * 40 + j0) = w; }
      }
    }
    if (isq) {
      for (int u = wq; u < 6; u += 4) { const int ib = u < 3 ? 0 : (u < 5 ? 1 : 2), jb = u < 3 ? u + 1 : (u < 5 ? u - 1 : 3);
        *(u32x2*)(p.AQK + (size_t)ci * 4096 + (ib * 16 + fr) * 64 + jb * 16 + fq * 4) = (u32x2){0u, 0u}; }
    }
  }
  lds_barrier();
  if (wid == 0) {
    const int blk = lane >> 5, c = lane & 31; const float* Mb = Mm + (blk * 32) * 64 + blk * 32;
    float X[32];
    f32x4 mb[2][8];
#pragma unroll
    for (int r = 0; r < 32; ++r) {
      if (r + 1 < 32) {
#pragma unroll
        for (int j4 = 0; j4 < (r + 4) / 4; ++j4) mb[(r + 1) & 1][j4] = *(const f32x4*)(Mb + (r + 1) * 64 + j4 * 4);
      }
      float s0 = (r == c) ? 1.f : 0.f, s1 = 0.f;
#pragma unroll
      for (int j4 = 0; j4 < (r + 3) / 4; ++j4) {
        const f32x4 m = mb[r & 1][j4];
        if (j4 * 4 + 0 < r) s0 -= m.x * X[j4 * 4 + 0];
        if (j4 * 4 + 1 < r) s1 -= m.y * X[j4 * 4 + 1];
        if (j4 * 4 + 2 < r) s0 -= m.z * X[j4 * 4 + 2];
        if (j4 * 4 + 3 < r) s1 -= m.w * X[j4 * 4 + 3];
      }
      X[r] = s0 + s1;
    }
#pragma unroll
    for (int r = 0; r < 32; ++r) Tb[(blk * 32 + r) * 40 + c] = (bf16_t)(pk2(X[r], 0.f) & 0xffffu);
  } else {
    for (int u = tid - 64; u < 1024; u += 448) {
      const int i8 = u & 7, d = u >> 3; float f[8];
#pragma unroll
      for (int e = 0; e < 8; ++e) { const int i = i8 * 8 + e; f[e] = bf2f(kh[i * 136 + d]) * __expf(glast - gcs[i]); }
      *(u32x4*)(p.QKV + (size_t)(T0 + (d >> 1)) * QW + 1024 + h * 128 + (d & 1) * 64 + i8 * 8) = pack8(f);
    }
    if (tid == 64) p.DL[ci] = __expf(glast);
  }
  lds_barrier();
  {
    const int l32 = lane & 31, lh = lane >> 5; const bool isV = wid >= 4;
    const bf16_t* srcl = (isV ? vh : kh) + (wid & 3) * 32 + l32; const float* rs = isV ? bet : rsk;
    bf16x8 r0[2];
#pragma unroll
    for (int s = 0; s < 2; ++s) { float f[8];
#pragma unroll
      for (int e = 0; e < 8; ++e) { const int k = 16 * s + 8 * lh + e; f[e] = bf2f(srcl[k * 136]) * rs[k]; }
      r0[s] = __builtin_bit_cast(bf16x8, pack8(f)); }
    f32x16 x0 = {};
#pragma unroll
    for (int s = 0; s < 2; ++s) x0 = __builtin_amdgcn_mfma_f32_32x32x16_bf16(*(const bf16x8*)(Tb + l32 * 40 + 16 * s + 8 * lh), r0[s], x0, 0, 0, 0);
    f32x16 y1;
#pragma unroll
    for (int r = 0; r < 16; ++r) { const int k = 32 + crow(r, lh); y1[r] = bf2f(srcl[k * 136]) * rs[k]; }
#pragma unroll
    for (int s = 0; s < 2; ++s) y1 = __builtin_amdgcn_mfma_f32_32x32x16_bf16(ld_permk(M10n + l32 * 40, s, lh), packfrag(x0, s), y1, 0, 0, 0);
    f32x16 x1 = {};
#pragma unroll
    for (int s = 0; s < 2; ++s) x1 = __builtin_amdgcn_mfma_f32_32x32x16_bf16(ld_permk(Tb + (32 + l32) * 40, s, lh), packfrag(y1, s), x1, 0, 0, 0);
    const int col = (wid & 3) * 32 + l32;
    if (!isV) {
      bf16_t* wp = p.UW + (size_t)ci * 8192 + col;
#pragma unroll
      for (int r = 0; r < 16; ++r) { const int i = crow(r, lh); wp[i * 128] = (bf16_t)(pk2(-x0[r], 0.f) & 0xffffu); wp[(32 + i) * 128] = (bf16_t)(pk2(-x1[r], 0.f) & 0xffffu); }
    } else {
      bf16_t* up = p.QKV + (size_t)(T0 + (col >> 1)) * QW + 2048 + h * 128 + (col & 1) * 64;
#pragma unroll
      for (int q = 0; q < 4; ++q) {
        u32x2 w0, w1; w0.x = pk2(x0[q * 4], x0[q * 4 + 1]); w0.y = pk2(x0[q * 4 + 2], x0[q * 4 + 3]); w1.x = pk2(x1[q * 4], x1[q * 4 + 1]); w1.y = pk2(x1[q * 4 + 2], x1[q * 4 + 3]);
        *(u32x2*)(up + q * 8 + lh * 4) = w0; *(u32x2*)(up + 32 + q * 8 + lh * 4) = w1;
      }
    }
  }
  lds_barrier();
}

__device__ void phase2(const Params& p) {
  const int G = gridDim.x;
  {
    extern __shared__ __attribute__((aligned(16))) unsigned char smem[];
    float* cw = (float*)(smem + 129792);
    const int tid0 = launder(threadIdx.x);
    int cur_h = -1; u32x4 pre[7];
    int task = blockIdx.x;
#pragma unroll
    for (int k = 0; k < 7; ++k) { const int u = k * 512 + tid0; pre[k] = (u32x4){0u, 0u, 0u, 0u}; if (task < 2048 && u < 67 * 48) pre[k] = raw_unit_load(p, task >> 3, task & 7, u); }
    float pg = 0.f, pb = 0.f;
    if (task < 2048 && tid0 < 64) { pg = p.BG[(size_t)((task >> 3) * 64 + tid0) * 16 + 8 + (task & 7)]; pb = p.BG[(size_t)((task >> 3) * 64 + tid0) * 16 + (task & 7)]; }
    for (; task < 2048; task += G) {
      const int h = task & 7;
      if (h != cur_h) {
        lds_barrier();
        for (int u = tid0; u < 3 * 4 * 128; u += 512) { const int part = u / 512, j = (u >> 7) & 3, col = u & 127; cw[u] = p.cbw[(size_t)j * QW + part * 1024 + h * 128 + col]; }
        cur_h = h;
      }
      const int nt = task + G;
      chunk_task(p, task >> 3, h, pre, pg, pb, nt >> 3, nt & 7, nt < 2048);
    }
  }
  const int tid = launder(threadIdx.x);
  {
    const int c8 = (tid & 127) * 8;
    float w0[8], w1[8], w2[8];
#pragma unroll
    for (int e = 0; e < 8; ++e) { w0[e] = p.caw[c8 + e]; w1[e] = p.caw[DM + c8 + e]; w2[e] = p.caw[2 * DM + c8 + e]; }
#pragma unroll 1
    for (int grp = blockIdx.x * 4 + (tid >> 7); grp < NT / 8; grp += G * 4) {
      const int r0 = grp * 8;
      u32x4 pw[10], gw[8];
#pragma unroll
      for (int k = 0; k < 10; ++k) { const int r = r0 - 2 + k; pw[k] = (u32x4){0u, 0u, 0u, 0u}; if (r >= 0) pw[k] = *(const u32x4*)(p.P + (size_t)r * DM + c8); }
#pragma unroll
      for (int k = 0; k < 8; ++k) gw[k] = *(const u32x4*)(p.GATE + (size_t)(r0 + k) * DM + c8);
#pragma unroll
      for (int k = 0; k < 8; ++k) {
        const int r = r0 + k;
        float cur[8], p1[8], p2[8], g[8];
        unpack8(pw[k + 2], cur); unpack8(pw[k + 1], p1); unpack8(pw[k], p2); unpack8(gw[k], g);
        if (r < NTP) {
          const int t = r & 2047;
          if (t < 1) { for (int e = 0; e < 8; ++e) p1[e] = 0.f; }
          if (t < 2) { for (int e = 0; e < 8; ++e) p2[e] = 0.f; }
          if (t >= 2046) { float* o = p.out + OFF_NCA_P + ((size_t)(r >> 11) * 2 + (t - 2046)) * DM + c8; *(f32x4*)o = (f32x4){cur[0], cur[1], cur[2], cur[3]}; *(f32x4*)(o + 4) = (f32x4){cur[4], cur[5], cur[6], cur[7]}; }
        } else {
          const int bs = (r - NTP) >> 2, t = (r - NTP) & 3;
          const float* past = p.sca + (size_t)bs * 2 * DM + c8;
          if (t < 1) { for (int e = 0; e < 8; ++e) p1[e] = past[DM + e]; }
          if (t < 2) { for (int e = 0; e < 8; ++e) p2[e] = past[(t == 1 ? DM : 0) + e]; }
          if (t >= 2) { float* o = p.out + OFF_NCA_S + ((size_t)bs * 2 + (t - 2)) * DM + c8; *(f32x4*)o = (f32x4){cur[0], cur[1], cur[2], cur[3]}; *(f32x4*)(o + 4) = (f32x4){cur[4], cur[5], cur[6], cur[7]}; }
        }
        float o8[8];
#pragma unroll
        for (int e = 0; e < 8; ++e) o8[e] = g[e] * (w0[e] * p2[e] + w1[e] * p1[e] + w2[e] * cur[e]);
        *(u32x4*)(p.GATE + (size_t)r * DM + c8) = pack8(o8);
      }
    }
  }
}

DI void cvt16(f32x16& a, int q, u32x2 w) { a[q * 4 + 0] = bflo(w.x); a[q * 4 + 1] = bfhi(w.x); a[q * 4 + 2] = bflo(w.y); a[q * 4 + 3] = bfhi(w.y); }
__device__ __forceinline__ void scan_seq(const Params& p, int seq) {
  extern __shared__ __attribute__((aligned(16))) unsigned char smem[];
  bf16_t* A1 = (bf16_t*)smem;
  bf16_t* AQ = (bf16_t*)(smem + 34816);
  bf16_t* KT = (bf16_t*)(smem + 44032);
  bf16_t* ST = (bf16_t*)(smem + 62464);
  bf16_t* UT = (bf16_t*)(smem + 97280);
  float* OS = (float*)(smem + 115712);
  const int tid = launder(threadIdx.x), wid = tid >> 6, lane = tid & 63, vb = wid & 3, hw = wid >> 2, l32 = lane & 31, lh = lane >> 5;
  const int b = seq >> 3, h = seq & 7;
  f32x16 S0 = {}, S1 = {};
  for (int i = tid; i < 128 * 136 / 8; i += 512) ((u32x4*)ST)[i] = (u32x4){0u, 0u, 0u, 0u};
  const int v = vb * 32 + l32;
  u32x4 pA[4], pQ, pK[2]; u32x2 pU[8]; float pdl;
  float onw16[16];
  { const int seg = tid & 7;
#pragma unroll
    for (int e = 0; e < 16; ++e) onw16[e] = p.onw[seg * 16 + e]; }
#define SCAN_SRC_A(nn, it) ({ const int ci_ = (b * 32 + (nn)) * 8 + h, T0_ = (b * 32 + (nn)) * 64; const int u_ = (it) * 512 + tid, r_ = u_ >> 4, c_ = (u_ & 15) * 8; \
    (const u32x4*)(r_ < 64 ? p.UW + ((size_t)ci_ * 64 + r_) * 128 + c_ : p.QKV + (size_t)(T0_ + r_ - 64) * QW + h * 128 + c_); })
#define SCAN_LOAD_A(nn) do { _Pragma("unroll") for (int it = 0; it < 4; ++it) pA[it] = *SCAN_SRC_A(nn, it); } while (0)
#define SCAN_LOAD_QK(nn) do { const int ci_ = (b * 32 + (nn)) * 8 + h, T0_ = (b * 32 + (nn)) * 64; \
    { const int r = tid >> 3, c = (tid & 7) * 8; pQ = *(const u32x4*)(p.AQK + (size_t)ci_ * 4096 + r * 64 + c); } \
    _Pragma("unroll") for (int it = 0; it < 2; ++it) { const int u = it * 512 + tid, d = u >> 3, c = (u & 7) * 8; \
      pK[it] = *(const u32x4*)(p.QKV + (size_t)(T0_ + (d >> 1)) * QW + 1024 + h * 128 + (d & 1) * 64 + c); } } while (0)
#define SCAN_LOAD_U(nn) do { const int ci_ = (b * 32 + (nn)) * 8 + h, T0_ = (b * 32 + (nn)) * 64; \
    if (hw == 0) { const bf16_t* base_ = p.QKV + (size_t)(T0_ + (v >> 1)) * QW + 2048 + h * 128 + (v & 1) * 64; \
      _Pragma("unroll") for (int q = 0; q < 4; ++q) { pU[q] = *(const u32x2*)(base_ + q * 8 + lh * 4); pU[4 + q] = *(const u32x2*)(base_ + 32 + q * 8 + lh * 4); } } \
    pdl = p.DL[ci_]; } while (0)
#define SCAN_FILL_A() do { _Pragma("unroll") for (int it = 0; it < 4; ++it) { const int u = it * 512 + tid, r = u >> 4, c = (u & 15) * 8; *(u32x4*)(A1 + r * 136 + c) = pA[it]; } } while (0)
#define SCAN_FILL_QK() do { { const int r = tid >> 3, c = (tid & 7) * 8; *(u32x4*)(AQ + r * 72 + c) = pQ; } \
    _Pragma("unroll") for (int it = 0; it < 2; ++it) { const int u = it * 512 + tid, d = u >> 3, c = (u & 7) * 8; *(u32x4*)(KT + d * 72 + c) = pK[it]; } } while (0)
  SCAN_LOAD_A(0); SCAN_LOAD_QK(0); SCAN_LOAD_U(0);
  SCAN_FILL_A(); SCAN_FILL_QK();
  SCAN_LOAD_A(1); SCAN_LOAD_QK(1);
  lds_barrier();
#pragma unroll 1
  for (int n = 0; n < 32; ++n) {
    const int cgi = b * 32 + n, T0 = cgi * 64;
    f32x16 a0 = {}, a1 = {};
    if (hw == 0) {
#pragma unroll
      for (int q = 0; q < 4; ++q) { cvt16(a0, q, pU[q]); cvt16(a1, q, pU[4 + q]); }
    }
    const float dl = pdl;
    if (n + 1 < 32) SCAN_LOAD_U(n + 1);
    u32x4 zz0, zz1;
    { const int i = tid >> 3, seg = tid & 7; const size_t tok = (size_t)T0 + i; zz0 = *(const u32x4*)(p.SBZ + tok * DM + h * 128 + seg * 16); zz1 = *(const u32x4*)(p.SBZ + tok * DM + h * 128 + seg * 16 + 8); }
#pragma unroll
    for (int ks = 0; ks < 8; ++ks) {
      const bf16x8 bfr = *(const bf16x8*)(ST + v * 136 + ks * 16 + lh * 8);
      const bf16x8 x0 = *(const bf16x8*)(A1 + (hw * 64 + l32) * 136 + ks * 16 + lh * 8), x1 = *(const bf16x8*)(A1 + (hw * 64 + 32 + l32) * 136 + ks * 16 + lh * 8);
      a0 = __builtin_amdgcn_mfma_f32_32x32x16_bf16(x0, bfr, a0, 0, 0, 0);
      a1 = __builtin_amdgcn_mfma_f32_32x32x16_bf16(x1, bfr, a1, 0, 0, 0);
    }
    if (hw == 0) {
#pragma unroll
      for (int q = 0; q < 4; ++q) {
        u32x2 w0, w1; w0.x = pk2(a0[q * 4], a0[q * 4 + 1]); w0.y = pk2(a0[q * 4 + 2], a0[q * 4 + 3]); w1.x = pk2(a1[q * 4], a1[q * 4 + 1]); w1.y = pk2(a1[q * 4 + 2], a1[q * 4 + 3]);
        *(u32x2*)(UT + v * 72 + q * 8 + lh * 4) = w0; *(u32x2*)(UT + v * 72 + 32 + q * 8 + lh * 4) = w1;
      }
    }
    lds_barrier();
    S0 *= dl; S1 *= dl;
#pragma unroll
    for (int ks = 0; ks < 4; ++ks) {
      const bf16x8 bfr = *(const bf16x8*)(UT + v * 72 + ks * 16 + lh * 8);
      if (hw == 1) {
        const bf16x8 x0 = *(const bf16x8*)(AQ + l32 * 72 + ks * 16 + lh * 8), x1 = *(const bf16x8*)(AQ + (32 + l32) * 72 + ks * 16 + lh * 8);
        a0 = __builtin_amdgcn_mfma_f32_32x32x16_bf16(x0, bfr, a0, 0, 0, 0);
        a1 = __builtin_amdgcn_mfma_f32_32x32x16_bf16(x1, bfr, a1, 0, 0, 0);
      }
      const bf16x8 k0 = *(const bf16x8*)(KT + ((2 * hw) * 32 + l32) * 72 + ks * 16 + lh * 8), k1 = *(const bf16x8*)(KT + ((2 * hw + 1) * 32 + l32) * 72 + ks * 16 + lh * 8);
      S0 = __builtin_amdgcn_mfma_f32_32x32x16_bf16(k0, bfr, S0, 0, 0, 0);
      S1 = __builtin_amdgcn_mfma_f32_32x32x16_bf16(k1, bfr, S1, 0, 0, 0);
    }
    if (n + 1 < 32) { SCAN_FILL_A(); if (n + 2 < 32) SCAN_LOAD_A(n + 2); }
#pragma unroll
    for (int q = 0; q < 4; ++q) {
      u32x2 w0, w1; w0.x = pk2(S0[q * 4], S0[q * 4 + 1]); w0.y = pk2(S0[q * 4 + 2], S0[q * 4 + 3]); w1.x = pk2(S1[q * 4], S1[q * 4 + 1]); w1.y = pk2(S1[q * 4 + 2], S1[q * 4 + 3]);
      *(u32x2*)(ST + v * 136 + (2 * hw) * 32 + q * 8 + lh * 4) = w0; *(u32x2*)(ST + v * 136 + (2 * hw + 1) * 32 + q * 8 + lh * 4) = w1;
    }
    if (hw == 1) {
#pragma unroll
      for (int r = 0; r < 16; ++r) { const int i = (r & 3) + 8 * (r >> 2) + 4 * lh; OS[i * 132 + v] = a0[r]; OS[(32 + i) * 132 + v] = a1[r]; }
    }
    lds_barrier();
    {
      const int i = tid >> 3, seg = tid & 7; const float* orow = OS + i * 132 + seg * 16; float o[16]; float ss = 0.f;
#pragma unroll
      for (int e4 = 0; e4 < 4; ++e4) { const f32x4 t = *(const f32x4*)(orow + e4 * 4); o[e4 * 4] = t.x; o[e4 * 4 + 1] = t.y; o[e4 * 4 + 2] = t.z; o[e4 * 4 + 3] = t.w; ss += (t.x * t.x + t.y * t.y) + (t.z * t.z + t.w * t.w); }
      ss += __shfl_xor(ss, 1); ss += __shfl_xor(ss, 2); ss += __shfl_xor(ss, 4);
      const float rstd = rsqrtf(ss * (1.f / 128.f) + EPS);
      const size_t tok = (size_t)T0 + i; float z[16];
      unpack8(zz0, z); unpack8(zz1, z + 8);
#pragma unroll
      for (int e = 0; e < 16; ++e) o[e] = o[e] * rstd * onw16[e] * z[e];
      bf16_t* dst = p.QKV + tok * QW + 2048 + h * 128 + seg * 16;
      *(u32x4*)dst = pack8(o); *(u32x4*)(dst + 8) = pack8(o + 8);
    }
    if (n + 1 < 32) { SCAN_FILL_QK(); if (n + 2 < 32) SCAN_LOAD_QK(n + 2); }
  }
  float* sp = p.out + OFF_ND_P + (size_t)(b * 8 + h) * 16384;
#pragma unroll
  for (int r = 0; r < 16; ++r) { const int dd = (r & 3) + 8 * (r >> 2) + 4 * lh; sp[(size_t)((2 * hw) * 32 + dd) * 128 + v] = S0[r]; sp[(size_t)((2 * hw + 1) * 32 + dd) * 128 + v] = S1[r]; }
  lds_barrier();
}

__device__ __forceinline__ void sample_seq(const Params& p, int s, f32x4 (&Sn)[8], int s_next) {
  extern __shared__ __attribute__((aligned(16))) unsigned char smem[];
  float* qs = (float*)smem;
  float* ks = qs + 512;
  float* vs = ks + 512;
  float* os = vs + 512;
  float* red = os + 512;
  const int tid = launder(threadIdx.x), bs = s >> 3, h = s & 7;
  const size_t Tb = (size_t)NTP + bs * 4;
  const int kg = tid >> 5, vg = tid & 31;
  f32x4 S[8];
#pragma unroll
  for (int kk = 0; kk < 8; ++kk) S[kk] = Sn[kk];
  if (s_next >= 0) { const float* sn = p.sd + ((size_t)s_next * 128 + kg * 8) * 128 + vg * 4;
#pragma unroll
    for (int kk = 0; kk < 8; ++kk) Sn[kk] = ldnt4(sn + kk * 128); }
  float ga[4], be[4];
#pragma unroll
  for (int t = 0; t < 4; ++t) { ga[t] = p.BG[(Tb + t) * 16 + 8 + h]; be[t] = p.BG[(Tb + t) * 16 + h]; }
  u32x4 zt = {0u, 0u, 0u, 0u}; float ow[8];
  { const int t = (tid >> 4) & 3, seg = tid & 15; zt = *(const u32x4*)(p.SBZ + (Tb + t) * DM + h * 128 + seg * 8);
#pragma unroll
    for (int e = 0; e < 8; ++e) ow[e] = p.onw[seg * 8 + e]; }
  if (tid < 192) {
    const int c8 = tid & 15, grp = tid >> 4, part = grp % 3, t = grp / 3;
    const int colw = part * 1024 + h * 128 + c8 * 8;
    float a[8] = {0.f, 0.f, 0.f, 0.f, 0.f, 0.f, 0.f, 0.f};
#pragma unroll
    for (int j = 0; j < 4; ++j) {
      const int e_ = t + j; float x[8];
      if (e_ < 3) { const float* ps = p.scq + ((size_t)bs * 3 + e_) * QW + colw; for (int e = 0; e < 8; ++e) x[e] = ps[e]; }
      else unpack8(*(const u32x4*)(p.QKV + (Tb + e_ - 3) * QW + colw), x);
      const float* w = p.cbw + j * QW + colw;
#pragma unroll
      for (int e = 0; e < 8; ++e) a[e] += x[e] * w[e];
      if (j == 3 && t >= 1) { float* o = p.out + OFF_NCQ_S + ((size_t)bs * 3 + (t - 1)) * QW + colw; for (int e = 0; e < 8; ++e) o[e] = x[e]; }
    }
    float ss = 0.f;
#pragma unroll
    for (int e = 0; e < 8; ++e) { a[e] = siluf(a[e]); ss += a[e] * a[e]; }
    ss += __shfl_xor(ss, 1); ss += __shfl_xor(ss, 2); ss += __shfl_xor(ss, 4); ss += __shfl_xor(ss, 8);
    if (part < 2) { const float sc = rsqrtf(ss + EPS) * (part == 0 ? 0.08838834764831845f : 1.f); for (int e = 0; e < 8; ++e) a[e] *= sc; }
    float* d = (part == 0 ? qs : (part == 1 ? ks : vs)) + t * 128 + c8 * 8;
#pragma unroll
    for (int e = 0; e < 8; ++e) d[e] = a[e];
  }
  lds_barrier();
#pragma unroll
  for (int t = 0; t < 4; ++t) {
    const float a = __expf(ga[t]), beta = be[t];
    f32x4 part = {0.f, 0.f, 0.f, 0.f};
#pragma unroll
    for (int kk = 0; kk < 8; ++kk) { S[kk] *= a; part += S[kk] * ks[t * 128 + kg * 8 + kk]; }
    *(f32x4*)(red + kg * 128 + vg * 4) = part;
    lds_barrier();
    f32x4 r = {0.f, 0.f, 0.f, 0.f};
#pragma unroll
    for (int g2 = 0; g2 < 16; ++g2) r += *(const f32x4*)(red + g2 * 128 + vg * 4);
    const f32x4 dlt = (*(const f32x4*)(vs + t * 128 + vg * 4) - r) * beta;
    f32x4 po = {0.f, 0.f, 0.f, 0.f};
#pragma unroll
    for (int kk = 0; kk < 8; ++kk) { S[kk] += dlt * ks[t * 128 + kg * 8 + kk]; po += S[kk] * qs[t * 128 + kg * 8 + kk]; }
    lds_barrier();
    *(f32x4*)(red + kg * 128 + vg * 4) = po;
    lds_barrier();
    if (tid < 128) { float o = 0.f; for (int g2 = 0; g2 < 16; ++g2) o += red[g2 * 128 + tid]; os[t * 128 + tid] = o; }
    lds_barrier();
  }
  float* so = p.out + OFF_ND_S + ((size_t)s * 128 + kg * 8) * 128 + vg * 4;
#pragma unroll
  for (int kk = 0; kk < 8; ++kk) stnt4(so + kk * 128, S[kk]);
  if (tid < 64) {
    const int t = tid >> 4, seg = tid & 15; float o[8]; float ss = 0.f;
#pragma unroll
    for (int e = 0; e < 8; ++e) { o[e] = os[t * 128 + seg * 8 + e]; ss += o[e] * o[e]; }
    ss += __shfl_xor(ss, 1); ss += __shfl_xor(ss, 2); ss += __shfl_xor(ss, 4); ss += __shfl_xor(ss, 8);
    const float rstd = rsqrtf(ss * (1.f / 128.f) + EPS); float z[8];
    unpack8(zt, z);
#pragma unroll
    for (int e = 0; e < 8; ++e) o[e] = o[e] * rstd * ow[e] * z[e];
    *(u32x4*)(p.QKV + (Tb + t) * QW + 2048 + h * 128 + seg * 8) = pack8(o);
  }
  lds_barrier();
}

__device__ void phase3(const Params& p) {
  const int G = gridDim.x, bid = blockIdx.x;
  const bool split = G > 64;
#ifndef P3_NO_SCAN
  if (!split || bid < 64) for (int seq = bid; seq < 64; seq += (split ? 64 : G)) scan_seq(p, seq);
#endif
  if (!split || bid >= 64) {
    const int wk = split ? bid - 64 : bid, NW = split ? G - 64 : G;
#ifndef P3_NO_GEMM
    { extern __shared__ __attribute__((aligned(16))) unsigned char smem[];
      Sched S; S.init_strided(wk, NW, 264); gemm_phase<1>(p, (LAS unsigned char*)smem, p.GATE, DM, p.WOA, S); }
#endif
#ifndef P3_NO_SAMPLE
    {
      const int n2 = (264 > NW && 264 < 2 * NW) ? 264 - NW : 0, n1 = NW - n2;
      const int s_first = wk < n2 ? 1024 : (wk - n2), s_step = n1, s_end = 1024;
      f32x4 Sn[8];
      if (s_first < s_end) { const int tid_ = launder(threadIdx.x); const float* sn = p.sd + ((size_t)s_first * 128 + (tid_ >> 5) * 8) * 128 + (tid_ & 31) * 4;
#pragma unroll
        for (int kk = 0; kk < 8; ++kk) Sn[kk] = ldnt4(sn + kk * 128); }
      for (int s = s_first; s < s_end; s += s_step) sample_seq(p, s, Sn, s + s_step < s_end ? s + s_step : -1);
    }
#endif
  }
}

__device__ void phase4(const Params& p) {
  extern __shared__ __attribute__((aligned(16))) unsigned char smem[];
  Sched S; S.init_strided(blockIdx.x, gridDim.x, 256); gemm_phase<2>(p, (LAS unsigned char*)smem, p.QKV + 2048, QW, p.WOB, S);
  gemm_tail<2>(p, p.QKV + 2048, QW, p.WOB, 256, 8);
}
__device__ void phase5(const Params& p) {
  extern __shared__ __attribute__((aligned(16))) unsigned char smem[];
  Sched S; S.init_strided(blockIdx.x, gridDim.x, 256);
  gemm_phase<4>(p, (LAS unsigned char*)smem, p.UW, DM, p.WO, S);
  gemm_tail<3>(p, p.UW, DM, p.WO, 256, 8);
}
__device__ void phase6(const Params& p) {
  const int tid = launder(threadIdx.x), wid = tid >> 6, lane = tid & 63, G = gridDim.x;
  f32x4 w[4];
#pragma unroll
  for (int i = 0; i < 4; ++i) w[i] = *(const f32x4*)(p.fnw + i * 256 + lane * 4);
  const int row_lo = (G == 256) ? NTP : 0;
#pragma unroll 1
  for (int row = row_lo + (blockIdx.x * 8 + wid) * 4; row < NT; row += G * 8 * 4) {
    f32x4 v[4][4];
#pragma unroll
    for (int q = 0; q < 4; ++q)
#pragma unroll
      for (int i = 0; i < 4; ++i) v[q][i] = *(const f32x4*)(p.out + (size_t)(row + q) * DM + i * 256 + lane * 4);
#pragma unroll
    for (int q = 0; q < 4; ++q) {
      float ss = 0.f;
#pragma unroll
      for (int i = 0; i < 4; ++i) ss += (v[q][i].x * v[q][i].x + v[q][i].y * v[q][i].y) + (v[q][i].z * v[q][i].z + v[q][i].w * v[q][i].w);
      ss = wave_sum(ss);
      const float rstd = rsqrtf(ss * (1.f / DM) + EPS);
#pragma unroll
      for (int i = 0; i < 4; ++i) *(f32x4*)(p.out + (size_t)(row + q) * DM + i * 256 + lane * 4) = v[q][i] * rstd * w[i];
    }
  }
}

#define XB_TMO      128
#define XB_XCNT(j)  (256  + 64 * (j))
#define XB_XSUB(j)  (1280 + 64 * (j))
#define XB_XGEN(j)  (2304 + 64 * (j))
#define XB_TOP      3328
#define XB_TOPGEN   3392
#define XCD_BAR_WORDS 3456
#define XB_SPIN_CAP (1u << 18)
DI unsigned xb_ld(unsigned* p) { return __hip_atomic_load(p, __ATOMIC_RELAXED, __HIP_MEMORY_SCOPE_AGENT); }
DI unsigned xb_add(unsigned* p, unsigned v) { return __hip_atomic_fetch_add(p, v, __ATOMIC_RELAXED, __HIP_MEMORY_SCOPE_AGENT); }
DI unsigned xb_xcc_id() { return (unsigned)__builtin_amdgcn_s_getreg((3 << 11) | 20) & 0xFu; }
#define XB_SPIN(cond, bar) do { unsigned _sp = 0; while (cond) { __builtin_amdgcn_s_sleep(1); \
    if ((++_sp & 255u) == 0u) { if (xb_ld(&(bar)[XB_TMO])) break; if (_sp > XB_SPIN_CAP) { atomicAdd(&(bar)[XB_TMO], 1u); break; } } } } while (0)
struct XcdBarrier { unsigned* bar; unsigned x; volatile LAS unsigned* st; };
DI XcdBarrier xcd_barrier_post(unsigned* bar, volatile LAS unsigned* st) {
  XcdBarrier b; b.bar = bar; b.x = xb_xcc_id(); b.st = st;
  if (threadIdx.x == 0) (void)xb_add(&bar[XB_XCNT(b.x)], 1u);
  return b;
}
DI void xcd_barrier_complete(unsigned* bar, unsigned x, unsigned& nloc, unsigned& nx) {
  const unsigned G = gridDim.x * gridDim.y * gridDim.z;
  unsigned sum, cnt, mine, sp = 0u;
  for (;;) {
    sum = 0u; cnt = 0u; mine = 0u;
#pragma unroll
    for (unsigned j = 0; j < 16; ++j) { const unsigned c = xb_ld(&bar[XB_XCNT(j)]); sum += c; cnt += (c > 0u) ? 1u : 0u; mine = (j == x) ? c : mine; }
    if (sum == G) break;
    __builtin_amdgcn_s_sleep(1);
    if ((++sp & 255u) == 0u) { if (xb_ld(&bar[XB_TMO])) break; if (sp > XB_SPIN_CAP) { atomicAdd(&bar[XB_TMO], 1u); break; } }
  }
  nloc = mine > 0u ? mine : 1u; nx = cnt > 0u ? cnt : 1u;
}
DI void xcd_barrier(const XcdBarrier& b) {
  asm volatile("s_waitcnt vmcnt(0)" ::: "memory");
  __syncthreads();
  if (threadIdx.x == 0) {
    unsigned* bar = b.bar;
    __builtin_amdgcn_s_waitcnt(0);
    unsigned nloc = b.st[0], nx = b.st[1];
    if (nloc == 0u) { xcd_barrier_complete(bar, b.x, nloc, nx); b.st[0] = nloc; b.st[1] = nx; }
    const unsigned old = xb_add(&bar[XB_XSUB(b.x)], 1u);
    const unsigned gen = old / nloc;
    if (old + 1u == (gen + 1u) * nloc) {
      __builtin_amdgcn_fence(__ATOMIC_RELEASE, "agent");
      asm volatile("s_waitcnt vmcnt(0)" ::: "memory");
      const unsigned og = xb_add(&bar[XB_TOP], 1u);
      const unsigned tg = og / nx;
      if (og + 1u == (tg + 1u) * nx) xb_add(&bar[XB_TOPGEN], 1u);
      else XB_SPIN(xb_ld(&bar[XB_TOPGEN]) == tg, bar);
      __builtin_amdgcn_fence(__ATOMIC_ACQUIRE, "agent");
      xb_add(&bar[XB_XGEN(b.x)], 1u);
      asm volatile("s_waitcnt vmcnt(0)" ::: "memory");
    } else {
      XB_SPIN(xb_ld(&bar[XB_XGEN(b.x)]) == gen, bar);
      __builtin_amdgcn_fence(__ATOMIC_ACQUIRE, "agent");
      asm volatile("s_waitcnt vmcnt(0)" ::: "memory");
    }
  }
  __syncthreads();
}

__global__ void __launch_bounds__(512, 2) mega(Params p, int ph_lo, int ph_hi) {
  cg::grid_group grid = cg::this_grid();
  const int lo = ph_lo, hi = ph_hi;
  extern __shared__ __attribute__((aligned(16))) unsigned char smem[];
  volatile LAS unsigned* st = (volatile LAS unsigned*)((LAS unsigned char*)smem + 149504);
  if (threadIdx.x < 4) st[threadIdx.x] = 0u;
  __syncthreads();
  XcdBarrier xb; xb.bar = p.bar; xb.x = 0; xb.st = st;
  if (hi - lo > 1) xb = xcd_barrier_post(p.bar, st);
  if (hi > 100) grid.sync();
#define GRID_SYNC() xcd_barrier(xb)
#define IN(k) (lo <= (k) && (k) < hi)
#define BOTH(k) (IN(k) && IN((k) + 1))
  if (IN(0)) { phase0(p); if (BOTH(0)) GRID_SYNC(); }
  if (IN(1)) { phase1(p); if (BOTH(1)) GRID_SYNC(); }
  if (IN(2)) { phase2(p); if (BOTH(2)) GRID_SYNC(); }
  if (IN(3)) { phase3(p); if (BOTH(3)) GRID_SYNC(); }
  if (IN(4)) { phase4(p); if (BOTH(4)) GRID_SYNC(); }
  if (IN(5)) { phase5(p); if (BOTH(5)) GRID_SYNC(); }
  if (IN(6)) { phase6(p); }
}

extern "C" void kernel_launch(void* const* d_in, const int* in_sizes, int n_in, void* d_out, int out_size, void* d_ws, size_t ws_size, hipStream_t stream) {
  static int grid = 0;
  if (grid == 0) {
    int dev = 0, cus = 0, per_cu = 0;
    hipGetDevice(&dev);
    hipDeviceGetAttribute(&cus, hipDeviceAttributeMultiprocessorCount, dev);
    if (hipFuncSetAttribute((const void*)mega, hipFuncAttributeMaxDynamicSharedMemorySize, LDS_BYTES) != hipSuccess) fprintf(stderr, "hipFuncSetAttribute failed\n");
    hipOccupancyMaxActiveBlocksPerMultiprocessor(&per_cu, (const void*)mega, 512, LDS_BYTES);
    if (per_cu < 1) { fprintf(stderr, "occupancy query says %d\n", per_cu); per_cu = 1; }
    (void)hipGetLastError();
    grid = cus;
  }
  Params p{};
  p.x_p = (const float*)d_in[0]; p.x_s = (const float*)d_in[1]; p.sca = (const float*)d_in[2]; p.scq = (const float*)d_in[3]; p.sd = (const float*)d_in[4];
  p.w_in = (const float*)d_in[5]; p.caw = (const float*)d_in[6]; p.cbw = (const float*)d_in[7]; p.a_log = (const float*)d_in[8]; p.dt_bias = (const float*)d_in[9];
  p.onw = (const float*)d_in[10]; p.w_oa = (const float*)d_in[11]; p.w_ob = (const float*)d_in[12]; p.w_o = (const float*)d_in[13]; p.nw = (const float*)d_in[14]; p.fnw = (const float*)d_in[15];
  p.out = (float*)d_out;
  unsigned char* ws = (unsigned char*)d_ws; size_t o = 0;
  auto take = [&](size_t bytes) { unsigned char* r = ws + o; o += (bytes + 255) & ~(size_t)255; return r; };
  p.QKV = (bf16_t*)take((size_t)NT * QW * 2);
  p.SBZ = (bf16_t*)take((size_t)NT * DM * 2);
  p.GATE = (bf16_t*)take((size_t)NT * DM * 2);
  p.UW = (bf16_t*)take((size_t)NT * DM * 2);
  p.AQK = (bf16_t*)take((size_t)2048 * 4096 * 2);
  p.WOA = (bf16_t*)take((size_t)DM * DM * 2); p.WOB = (bf16_t*)take((size_t)DM * DM * 2); p.WO = (bf16_t*)take((size_t)DM * DM * 2);
  p.WB16 = (bf16_t*)take(16 * DM * 2);
  p.BG = (float*)take((size_t)NT * 16 * 4);
  p.DL = (float*)take(2048 * 4);
  p.bar = (unsigned*)take((XCD_BAR_WORDS + 64 * 64) * 4);
  p.RS = (float*)take(64 * 4 * 256 * 4);
  if (o > ws_size) { fprintf(stderr, "workspace too small: need %zu have %zu\n", o, ws_size); return; }
  p.SGA = (bf16_t*)d_out; p.SGB = p.SGA + (size_t)NT * DM;
  unsigned char* nds = (unsigned char*)((float*)d_out + OFF_ND_S);
  p.WIN = (bf16_t*)nds; p.P = (bf16_t*)(nds + (size_t)10240 * DM * 2); p.HALO = (bf16_t*)(nds + (size_t)10240 * DM * 2 + (size_t)NT * DM * 2);
#if COOP
  if (hipMemsetAsync(p.bar, 0, (XCD_BAR_WORDS + 64 * 64) * 4, stream) != hipSuccess) fprintf(stderr, "memset of barrier words failed\n");
  int lo = 0, hi = 7; void* args[] = {&p, &lo, &hi};
  hipError_t e = hipLaunchCooperativeKernel((const void*)mega, dim3(grid), dim3(512), args, LDS_BYTES, stream);
  if (e != hipSuccess) fprintf(stderr, "cooperative launch failed: %s\n", hipGetErrorString(e));
#else
  for (int ph = 0; ph < 7; ++ph) { hipLaunchKernelGGL(mega, dim3(grid), dim3(512), LDS_BYTES, stream, p, ph, ph + 1); if (ph == DUP) hipLaunchKernelGGL(mega, dim3(grid), dim3(512), LDS_BYTES, stream, p, ph, ph + 1); }
#endif
}
```

```cpp
#include <hip/hip_runtime.h>
#include <hip/hip_cooperative_groups.h>
#include <cstdio>
#include <cstdint>
namespace cg = cooperative_groups;

#ifndef COOP
#define COOP 1
#endif
#ifndef DUP
#define DUP -1
#endif

typedef unsigned short bf16_t;
typedef short bf16x8 __attribute__((ext_vector_type(8)));
typedef float f32x4 __attribute__((ext_vector_type(4)));
typedef float f32x2 __attribute__((ext_vector_type(2)));
typedef float f32x16 __attribute__((ext_vector_type(16)));
typedef unsigned u32x4 __attribute__((ext_vector_type(4)));
typedef unsigned u32x2 __attribute__((ext_vector_type(2)));
typedef __bf16 bf16x2_t __attribute__((ext_vector_type(2)));

#define DI __device__ __forceinline__

constexpr int NT = 16896, NTP = 16384, DM = 1024, QW = 3072, NIN = 10256;
constexpr float EPS = 1e-6f;
constexpr size_t OFF_NCA_P = 17301504, OFF_NCQ_P = 17317888, OFF_ND_P = 17391616, OFF_NCA_S = 18440192, OFF_NCQ_S = 18702336, OFF_ND_S = 19881984;
constexpr int LDS_BYTES = 149504 + 16;

struct Params {
  const float *x_p, *x_s, *sca, *scq, *sd, *w_in, *caw, *cbw, *a_log, *dt_bias, *onw, *w_oa, *w_ob, *w_o, *nw, *fnw;
  float* out;
  bf16_t *QKV, *SBZ, *GATE, *UW, *AQK, *WOA, *WOB, *WO, *WB16;
  float *BG, *DL;
  bf16_t *SGA, *SGB, *WIN, *P, *HALO;
  unsigned* bar;
  float* RS;
};

DI unsigned pk2(float a, float b) { bf16x2_t v = __builtin_convertvector((f32x2){a, b}, bf16x2_t); return __builtin_bit_cast(unsigned, v); }
DI float bflo(unsigned w) { return __uint_as_float(w << 16); }
DI float bfhi(unsigned w) { return __uint_as_float(w & 0xffff0000u); }
DI float bf2f(bf16_t v) { return __uint_as_float(((unsigned)v) << 16); }
DI float siluf(float x) { return x * __builtin_amdgcn_rcpf(1.f + __expf(-x)); }
DI float sigmf(float x) { return __builtin_amdgcn_rcpf(1.f + __expf(-x)); }
DI f32x4 ldnt4(const float* q) { return __builtin_nontemporal_load((const f32x4*)q); }
DI void stnt4(float* q, f32x4 v) { __builtin_nontemporal_store(v, (f32x4*)q); }
DI float wave_sum(float v) {
#pragma unroll
  for (int o = 1; o < 64; o <<= 1) v += __shfl_xor(v, o);
  return v;
}
DI void unpack8(u32x4 w, float* f) { f[0] = bflo(w.x); f[1] = bfhi(w.x); f[2] = bflo(w.y); f[3] = bfhi(w.y); f[4] = bflo(w.z); f[5] = bfhi(w.z); f[6] = bflo(w.w); f[7] = bfhi(w.w); }
DI u32x4 pack8(const float* f) { u32x4 w; w.x = pk2(f[0], f[1]); w.y = pk2(f[2], f[3]); w.z = pk2(f[4], f[5]); w.w = pk2(f[6], f[7]); return w; }

DI int perm32(int rho) { const int n = rho >> 4, i = rho & 15; return 8 * (i >> 2) + 4 * n + (i & 3); }
DI int colmap_in(int R) {
  const int pn = R >> 8, l = R & 255, bj = l >> 7, wc = (l & 127) >> 5, rho = l & 31;
  if (pn < 16) { const int n = rho >> 4, i = rho & 15; return (bj * 2 + n) * 1024 + 64 * pn + wc * 16 + i; }
  const int base = pn < 32 ? 4096 + (pn - 16) * 256 : 8208 + (pn - 32) * 256;
  return base + bj * 128 + wc * 32 + perm32(rho);
}
DI int colmap_sq(int R) { return (R & ~31) + perm32(R & 31); }

constexpr int BM = 256, BK = 64, HALF = 128, NXCD = 8, WGM = 8, HT = HALF * BK;
DI void lds_barrier() { asm volatile("s_waitcnt lgkmcnt(0)" ::: "memory"); __builtin_amdgcn_s_barrier(); asm volatile("" ::: "memory"); }
DI int launder(int x) { asm volatile("" : "+v"(x)); return x; }
DI int lds_byte(int r, int c) { const int st = (r >> 4) * 2 + (c >> 5), rr = r & 15, cc = c & 31, ob = rr * 64 + cc * 2; return st * 1024 + (ob ^ (((ob >> 9) & 1) << 5)); }
DI void stage_rc(int b, int& R, int& C) { const int st = b / 1024, sb = b % 1024, swz = sb ^ (((sb >> 9) & 1) << 5); R = (st >> 1) * 16 + swz / 64; C = (st & 1) * 32 + (swz % 64) / 2; }

struct TileOrder {
  int nM, nN, nwg, G, c;
  DI void init(int M, int N, int G_, int c_) { nM = M / BM; nN = N / BM; nwg = nM * nN; G = G_; c = c_; }
  DI bool next(int i, int& pm, int& pn) const {
    const long L = (long)i * G + c; if (L >= nwg) return false;
    int wgid = (int)L; { const int q = nwg / NXCD, r = nwg % NXCD, xcd = wgid % NXCD, off = wgid / NXCD; wgid = (xcd < r ? xcd * (q + 1) : r * (q + 1) + (xcd - r) * q) + off; }
    const int nig = WGM * nN, gid = wgid / nig, fm = gid * WGM, gsz = (nM - fm) < WGM ? (nM - fm) : WGM;
    pm = fm + ((wgid % nig) % gsz); pn = (wgid % nig) / gsz; return true;
  }
};

#define FN_CNT(pm) (XCD_BAR_WORDS_C + 64 * (pm))
constexpr int XCD_BAR_WORDS_C = 3456;
DI void epilogue_final(const Params& p, f32x4 (&acc)[2][2][4][2], int pm, int pn, int wr, int wc, int fr, int fq, unsigned char* smem_, int tid) {
  float* PS = (float*)(smem_ + 131072);
  float* RSTD = (float*)(smem_ + 131072 + 4096);
  const int col0 = pn * BM + wc * 32 + 8 * fq;
#pragma unroll
  for (int ai = 0; ai < 2; ++ai)
#pragma unroll
    for (int m = 0; m < 4; ++m) {
      const int rl = ai * HALF + wr * 64 + m * 16 + fr; const size_t row = (size_t)pm * BM + rl;
      const float* xr = p.x_p + row * DM;
      float ss = 0.f;
#pragma unroll
      for (int bj = 0; bj < 2; ++bj) {
        const f32x4 x0 = ldnt4(xr + col0 + bj * HALF), x1 = ldnt4(xr + col0 + bj * HALF + 4);
        acc[ai][bj][m][0] += x0; acc[ai][bj][m][1] += x1;
        const f32x4 a = acc[ai][bj][m][0], b = acc[ai][bj][m][1];
        ss += (a.x * a.x + a.y * a.y) + (a.z * a.z + a.w * a.w) + (b.x * b.x + b.y * b.y) + (b.z * b.z + b.w * b.w);
      }
      ss += __shfl_xor(ss, 16); ss += __shfl_xor(ss, 32);
      if (fq == 0) PS[rl * 4 + wc] = ss;
      __builtin_amdgcn_sched_barrier(0);
    }
  lds_barrier();
  unsigned* cnt = p.bar + FN_CNT(pm);
  if (tid < 256) {
    const f32x4 s4 = *(const f32x4*)(PS + tid * 4);
    __hip_atomic_store((unsigned*)p.RS + ((size_t)(pm * 4 + pn) * 256 + tid), __float_as_uint((s4.x + s4.y) + (s4.z + s4.w)), __ATOMIC_RELAXED, __HIP_MEMORY_SCOPE_AGENT);
  }
  asm volatile("s_waitcnt vmcnt(0)" ::: "memory");
  lds_barrier();
  if (tid == 0) __hip_atomic_fetch_add(cnt, 1u, __ATOMIC_RELAXED, __HIP_MEMORY_SCOPE_AGENT);
  if (tid < 64) {
    unsigned sp = 0;
    while ((unsigned)__builtin_amdgcn_readfirstlane(__hip_atomic_load(cnt, __ATOMIC_RELAXED, __HIP_MEMORY_SCOPE_AGENT)) < 4u) { __builtin_amdgcn_s_sleep(2); if (++sp > (1u << 20)) break; }
    __builtin_amdgcn_fence(__ATOMIC_ACQUIRE, "agent");
  }
  asm volatile("s_waitcnt vmcnt(0) lgkmcnt(0)" ::: "memory");
  lds_barrier();
  if (tid < 256) {
    float tot = 0.f;
#pragma unroll
    for (int t = 0; t < 4; ++t) tot += __uint_as_float(__hip_atomic_load((unsigned*)p.RS + ((size_t)(pm * 4 + t) * 256 + tid), __ATOMIC_RELAXED, __HIP_MEMORY_SCOPE_AGENT));
    RSTD[tid] = rsqrtf(tot * (1.f / DM) + EPS);
  }
  lds_barrier();
#pragma unroll
  for (int bj = 0; bj < 2; ++bj) {
    const f32x4 fw0 = *(const f32x4*)(p.fnw + col0 + bj * HALF), fw1 = *(const f32x4*)(p.fnw + col0 + bj * HALF + 4);
#pragma unroll
    for (int ai = 0; ai < 2; ++ai)
#pragma unroll
      for (int m = 0; m < 4; ++m) {
        const int rl = ai * HALF + wr * 64 + m * 16 + fr; const size_t row = (size_t)pm * BM + rl; const float r = RSTD[rl];
        float* o = p.out + row * DM + col0 + bj * HALF;
        stnt4(o, acc[ai][bj][m][0] * r * fw0); stnt4(o + 4, acc[ai][bj][m][1] * r * fw1);
        __builtin_amdgcn_sched_barrier(0);
      }
  }
}

template <int EPI>
DI void epilogue(const Params& p, const f32x4 (&acc)[2][2][4][2], int pm, int pn, int wr, int wc, int fr, int fq) {
  const int row0 = pm * BM + wr * 64 + fr;
  if (EPI == 0) {
    if (pn < 16) {
      const int ch = pn * 64 + wc * 16 + fq * 4;
#pragma unroll
      for (int ai = 0; ai < 2; ++ai)
#pragma unroll
        for (int m = 0; m < 4; ++m) {
          const size_t row = row0 + ai * HALF + m * 16;
          const f32x4 b = acc[ai][0][m][0], c = acc[ai][0][m][1], h = acc[ai][1][m][0], z = acc[ai][1][m][1];
          u32x2 pp, gg;
          pp.x = pk2(c[0] * h[0], c[1] * h[1]); pp.y = pk2(c[2] * h[2], c[3] * h[3]);
          gg.x = pk2(siluf(z[0]) * b[0], siluf(z[1]) * b[1]); gg.y = pk2(siluf(z[2]) * b[2], siluf(z[3]) * b[3]);
          *(u32x2*)(p.P + row * DM + ch) = pp;
          *(u32x2*)(p.GATE + row * DM + ch) = gg;
        }
    } else {
      const int kind = pn < 28 ? 0 : (pn < 32 ? 1 : 2);
      bf16_t* dst; int ld, colt;
      if (kind == 0) { dst = p.QKV; ld = QW; colt = (pn - 16) * 256; }
      else if (kind == 1) { dst = p.SBZ; ld = DM; colt = (pn - 28) * 256; }
      else { dst = pn < 36 ? p.SGA : p.SGB; ld = DM; colt = ((pn - 32) & 3) * 256; }
      const int col0 = colt + wc * 32 + 8 * fq;
#pragma unroll
      for (int ai = 0; ai < 2; ++ai)
#pragma unroll
        for (int m = 0; m < 4; ++m) {
          const int row = row0 + ai * HALF + m * 16;
#pragma unroll
          for (int bj = 0; bj < 2; ++bj) {
            f32x4 v0 = acc[ai][bj][m][0], v1 = acc[ai][bj][m][1];
            if (kind == 1) { for (int j = 0; j < 4; ++j) { v0[j] = siluf(v0[j]); v1[j] = siluf(v1[j]); } }
            if (kind == 2) { for (int j = 0; j < 4; ++j) { v0[j] = sigmf(v0[j]); v1[j] = sigmf(v1[j]); } }
            u32x4 w; w.x = pk2(v0[0], v0[1]); w.y = pk2(v0[2], v0[3]); w.z = pk2(v1[0], v1[1]); w.w = pk2(v1[2], v1[3]);
            *(u32x4*)(dst + (size_t)row * ld + col0 + bj * HALF) = w;
            if (kind == 0 && row < NTP && (row & 63) >= 61)
              *(u32x4*)(p.HALO + ((size_t)(row >> 6) * 3 + ((row & 63) - 61)) * QW + col0 + bj * HALF) = w;
          }
        }
    }
  } else {
    const int col0 = pn * BM + wc * 32 + 8 * fq;
#pragma unroll
    for (int ai = 0; ai < 2; ++ai)
#pragma unroll
      for (int m = 0; m < 4; ++m) {
        const size_t row = row0 + ai * HALF + m * 16;
#pragma unroll
        for (int bj = 0; bj < 2; ++bj) {
          const f32x4 v0 = acc[ai][bj][m][0], v1 = acc[ai][bj][m][1];
          const size_t o = row * DM + col0 + bj * HALF;
          if (EPI == 1) {
            float s[8]; unpack8(*(const u32x4*)(p.SGA + o), s);
            u32x4 w; w.x = pk2(s[0] * v0[0], s[1] * v0[1]); w.y = pk2(s[2] * v0[2], s[3] * v0[3]); w.z = pk2(s[4] * v1[0], s[5] * v1[1]); w.w = pk2(s[6] * v1[2], s[7] * v1[3]);
            *(u32x4*)(p.SGA + o) = w;
          } else if (EPI == 2) {
            float s[8], a[8]; unpack8(*(const u32x4*)(p.SGB + o), s); unpack8(*(const u32x4*)(p.SGA + o), a);
            u32x4 w; w.x = pk2(a[0] + s[0] * v0[0], a[1] + s[1] * v0[1]); w.y = pk2(a[2] + s[2] * v0[2], a[3] + s[3] * v0[3]);
            w.z = pk2(a[4] + s[4] * v1[0], a[5] + s[5] * v1[1]); w.w = pk2(a[6] + s[6] * v1[2], a[7] + s[7] * v1[3]);
            *(u32x4*)(p.UW + o) = w;
          } else {
            const float* xr = row < NTP ? p.x_p + row * DM : p.x_s + (row - NTP) * DM;
            const f32x4 x0 = *(const f32x4*)(xr + col0 + bj * HALF), x1 = *(const f32x4*)(xr + col0 + bj * HALF + 4);
            *(f32x4*)(p.out + o) = x0 + v0; *(f32x4*)(p.out + o + 4) = x1 + v1;
          }
        }
      }
  }
}

#define LAS __attribute__((address_space(3)))
struct Sched {
  int mode, nM, nN, nwg, G, c, start, stride, count;
  DI void init_static(int M, int N, int G_, int c_) { mode = 0; nM = M / BM; nN = N / BM; nwg = nM * nN; G = G_; c = c_; start = stride = count = 0; }
  DI void init_strided(int start_, int stride_, int count_) { mode = 1; start = start_; stride = stride_; count = count_; nM = nN = nwg = G = c = 0; }
  DI bool next(int i, int& pm, int& pn) const {
    if (mode == 0) {
      const long L = (long)i * G + c; if (L >= nwg) return false;
      int wgid = (int)L; { const int q = nwg / NXCD, r = nwg % NXCD, xcd = wgid % NXCD, off = wgid / NXCD; wgid = (xcd < r ? xcd * (q + 1) : r * (q + 1) + (xcd - r) * q) + off; }
      const int nig = WGM * nN, gid = wgid / nig, fm = gid * WGM, gsz = (nM - fm) < WGM ? (nM - fm) : WGM;
      pm = fm + ((wgid % nig) % gsz); pn = (wgid % nig) / gsz; return true;
    }
    const int t = start + i * stride; if (t >= count) return false;
    pm = t >> 2; pn = t & 3; return true;
  }
};

template <int EPI>
DI void gemm_phase(const Params& p, LAS unsigned char* lds, const bf16_t* A, int lda, const bf16_t* Bt, const Sched& S) {
  constexpr int K = 1024, nt = K / BK, HTB = HALF * BK * 2;
  const int tid = launder(threadIdx.x), wid = __builtin_amdgcn_readfirstlane(tid >> 6), lane = tid & 63, wr = wid >> 2, wc = wid & 3, fr = lane & 15, fq = lane >> 4;
  unsigned voffA[2], voffB[2];
#pragma unroll
  for (int i = 0; i < 2; ++i) { int R, C; stage_rc(tid * 16 + i * 8192, R, C); voffA[i] = (unsigned)(R * lda + C) * 2u; voffB[i] = (unsigned)(R * K + C) * 2u; }
  const size_t kstep = (size_t)(BK * 2);
  const size_t hstepA = (size_t)HALF * lda * 2, tstepA = 2 * hstepA, hstepB = (size_t)HALF * K * 2, tstepB = 2 * hstepB;
  const unsigned ldsw = (unsigned)wid * 1024u;
  const int aoff = lds_byte(wr * 64 + fr, fq * 8), boff = lds_byte(wc * 32 + fr, fq * 8);
#define PG8_SA(b, h) (((b) * 2 + (h)) * HTB)
#define PG8_SB(b, h) ((4 + (b) * 2 + (h)) * HTB)
#define PG8_STAGE(bufoff, gbase, voff) do { _Pragma("unroll") for (int _i = 0; _i < 2; ++_i) \
    __builtin_amdgcn_global_load_lds((const unsigned*)((const char*)(gbase) + (voff)[_i]), (LAS unsigned*)(lds + (bufoff) + ldsw + _i * 8192), 16, 0, 0); } while (0)
#define PG8_LDA(dst, b, h) do { _Pragma("unroll") for (int m = 0; m < 4; ++m) _Pragma("unroll") for (int k = 0; k < 2; ++k) dst[m][k] = *(const LAS bf16x8*)(lds + PG8_SA(b, h) + aoff + m * 2048 + k * 1024); } while (0)
#define PG8_LDB(dst, b, h) do { _Pragma("unroll") for (int n = 0; n < 2; ++n) _Pragma("unroll") for (int k = 0; k < 2; ++k) dst[n][k] = *(const LAS bf16x8*)(lds + PG8_SB(b, h) + boff + n * 2048 + k * 1024); } while (0)
#define PG8_MMA(ai, bj, At, Bt_) do { __builtin_amdgcn_s_setprio(1); _Pragma("unroll") for (int m = 0; m < 4; ++m) _Pragma("unroll") for (int n = 0; n < 2; ++n) _Pragma("unroll") for (int k = 0; k < 2; ++k) \
    acc[ai][bj][m][n] = __builtin_amdgcn_mfma_f32_16x16x32_bf16(Bt_[n][k], At[m][k], acc[ai][bj][m][n], 0, 0, 0); __builtin_amdgcn_s_setprio(0); } while (0)
#define PG8_WAIT_V(n) asm volatile("s_waitcnt vmcnt(" #n ")" ::: "memory")
#define PG8_WAIT_L(n) asm volatile("s_waitcnt lgkmcnt(" #n ")" ::: "memory")
#define PG8_BAR __builtin_amdgcn_s_barrier()
#define PG8_SCHED __builtin_amdgcn_sched_barrier(0)
  int cpm, cpn, npm = 0, npn = 0; int ui = 0;
  if (!S.next(0, cpm, cpn)) return;
  f32x4 acc[2][2][4][2];
#pragma unroll
  for (int a = 0; a < 2; ++a)
#pragma unroll
    for (int b = 0; b < 2; ++b)
#pragma unroll
      for (int m = 0; m < 4; ++m)
#pragma unroll
        for (int n = 0; n < 2; ++n) acc[a][b][m][n] = (f32x4){0.f, 0.f, 0.f, 0.f};
  bf16x8 At[4][2], B0[2][2], B1[2][2];
  const char* cA = (const char*)A + (size_t)cpm * tstepA; const char* cB = (const char*)Bt + (size_t)cpn * tstepB;
  PG8_STAGE(PG8_SB(0, 0), cB, voffB); PG8_STAGE(PG8_SB(0, 1), cB + hstepB, voffB); PG8_STAGE(PG8_SA(0, 0), cA, voffA); PG8_STAGE(PG8_SA(0, 1), cA + hstepA, voffA);
  if (wr == 1) PG8_BAR;
  PG8_WAIT_V(2); PG8_BAR;
  PG8_STAGE(PG8_SB(1, 0), cB + kstep, voffB); PG8_STAGE(PG8_SA(1, 0), cA + kstep, voffA); PG8_STAGE(PG8_SB(1, 1), cB + hstepB + kstep, voffB);
  PG8_WAIT_V(6); PG8_BAR;
  for (;;) {
    const bool has_next = S.next(ui + 1, npm, npn);
    const char* nA = has_next ? (const char*)A + (size_t)npm * tstepA : cA; const char* nB = has_next ? (const char*)Bt + (size_t)npn * tstepB : cB;
#pragma unroll 1
    for (int t = 0; t < nt; t += 2) {
      const bool last = (t == nt - 2);
      const char* a1 = cA + (size_t)(t + 1) * kstep;
      const char* a2 = last ? nA : cA + (size_t)(t + 2) * kstep; const char* b2 = last ? nB : cB + (size_t)(t + 2) * kstep;
      const char* a3 = a2 + kstep; const char* b3 = b2 + kstep;
      PG8_LDB(B0, 0, 0); PG8_LDB(B1, 0, 1); PG8_SCHED; PG8_LDA(At, 0, 0); PG8_STAGE(PG8_SA(1, 1), a1 + hstepA, voffA);
      PG8_WAIT_V(8); PG8_WAIT_L(0); PG8_BAR; PG8_MMA(0, 0, At, B0); PG8_MMA(0, 1, At, B1); PG8_BAR; PG8_SCHED;
      PG8_LDA(At, 0, 1); PG8_STAGE(PG8_SB(0, 0), b2, voffB); PG8_STAGE(PG8_SB(0, 1), b2 + hstepB, voffB); PG8_STAGE(PG8_SA(0, 0), a2, voffA);
      PG8_WAIT_V(8); PG8_WAIT_L(0); PG8_BAR; PG8_MMA(1, 0, At, B0); PG8_MMA(1, 1, At, B1); PG8_BAR; PG8_SCHED;
      PG8_LDB(B0, 1, 0); PG8_LDB(B1, 1, 1); PG8_SCHED; PG8_LDA(At, 1, 0); PG8_STAGE(PG8_SA(0, 1), a2 + hstepA, voffA);
      PG8_WAIT_V(8); PG8_WAIT_L(0); PG8_BAR; PG8_MMA(0, 0, At, B0); PG8_MMA(0, 1, At, B1); PG8_BAR; PG8_SCHED;
      PG8_LDA(At, 1, 1); PG8_STAGE(PG8_SB(1, 0), b3, voffB); PG8_STAGE(PG8_SB(1, 1), b3 + hstepB, voffB); PG8_STAGE(PG8_SA(1, 0), a3, voffA);
      PG8_WAIT_V(8); PG8_WAIT_L(0); PG8_BAR; PG8_MMA(1, 0, At, B0); PG8_MMA(1, 1, At, B1); PG8_BAR; PG8_SCHED;
    }
    if (wr == 0) PG8_BAR;
    if (!(EPI == 4 && gridDim.x == 256)) epilogue<EPI == 4 ? 3 : EPI>(p, acc, cpm, cpn, wr, wc, fr, fq);
    if (!has_next) break;
#pragma unroll
    for (int a = 0; a < 2; ++a)
#pragma unroll
      for (int b = 0; b < 2; ++b)
#pragma unroll
        for (int m = 0; m < 4; ++m)
#pragma unroll
          for (int n = 0; n < 2; ++n) acc[a][b][m][n] = (f32x4){0.f, 0.f, 0.f, 0.f};
    cpm = npm; cpn = npn; cA = nA; cB = nB; ++ui;
    if (wr == 1) PG8_BAR;
  }
  PG8_WAIT_V(0);
  PG8_BAR;
  if (EPI == 4 && gridDim.x == 256) epilogue_final(p, acc, cpm, cpn, wr, wc, fr, fq, (unsigned char*)lds, tid);
#undef PG8_SA
#undef PG8_SB
#undef PG8_STAGE
#undef PG8_LDA
#undef PG8_LDB
#undef PG8_MMA
}

template <int EPI>
DI void gemm_tail(const Params& p, const bf16_t* A, int lda, const bf16_t* Bt, int tile0, int ntiles) {
  const int tid = launder(threadIdx.x), wid = tid >> 6, lane = tid & 63, fr = lane & 15, fq = lane >> 4;
  for (int q = blockIdx.x; q < ntiles * 32; q += gridDim.x) {
    const int t = tile0 + (q >> 5), sub = q & 31, pm = t >> 2, pn = t & 3;
    const int row0 = pm * 256 + (sub >> 3) * 64 + (wid >> 1) * 16, R0 = pn * 256 + (sub & 7) * 32 + (wid & 1) * 16;
    const bf16_t* ap = A + (size_t)(row0 + fr) * lda + fq * 8; const bf16_t* bp = Bt + (size_t)(R0 + fr) * DM + fq * 8;
    f32x4 acc = {0.f, 0.f, 0.f, 0.f};
#pragma unroll 16
    for (int ks = 0; ks < 32; ++ks) { const bf16x8 a = *(const bf16x8*)(ap + ks * 32), b = *(const bf16x8*)(bp + ks * 32); acc = __builtin_amdgcn_mfma_f32_16x16x32_bf16(b, a, acc, 0, 0, 0); }
    const size_t row = row0 + fr; const int col0 = (R0 & ~31) + 8 * fq + 4 * ((R0 >> 4) & 1);
    const size_t o = row * DM + col0;
    if (EPI == 2) {
      const u32x2 sw = *(const u32x2*)(p.SGB + o), aw = *(const u32x2*)(p.SGA + o);
      u32x2 w; w.x = pk2(bflo(aw.x) + bflo(sw.x) * acc[0], bfhi(aw.x) + bfhi(sw.x) * acc[1]); w.y = pk2(bflo(aw.y) + bflo(sw.y) * acc[2], bfhi(aw.y) + bfhi(sw.y) * acc[3]);
      *(u32x2*)(p.UW + o) = w;
    } else {
      const float* xr = row < NTP ? p.x_p + row * DM : p.x_s + (row - NTP) * DM;
      *(f32x4*)(p.out + o) = *(const f32x4*)(xr + col0) + acc;
    }
  }
}

DI void wtile_desc(const Params& p, int tile, const float*& src, bf16_t*& dst, int& N, int& kt, int& R0, int& kind) {
  if (tile < 2560) { src = p.w_in; dst = p.WIN; N = NIN; kt = tile & 15; R0 = (tile >> 4) * 64; kind = 0; }
  else { const int t2 = tile - 2560, mat = t2 >> 8; src = mat == 0 ? p.w_oa : (mat == 1 ? p.w_ob : p.w_o); dst = mat == 0 ? p.WOA : (mat == 1 ? p.WOB : p.WO); N = DM; kt = t2 & 15; R0 = ((t2 & 255) >> 4) * 64; kind = 1; }
}
DI void convert_tiles(const Params& p, int first, int end, int stride) {
  extern __shared__ __attribute__((aligned(16))) unsigned char smem[];
  float* lds = (float*)smem;
  const int tid = launder(threadIdx.x);
#pragma unroll 1
  for (int t0 = first; t0 < end; t0 += 4 * stride) {
    f32x4 v[4][2];
#pragma unroll
    for (int q = 0; q < 4; ++q) {
      const int tile = t0 + q * stride;
      if (tile < end) {
        const float* src; bf16_t* dst; int N, kt, R0, kind; wtile_desc(p, tile, src, dst, N, kt, R0, kind);
        const int r4 = tid & 15, R = R0 + r4 * 4, c = kind == 0 ? colmap_in(R) : colmap_sq(R);
#pragma unroll
        for (int ps = 0; ps < 2; ++ps) v[q][ps] = ldnt4(src + (size_t)(kt * 64 + ps * 32 + (tid >> 4)) * N + c);
      }
    }
#pragma unroll
    for (int q = 0; q < 4; ++q) {
      if (t0 + q * stride < end) {
#pragma unroll
        for (int ps = 0; ps < 2; ++ps) { float* d = lds + q * (64 * 65) + (ps * 32 + (tid >> 4)) * 65 + (tid & 15) * 4; d[0] = v[q][ps].x; d[1] = v[q][ps].y; d[2] = v[q][ps].z; d[3] = v[q][ps].w; }
      }
    }
    lds_barrier();
#pragma unroll
    for (int q = 0; q < 4; ++q) {
      const int tile = t0 + q * stride;
      if (tile < end) {
        const float* src; bf16_t* dst; int N, kt, R0, kind; wtile_desc(p, tile, src, dst, N, kt, R0, kind);
        const int R = tid >> 3, kg = tid & 7; float f[8];
#pragma unroll
        for (int i = 0; i < 8; ++i) f[i] = lds[q * (64 * 65) + (kg * 8 + i) * 65 + R];
        *(u32x4*)(dst + (size_t)(R0 + R) * DM + kt * 64 + kg * 8) = pack8(f);
      }
    }
    lds_barrier();
  }
}

__device__ void phase0(const Params& p) {
  extern __shared__ __attribute__((aligned(16))) unsigned char smem[];
  float* lds = (float*)smem;
  const int tid = threadIdx.x, wid = tid >> 6, lane = tid & 63, G = gridDim.x;
  {
    f32x4 w[4];
#pragma unroll
    for (int i = 0; i < 4; ++i) w[i] = *(const f32x4*)(p.nw + i * 256 + lane * 4);
#pragma unroll 1
    for (int row = (blockIdx.x * 8 + wid) * 4; row < NT; row += G * 8 * 4) {
      f32x4 v[4][4];
#pragma unroll
      for (int q = 0; q < 4; ++q) { const int r = row + q; const float* xr = r < NTP ? p.x_p + (size_t)r * DM : p.x_s + (size_t)(r - NTP) * DM;
#pragma unroll
        for (int i = 0; i < 4; ++i) v[q][i] = ldnt4(xr + i * 256 + lane * 4); }
#pragma unroll
      for (int q = 0; q < 4; ++q) {
        float ss = 0.f;
#pragma unroll
        for (int i = 0; i < 4; ++i) ss += (v[q][i].x * v[q][i].x + v[q][i].y * v[q][i].y) + (v[q][i].z * v[q][i].z + v[q][i].w * v[q][i].w);
        ss = wave_sum(ss);
        const float rstd = rsqrtf(ss * (1.f / DM) + EPS);
#pragma unroll
        for (int i = 0; i < 4; ++i) { u32x2 o; o.x = pk2(v[q][i].x * rstd * w[i].x, v[q][i].y * rstd * w[i].y); o.y = pk2(v[q][i].z * rstd * w[i].z, v[q][i].w * rstd * w[i].w);
          *(u32x2*)(p.UW + (size_t)(row + q) * DM + i * 256 + lane * 4) = o; }
      }
    }
  }
  convert_tiles(p, blockIdx.x, 2560, G);
  for (int idx = blockIdx.x * 512 + tid; idx < 16 * DM; idx += G * 512) { const int c = idx >> 10, k = idx & 1023; p.WB16[idx] = (bf16_t)(pk2(p.w_in[(size_t)k * NIN + 8192 + c], 0.f) & 0xffffu); }
}

__device__ void phase1(const Params& p) {
  const int G = gridDim.x;
  { extern __shared__ __attribute__((aligned(16))) unsigned char smem[];
    Sched S; S.init_static(NT, 10240, G, blockIdx.x); gemm_phase<0>(p, (LAS unsigned char*)smem, p.UW, DM, p.WIN, S); }
  const int nfull = G == 256 ? 80 : 0, nside = G - nfull, sidx = (int)blockIdx.x - nfull;
  if (sidx >= 0) convert_tiles(p, 2560 + sidx, 2560 + 768, nside);
  const int tid = launder(threadIdx.x), wid = tid >> 6, lane = tid & 63, fr = lane & 15, fq = lane >> 4;
  if (sidx >= 0)
  for (int task = sidx * 8 + wid; task < NT / 16; task += nside * 8) {
    const int base = task * 16; f32x4 acc = {0.f, 0.f, 0.f, 0.f};
    const bf16_t* ap = p.UW + (size_t)(base + fr) * DM + fq * 8; const bf16_t* bp = p.WB16 + fr * DM + fq * 8;
#pragma unroll 8
    for (int ks = 0; ks < 32; ++ks) { const bf16x8 a = *(const bf16x8*)(ap + ks * 32), b = *(const bf16x8*)(bp + ks * 32); acc = __builtin_amdgcn_mfma_f32_16x16x32_bf16(a, b, acc, 0, 0, 0); }
    const int c = fr, h = c & 7; const float na = -__expf(p.a_log[h]), db = p.dt_bias[h];
#pragma unroll
    for (int j = 0; j < 4; ++j) {
      const int tok = base + fq * 4 + j; const float v = acc[j]; float r;
      if (c < 8) r = sigmf(v); else { const float xx = v + db; r = na * (xx > 20.f ? xx : log1pf(__expf(xx))); }
      p.BG[(size_t)tok * 16 + c] = r;
    }
  }
}

DI u32x4 raw_unit_load(const Params& p, int cgi, int h, int u) {
  const int r = u / 48, rem = u % 48, part = rem >> 4, c8 = rem & 15;
  u32x4 v = {0u, 0u, 0u, 0u};
  if (r < 3) { if ((cgi & 31) > 0) v = *(const u32x4*)(p.HALO + ((size_t)(cgi - 1) * 3 + r) * QW + part * 1024 + h * 128 + c8 * 8); }
  else v = *(const u32x4*)(p.QKV + (size_t)(cgi * 64 + r - 3) * QW + part * 1024 + h * 128 + c8 * 8);
  return v;
}
DI int crow(int r, int lh) { return (r & 3) + 8 * (r >> 2) + 4 * lh; }
DI bf16x8 packfrag(const f32x16& x, int s) {
  u32x4 w; w.x = pk2(x[8 * s], x[8 * s + 1]); w.y = pk2(x[8 * s + 2], x[8 * s + 3]); w.z = pk2(x[8 * s + 4], x[8 * s + 5]); w.w = pk2(x[8 * s + 6], x[8 * s + 7]);
  return __builtin_bit_cast(bf16x8, w);
}
DI bf16x8 ld_permk(const bf16_t* rowp, int s, int lh) {
  const u32x2 a = *(const u32x2*)(rowp + 16 * s + 4 * lh), b = *(const u32x2*)(rowp + 16 * s + 8 + 4 * lh);
  u32x4 w; w.x = a.x; w.y = a.y; w.z = b.x; w.w = b.y; return __builtin_bit_cast(bf16x8, w);
}

DI void chunk_task(const Params& p, int cgi, int h, u32x4 (&pre)[7], float& pg, float& pb, int next_cgi, int next_h, bool has_next) {
  extern __shared__ __attribute__((aligned(16))) unsigned char smem[];
  bf16_t* raw = (bf16_t*)smem;
  bf16_t* qh = (bf16_t*)(smem + 52736);
  bf16_t* kh = (bf16_t*)(smem + 70144);
  bf16_t* vh = (bf16_t*)(smem + 87552);
  float* Mm = (float*)(smem + 104960);
  bf16_t* M10n = (bf16_t*)(smem + 121344);
  bf16_t* Tb = (bf16_t*)(smem + 123904);
  float* gcs = (float*)(smem + 129024);
  float* bet = (float*)(smem + 129280);
  float* rsk = (float*)(smem + 129536);
  const float* cw = (const float*)(smem + 129792);
  const int tid = launder(threadIdx.x), wid = tid >> 6, lane = tid & 63;
  const int n = cgi & 31, b = cgi >> 5, T0 = cgi * 64, ci = cgi * 8 + h;
#pragma unroll
  for (int k = 0; k < 7; ++k) { const int u = k * 512 + tid; if (u < 67 * 48) { const int r = u / 48, rem = u % 48; *(u32x4*)(raw + r * 392 + (rem >> 4) * 128 + (rem & 15) * 8) = pre[k]; } }
  if (has_next) {
#pragma unroll
    for (int k = 0; k < 7; ++k) { const int u = k * 512 + tid; if (u < 67 * 48) pre[k] = raw_unit_load(p, next_cgi, next_h, u); }
  }
  if (wid == 0) {
    float g = pg; const float be = pb;
    if (has_next) { pg = p.BG[(size_t)(next_cgi * 64 + lane) * 16 + 8 + next_h]; pb = p.BG[(size_t)(next_cgi * 64 + lane) * 16 + next_h]; }
#pragma unroll
    for (int o = 1; o < 64; o <<= 1) { const float t = __shfl_up(g, o); if (lane >= o) g += t; }
    gcs[lane] = g; bet[lane] = be; rsk[lane] = be * __expf(g);
  }
  lds_barrier();
  const float glast = gcs[63];
#pragma unroll 1
  for (int part = 0; part < 3; ++part) {
    const int c8 = tid & 15, row = (tid >> 4) * 2;
    f32x2 w2[4][4];
#pragma unroll
    for (int j = 0; j < 4; ++j) { const f32x4 wa = *(const f32x4*)(cw + (part * 4 + j) * 128 + c8 * 8), wb = *(const f32x4*)(cw + (part * 4 + j) * 128 + c8 * 8 + 4);
      w2[j][0] = (f32x2){wa.x, wa.y}; w2[j][1] = (f32x2){wa.z, wa.w}; w2[j][2] = (f32x2){wb.x, wb.y}; w2[j][3] = (f32x2){wb.z, wb.w}; }
    f32x2 a2[2][4];
#pragma unroll
    for (int k = 0; k < 4; ++k) { a2[0][k] = (f32x2){0.f, 0.f}; a2[1][k] = (f32x2){0.f, 0.f}; }
#pragma unroll
    for (int rr = 0; rr < 5; ++rr) {
      const u32x4 xw = *(const u32x4*)(raw + (row + rr) * 392 + part * 128 + c8 * 8);
      f32x2 x2[4]; x2[0] = (f32x2){bflo(xw.x), bfhi(xw.x)}; x2[1] = (f32x2){bflo(xw.y), bfhi(xw.y)}; x2[2] = (f32x2){bflo(xw.z), bfhi(xw.z)}; x2[3] = (f32x2){bflo(xw.w), bfhi(xw.w)};
#pragma unroll
      for (int q = 0; q < 2; ++q) { const int j = rr - q; if (j >= 0 && j < 4) {
#pragma unroll
        for (int k = 0; k < 4; ++k) a2[q][k] = x2[k] * w2[j][k] + a2[q][k]; } }
    }
#pragma unroll
    for (int q = 0; q < 2; ++q) {
      f32x2 s2 = {0.f, 0.f};
#pragma unroll
      for (int k = 0; k < 4; ++k) {
        const f32x2 t = a2[q][k] * (-1.4426950408889634f);
        f32x2 d; d.x = __builtin_amdgcn_exp2f(t.x); d.y = __builtin_amdgcn_exp2f(t.y); d = d + 1.0f;
        f32x2 r; r.x = __builtin_amdgcn_rcpf(d.x); r.y = __builtin_amdgcn_rcpf(d.y);
        a2[q][k] = a2[q][k] * r; s2 = a2[q][k] * a2[q][k] + s2;
      }
      float ss = s2.x + s2.y;
      ss += __shfl_xor(ss, 1); ss += __shfl_xor(ss, 2); ss += __shfl_xor(ss, 4); ss += __shfl_xor(ss, 8);
      if (part < 2) { const float sc = rsqrtf(ss + EPS) * (part == 0 ? 0.08838834764831845f : 1.f);
#pragma unroll
        for (int k = 0; k < 4; ++k) a2[q][k] = a2[q][k] * sc; }
      bf16_t* dstl = part == 0 ? qh : (part == 1 ? kh : vh);
      { u32x4 o; o.x = pk2(a2[q][0].x, a2[q][0].y); o.y = pk2(a2[q][1].x, a2[q][1].y); o.z = pk2(a2[q][2].x, a2[q][2].y); o.w = pk2(a2[q][3].x, a2[q][3].y);
        *(u32x4*)(dstl + (row + q) * 136 + c8 * 8) = o; }
      if (part == 0) { const float eg = __expf(gcs[row + q]);
#pragma unroll
        for (int k = 0; k < 4; ++k) a2[q][k] = a2[q][k] * eg;
        u32x4 o; o.x = pk2(a2[q][0].x, a2[q][0].y); o.y = pk2(a2[q][1].x, a2[q][1].y); o.z = pk2(a2[q][2].x, a2[q][2].y); o.w = pk2(a2[q][3].x, a2[q][3].y);
        *(u32x4*)(p.QKV + (size_t)(T0 + row + q) * QW + h * 128 + c8 * 8) = o; }
    }
  }
  if (n == 31) {
    for (int u = tid; u < 3 * 384; u += 512) { const int j = u / 384, cc = u % 384, part = cc >> 7, col = cc & 127;
      p.out[OFF_NCQ_P + ((size_t)b * 3 + j) * QW + part * 1024 + h * 128 + col] = bf2f(raw[(64 + j) * 392 + cc]); }
  }
  lds_barrier();
  {
    const int fr = lane & 15, fq = lane >> 4, wq = wid & 3; const bool isq = wid >= 4;
    const bf16_t* Y = isq ? qh : kh;
#pragma unroll 1
    for (int bidx = wq; bidx < 10; bidx += 4) {
      const int ib = bidx >= 6 ? 3 : (bidx >= 3 ? 2 : (bidx >= 1 ? 1 : 0)), jb = bidx - (ib * (ib + 1)) / 2;
      const int i = ib * 16 + fr; const float gi = gcs[i], bi = bet[i];
      f32x4 d = {0.f, 0.f, 0.f, 0.f};
#pragma unroll
      for (int ks = 0; ks < 4; ++ks) {
        const bf16x8 xa = *(const bf16x8*)(kh + (jb * 16 + fr) * 136 + ks * 32 + fq * 8), yb = *(const bf16x8*)(Y + (ib * 16 + fr) * 136 + ks * 32 + fq * 8);
        d = __builtin_amdgcn_mfma_f32_16x16x32_bf16(xa, yb, d, 0, 0, 0);
      }
      const int j0 = jb * 16 + fq * 4; float r[4];
#pragma unroll
      for (int jj = 0; jj < 4; ++jj) { const int j = j0 + jj; const bool keep = isq ? (i >= j) : (i > j); r[jj] = keep ? d[jj] * __expf(gi - gcs[j]) * (isq ? 1.f : bi) : 0.f; }
      if (isq) { u32x2 w; w.x = pk2(r[0], r[1]); w.y = pk2(r[2], r[3]); *(u32x2*)(p.AQK + (size_t)ci * 4096 + i * 64 + j0) = w; }
      else {
        *(f32x4*)(Mm + i * 64 + j0) = (f32x4){r[0], r[1], r[2], r[3]};
        if (ib >= 2 && jb < 2) { u32x2 w; w.x = pk2(-r[0], -r[1]); w.y = pk2(-r[2], -r[3]); *(u32x2*)(M10n + (i - 32) * 40 + j0) = w; }
      }
    }
    if (isq) {
      for (int u = wq; u < 6; u += 4) { const int ib = u < 3 ? 0 : (u < 5 ? 1 : 2), jb = u < 3 ? u + 1 : (u < 5 ? u - 1 : 3);
        *(u32x2*)(p.AQK + (size_t)ci * 4096 + (ib * 16 + fr) * 64 + jb * 16 + fq * 4) = (u32x2){0u, 0u}; }
    }
  }
  lds_barrier();
  if (wid == 0) {
    const int blk = lane >> 5, c = lane & 31; const float* Mb = Mm + (blk * 32) * 64 + blk * 32;
    float X[32];
    f32x4 mb[2][8];
#pragma unroll
    for (int r = 0; r < 32; ++r) {
      if (r + 1 < 32) {
#pragma unroll
        for (int j4 = 0; j4 < (r + 4) / 4; ++j4) mb[(r + 1) & 1][j4] = *(const f32x4*)(Mb + (r + 1) * 64 + j4 * 4);
      }
      float s0 = (r == c) ? 1.f : 0.f, s1 = 0.f;
#pragma unroll
      for (int j4 = 0; j4 < (r + 3) / 4; ++j4) {
        const f32x4 m = mb[r & 1][j4];
        if (j4 * 4 + 0 < r) s0 -= m.x * X[j4 * 4 + 0];
        if (j4 * 4 + 1 < r) s1 -= m.y * X[j4 * 4 + 1];
        if (j4 * 4 + 2 < r) s0 -= m.z * X[j4 * 4 + 2];
        if (j4 * 4 + 3 < r) s1 -= m.w * X[j4 * 4 + 3];
      }
      X[r] = s0 + s1;
    }
#pragma unroll
    for (int r = 0; r < 32; ++r) Tb[(blk * 32 + r) * 40 + c] = (bf16_t)(pk2(X[r], 0.f) & 0xffffu);
  } else {
    for (int u = tid - 64; u < 1024; u += 448) {
      const int i8 = u & 7, d = u >> 3; float f[8];
#pragma unroll
      for (int e = 0; e < 8; ++e) { const int i = i8 * 8 + e; f[e] = bf2f(kh[i * 136 + d]) * __expf(glast - gcs[i]); }
      *(u32x4*)(p.QKV + (size_t)(T0 + (d >> 1)) * QW + 1024 + h * 128 + (d & 1) * 64 + i8 * 8) = pack8(f);
    }
    if (tid == 64) p.DL[ci] = __expf(glast);
  }
  lds_barrier();
  {
    const int l32 = lane & 31, lh = lane >> 5; const bool isV = wid >= 4;
    const bf16_t* srcl = (isV ? vh : kh) + (wid & 3) * 32 + l32; const float* rs = isV ? bet : rsk;
    bf16x8 r0[2];
#pragma unroll
    for (int s = 0; s < 2; ++s) { float f[8];
#pragma unroll
      for (int e = 0; e < 8; ++e) { const int k = 16 * s + 8 * lh + e; f[e] = bf2f(srcl[k * 136]) * rs[k]; }
      r0[s] = __builtin_bit_cast(bf16x8, pack8(f)); }
    f32x16 x0 = {};
#pragma unroll
    for (int s = 0; s < 2; ++s) x0 = __builtin_amdgcn_mfma_f32_32x32x16_bf16(*(const bf16x8*)(Tb + l32 * 40 + 16 * s + 8 * lh), r0[s], x0, 0, 0, 0);
    f32x16 y1;
#pragma unroll
    for (int r = 0; r < 16; ++r) { const int k = 32 + crow(r, lh); y1[r] = bf2f(srcl[k * 136]) * rs[k]; }
#pragma unroll
    for (int s = 0; s < 2; ++s) y1 = __builtin_amdgcn_mfma_f32_32x32x16_bf16(ld_permk(M10n + l32 * 40, s, lh), packfrag(x0, s), y1, 0, 0, 0);
    f32x16 x1 = {};
#pragma unroll
    for (int s = 0; s < 2; ++s) x1 = __builtin_amdgcn_mfma_f32_32x32x16_bf16(ld_permk(Tb + (32 + l32) * 40, s, lh), packfrag(y1, s), x1, 0, 0, 0);
    const int col = (wid & 3) * 32 + l32;
    if (!isV) {
      bf16_t* wp = p.UW + (size_t)ci * 8192 + col;
#pragma unroll
      for (int r = 0; r < 16; ++r) { const int i = crow(r, lh); wp[i * 128] = (bf16_t)(pk2(-x0[r], 0.f) & 0xffffu); wp[(32 + i) * 128] = (bf16_t)(pk2(-x1[r], 0.f) & 0xffffu); }
    } else {
      bf16_t* up = p.QKV + (size_t)(T0 + (col >> 1)) * QW + 2048 + h * 128 + (col & 1) * 64;
#pragma unroll
      for (int q = 0; q < 4; ++q) {
        u32x2 w0, w1; w0.x = pk2(x0[q * 4], x0[q * 4 + 1]); w0.y = pk2(x0[q * 4 + 2], x0[q * 4 + 3]); w1.x = pk2(x1[q * 4], x1[q * 4 + 1]); w1.y = pk2(x1[q * 4 + 2], x1[q * 4 + 3]);
        *(u32x2*)(up + q * 8 + lh * 4) = w0; *(u32x2*)(up + 32 + q * 8 + lh * 4) = w1;
      }
    }
  }
  lds_barrier();
}

__device__ void phase2(const Params& p) {
  const int G = gridDim.x;
  const int tid = launder(threadIdx.x);
  {
    const int c8 = (tid & 127) * 8;
    float w0[8], w1[8], w2[8];
#pragma unroll
    for (int e = 0; e < 8; ++e) { w0[e] = p.caw[c8 + e]; w1[e] = p.caw[DM + c8 + e]; w2[e] = p.caw[2 * DM + c8 + e]; }
#pragma unroll 1
    for (int grp = blockIdx.x * 4 + (tid >> 7); grp < NT / 8; grp += G * 4) {
      const int r0 = grp * 8;
      u32x4 pw[10], gw[8];
#pragma unroll
      for (int k = 0; k < 10; ++k) { const int r = r0 - 2 + k; pw[k] = (u32x4){0u, 0u, 0u, 0u}; if (r >= 0) pw[k] = *(const u32x4*)(p.P + (size_t)r * DM + c8); }
#pragma unroll
      for (int k = 0; k < 8; ++k) gw[k] = *(const u32x4*)(p.GATE + (size_t)(r0 + k) * DM + c8);
#pragma unroll
      for (int k = 0; k < 8; ++k) {
        const int r = r0 + k;
        float cur[8], p1[8], p2[8], g[8];
        unpack8(pw[k + 2], cur); unpack8(pw[k + 1], p1); unpack8(pw[k], p2); unpack8(gw[k], g);
        if (r < NTP) {
          const int t = r & 2047;
          if (t < 1) { for (int e = 0; e < 8; ++e) p1[e] = 0.f; }
          if (t < 2) { for (int e = 0; e < 8; ++e) p2[e] = 0.f; }
          if (t >= 2046) { float* o = p.out + OFF_NCA_P + ((size_t)(r >> 11) * 2 + (t - 2046)) * DM + c8; *(f32x4*)o = (f32x4){cur[0], cur[1], cur[2], cur[3]}; *(f32x4*)(o + 4) = (f32x4){cur[4], cur[5], cur[6], cur[7]}; }
        } else {
          const int bs = (r - NTP) >> 2, t = (r - NTP) & 3;
          const float* past = p.sca + (size_t)bs * 2 * DM + c8;
          if (t < 1) { for (int e = 0; e < 8; ++e) p1[e] = past[DM + e]; }
          if (t < 2) { for (int e = 0; e < 8; ++e) p2[e] = past[(t == 1 ? DM : 0) + e]; }
          if (t >= 2) { float* o = p.out + OFF_NCA_S + ((size_t)bs * 2 + (t - 2)) * DM + c8; *(f32x4*)o = (f32x4){cur[0], cur[1], cur[2], cur[3]}; *(f32x4*)(o + 4) = (f32x4){cur[4], cur[5], cur[6], cur[7]}; }
        }
        float o8[8];
#pragma unroll
        for (int e = 0; e < 8; ++e) o8[e] = g[e] * (w0[e] * p2[e] + w1[e] * p1[e] + w2[e] * cur[e]);
        *(u32x4*)(p.GATE + (size_t)r * DM + c8) = pack8(o8);
      }
    }
  }
  {
    extern __shared__ __attribute__((aligned(16))) unsigned char smem[];
    float* cw = (float*)(smem + 129792);
    const int tid0 = launder(threadIdx.x);
    int cur_h = -1; u32x4 pre[7];
    int task = blockIdx.x;
#pragma unroll
    for (int k = 0; k < 7; ++k) { const int u = k * 512 + tid0; pre[k] = (u32x4){0u, 0u, 0u, 0u}; if (task < 2048 && u < 67 * 48) pre[k] = raw_unit_load(p, task >> 3, task & 7, u); }
    float pg = 0.f, pb = 0.f;
    if (task < 2048 && tid0 < 64) { pg = p.BG[(size_t)((task >> 3) * 64 + tid0) * 16 + 8 + (task & 7)]; pb = p.BG[(size_t)((task >> 3) * 64 + tid0) * 16 + (task & 7)]; }
    for (; task < 2048; task += G) {
      const int h = task & 7;
      if (h != cur_h) {
        lds_barrier();
        for (int u = tid0; u < 3 * 4 * 128; u += 512) { const int part = u / 512, j = (u >> 7) & 3, col = u & 127; cw[u] = p.cbw[(size_t)j * QW + part * 1024 + h * 128 + col]; }
        cur_h = h;
      }
      const int nt = task + G;
      chunk_task(p, task >> 3, h, pre, pg, pb, nt >> 3, nt & 7, nt < 2048);
    }
  }
}

DI void cvt16(f32x16& a, int q, u32x2 w) { a[q * 4 + 0] = bflo(w.x); a[q * 4 + 1] = bfhi(w.x); a[q * 4 + 2] = bflo(w.y); a[q * 4 + 3] = bfhi(w.y); }
__device__ __forceinline__ void scan_seq(const Params& p, int seq) {
  extern __shared__ __attribute__((aligned(16))) unsigned char smem[];
  bf16_t* A1 = (bf16_t*)smem;
  bf16_t* AQ = (bf16_t*)(smem + 34816);
  bf16_t* KT = (bf16_t*)(smem + 44032);
  bf16_t* ST = (bf16_t*)(smem + 62464);
  bf16_t* UT = (bf16_t*)(smem + 97280);
  float* OS = (float*)(smem + 115712);
  const int tid = launder(threadIdx.x), wid = tid >> 6, lane = tid & 63, vb = wid & 3, hw = wid >> 2, l32 = lane & 31, lh = lane >> 5;
  const int b = seq >> 3, h = seq & 7;
  f32x16 S0 = {}, S1 = {};
  for (int i = tid; i < 128 * 136 / 8; i += 512) ((u32x4*)ST)[i] = (u32x4){0u, 0u, 0u, 0u};
  const int v = vb * 32 + l32;
  u32x4 pA[4], pQ, pK[2]; u32x2 pU[8]; float pdl;
  float onw16[16];
  { const int seg = tid & 7;
#pragma unroll
    for (int e = 0; e < 16; ++e) onw16[e] = p.onw[seg * 16 + e]; }
#define SCAN_SRC_A(nn, it) ({ const int ci_ = (b * 32 + (nn)) * 8 + h, T0_ = (b * 32 + (nn)) * 64; const int u_ = (it) * 512 + tid, r_ = u_ >> 4, c_ = (u_ & 15) * 8; \
    (const u32x4*)(r_ < 64 ? p.UW + ((size_t)ci_ * 64 + r_) * 128 + c_ : p.QKV + (size_t)(T0_ + r_ - 64) * QW + h * 128 + c_); })
#define SCAN_LOAD_A(nn) do { _Pragma("unroll") for (int it = 0; it < 4; ++it) pA[it] = *SCAN_SRC_A(nn, it); } while (0)
#define SCAN_LOAD_QK(nn) do { const int ci_ = (b * 32 + (nn)) * 8 + h, T0_ = (b * 32 + (nn)) * 64; \
    { const int r = tid >> 3, c = (tid & 7) * 8; pQ = *(const u32x4*)(p.AQK + (size_t)ci_ * 4096 + r * 64 + c); } \
    _Pragma("unroll") for (int it = 0; it < 2; ++it) { const int u = it * 512 + tid, d = u >> 3, c = (u & 7) * 8; \
      pK[it] = *(const u32x4*)(p.QKV + (size_t)(T0_ + (d >> 1)) * QW + 1024 + h * 128 + (d & 1) * 64 + c); } } while (0)
#define SCAN_LOAD_U(nn) do { const int ci_ = (b * 32 + (nn)) * 8 + h, T0_ = (b * 32 + (nn)) * 64; \
    if (hw == 0) { const bf16_t* base_ = p.QKV + (size_t)(T0_ + (v >> 1)) * QW + 2048 + h * 128 + (v & 1) * 64; \
      _Pragma("unroll") for (int q = 0; q < 4; ++q) { pU[q] = *(const u32x2*)(base_ + q * 8 + lh * 4); pU[4 + q] = *(const u32x2*)(base_ + 32 + q * 8 + lh * 4); } } \
    pdl = p.DL[ci_]; } while (0)
#define SCAN_FILL_A() do { _Pragma("unroll") for (int it = 0; it < 4; ++it) { const int u = it * 512 + tid, r = u >> 4, c = (u & 15) * 8; *(u32x4*)(A1 + r * 136 + c) = pA[it]; } } while (0)
#define SCAN_FILL_QK() do { { const int r = tid >> 3, c = (tid & 7) * 8; *(u32x4*)(AQ + r * 72 + c) = pQ; } \
    _Pragma("unroll") for (int it = 0; it < 2; ++it) { const int u = it * 512 + tid, d = u >> 3, c = (u & 7) * 8; *(u32x4*)(KT + d * 72 + c) = pK[it]; } } while (0)
  SCAN_LOAD_A(0); SCAN_LOAD_QK(0); SCAN_LOAD_U(0);
  SCAN_FILL_A(); SCAN_FILL_QK();
  SCAN_LOAD_A(1); SCAN_LOAD_QK(1);
  lds_barrier();
#pragma unroll 1
  for (int n = 0; n < 32; ++n) {
    const int cgi = b * 32 + n, T0 = cgi * 64;
    f32x16 a0 = {}, a1 = {};
    if (hw == 0) {
#pragma unroll
      for (int q = 0; q < 4; ++q) { cvt16(a0, q, pU[q]); cvt16(a1, q, pU[4 + q]); }
    }
    const float dl = pdl;
    if (n + 1 < 32) SCAN_LOAD_U(n + 1);
    u32x4 zz0, zz1;
    { const int i = tid >> 3, seg = tid & 7; const size_t tok = (size_t)T0 + i; zz0 = *(const u32x4*)(p.SBZ + tok * DM + h * 128 + seg * 16); zz1 = *(const u32x4*)(p.SBZ + tok * DM + h * 128 + seg * 16 + 8); }
#pragma unroll
    for (int ks = 0; ks < 8; ++ks) {
      const bf16x8 bfr = *(const bf16x8*)(ST + v * 136 + ks * 16 + lh * 8);
      const bf16x8 x0 = *(const bf16x8*)(A1 + (hw * 64 + l32) * 136 + ks * 16 + lh * 8), x1 = *(const bf16x8*)(A1 + (hw * 64 + 32 + l32) * 136 + ks * 16 + lh * 8);
      a0 = __builtin_amdgcn_mfma_f32_32x32x16_bf16(x0, bfr, a0, 0, 0, 0);
      a1 = __builtin_amdgcn_mfma_f32_32x32x16_bf16(x1, bfr, a1, 0, 0, 0);
    }
    if (hw == 0) {
#pragma unroll
      for (int q = 0; q < 4; ++q) {
        u32x2 w0, w1; w0.x = pk2(a0[q * 4], a0[q * 4 + 1]); w0.y = pk2(a0[q * 4 + 2], a0[q * 4 + 3]); w1.x = pk2(a1[q * 4], a1[q * 4 + 1]); w1.y = pk2(a1[q * 4 + 2], a1[q * 4 + 3]);
        *(u32x2*)(UT + v * 72 + q * 8 + lh * 4) = w0; *(u32x2*)(UT + v * 72 + 32 + q * 8 + lh * 4) = w1;
      }
    }
    lds_barrier();
    S0 *= dl; S1 *= dl;
#pragma unroll
    for (int ks = 0; ks < 4; ++ks) {
      const bf16x8 bfr = *(const bf16x8*)(UT + v * 72 + ks * 16 + lh * 8);
      if (hw == 1) {
        const bf16x8 x0 = *(const bf16x8*)(AQ + l32 * 72 + ks * 16 + lh * 8), x1 = *(const bf16x8*)(AQ + (32 + l32) * 72 + ks * 16 + lh * 8);
        a0 = __builtin_amdgcn_mfma_f32_32x32x16_bf16(x0, bfr, a0, 0, 0, 0);
        a1 = __builtin_amdgcn_mfma_f32_32x32x16_bf16(x1, bfr, a1, 0, 0, 0);
      }
      const bf16x8 k0 = *(const bf16x8*)(KT + ((2 * hw) * 32 + l32) * 72 + ks * 16 + lh * 8), k1 = *(const bf16x8*)(KT + ((2 * hw + 1) * 32 + l32) * 72 + ks * 16 + lh * 8);
      S0 = __builtin_amdgcn_mfma_f32_32x32x16_bf16(k0, bfr, S0, 0, 0, 0);
      S1 = __builtin_amdgcn_mfma_f32_32x32x16_bf16(k1, bfr, S1, 0, 0, 0);
    }
    if (n + 1 < 32) { SCAN_FILL_A(); if (n + 2 < 32) SCAN_LOAD_A(n + 2); }
#pragma unroll
    for (int q = 0; q < 4; ++q) {
      u32x2 w0, w1; w0.x = pk2(S0[q * 4], S0[q * 4 + 1]); w0.y = pk2(S0[q * 4 + 2], S0[q * 4 + 3]); w1.x = pk2(S1[q * 4], S1[q * 4 + 1]); w1.y = pk2(S1[q * 4 + 2], S1[q * 4 + 3]);
      *(u32x2*)(ST + v * 136 + (2 * hw) * 32 + q * 8 + lh * 4) = w0; *(u32x2*)(ST + v * 136 + (2 * hw + 1) * 32 + q * 8 + lh * 4) = w1;
    }
    if (hw == 1) {
#pragma unroll
      for (int r = 0; r < 16; ++r) { const int i = (r & 3) + 8 * (r >> 2) + 4 * lh; OS[i * 132 + v] = a0[r]; OS[(32 + i) * 132 + v] = a1[r]; }
    }
    lds_barrier();
    {
      const int i = tid >> 3, seg = tid & 7; const float* orow = OS + i * 132 + seg * 16; float o[16]; float ss = 0.f;
#pragma unroll
      for (int e4 = 0; e4 < 4; ++e4) { const f32x4 t = *(const f32x4*)(orow + e4 * 4); o[e4 * 4] = t.x; o[e4 * 4 + 1] = t.y; o[e4 * 4 + 2] = t.z; o[e4 * 4 + 3] = t.w; ss += (t.x * t.x + t.y * t.y) + (t.z * t.z + t.w * t.w); }
      ss += __shfl_xor(ss, 1); ss += __shfl_xor(ss, 2); ss += __shfl_xor(ss, 4);
      const float rstd = rsqrtf(ss * (1.f / 128.f) + EPS);
      const size_t tok = (size_t)T0 + i; float z[16];
      unpack8(zz0, z); unpack8(zz1, z + 8);
#pragma unroll
      for (int e = 0; e < 16; ++e) o[e] = o[e] * rstd * onw16[e] * z[e];
      bf16_t* dst = p.QKV + tok * QW + 2048 + h * 128 + seg * 16;
      *(u32x4*)dst = pack8(o); *(u32x4*)(dst + 8) = pack8(o + 8);
    }
    if (n + 1 < 32) { SCAN_FILL_QK(); if (n + 2 < 32) SCAN_LOAD_QK(n + 2); }
  }
  float* sp = p.out + OFF_ND_P + (size_t)(b * 8 + h) * 16384;
#pragma unroll
  for (int r = 0; r < 16; ++r) { const int dd = (r & 3) + 8 * (r >> 2) + 4 * lh; sp[(size_t)((2 * hw) * 32 + dd) * 128 + v] = S0[r]; sp[(size_t)((2 * hw + 1) * 32 + dd) * 128 + v] = S1[r]; }
  lds_barrier();
}

__device__ __forceinline__ void sample_seq(const Params& p, int s, f32x4 (&Sn)[8], int s_next) {
  extern __shared__ __attribute__((aligned(16))) unsigned char smem[];
  float* qs = (float*)smem;
  float* ks = qs + 512;
  float* vs = ks + 512;
  float* os = vs + 512;
  float* red = os + 512;
  const int tid = launder(threadIdx.x), bs = s >> 3, h = s & 7;
  const size_t Tb = (size_t)NTP + bs * 4;
  const int kg = tid >> 5, vg = tid & 31;
  f32x4 S[8];
#pragma unroll
  for (int kk = 0; kk < 8; ++kk) S[kk] = Sn[kk];
  if (s_next >= 0) { const float* sn = p.sd + ((size_t)s_next * 128 + kg * 8) * 128 + vg * 4;
#pragma unroll
    for (int kk = 0; kk < 8; ++kk) Sn[kk] = ldnt4(sn + kk * 128); }
  float ga[4], be[4];
#pragma unroll
  for (int t = 0; t < 4; ++t) { ga[t] = p.BG[(Tb + t) * 16 + 8 + h]; be[t] = p.BG[(Tb + t) * 16 + h]; }
  u32x4 zt = {0u, 0u, 0u, 0u}; float ow[8];
  { const int t = (tid >> 4) & 3, seg = tid & 15; zt = *(const u32x4*)(p.SBZ + (Tb + t) * DM + h * 128 + seg * 8);
#pragma unroll
    for (int e = 0; e < 8; ++e) ow[e] = p.onw[seg * 8 + e]; }
  if (tid < 192) {
    const int c8 = tid & 15, grp = tid >> 4, part = grp % 3, t = grp / 3;
    const int colw = part * 1024 + h * 128 + c8 * 8;
    float a[8] = {0.f, 0.f, 0.f, 0.f, 0.f, 0.f, 0.f, 0.f};
#pragma unroll
    for (int j = 0; j < 4; ++j) {
      const int e_ = t + j; float x[8];
      if (e_ < 3) { const float* ps = p.scq + ((size_t)bs * 3 + e_) * QW + colw; for (int e = 0; e < 8; ++e) x[e] = ps[e]; }
      else unpack8(*(const u32x4*)(p.QKV + (Tb + e_ - 3) * QW + colw), x);
      const float* w = p.cbw + j * QW + colw;
#pragma unroll
      for (int e = 0; e < 8; ++e) a[e] += x[e] * w[e];
      if (j == 3 && t >= 1) { float* o = p.out + OFF_NCQ_S + ((size_t)bs * 3 + (t - 1)) * QW + colw; for (int e = 0; e < 8; ++e) o[e] = x[e]; }
    }
    float ss = 0.f;
#pragma unroll
    for (int e = 0; e < 8; ++e) { a[e] = siluf(a[e]); ss += a[e] * a[e]; }
    ss += __shfl_xor(ss, 1); ss += __shfl_xor(ss, 2); ss += __shfl_xor(ss, 4); ss += __shfl_xor(ss, 8);
    if (part < 2) { const float sc = rsqrtf(ss + EPS) * (part == 0 ? 0.08838834764831845f : 1.f); for (int e = 0; e < 8; ++e) a[e] *= sc; }
    float* d = (part == 0 ? qs : (part == 1 ? ks : vs)) + t * 128 + c8 * 8;
#pragma unroll
    for (int e = 0; e < 8; ++e) d[e] = a[e];
  }
  lds_barrier();
#pragma unroll
  for (int t = 0; t < 4; ++t) {
    const float a = __expf(ga[t]), beta = be[t];
    f32x4 part = {0.f, 0.f, 0.f, 0.f};
#pragma unroll
    for (int kk = 0; kk < 8; ++kk) { S[kk] *= a; part += S[kk] * ks[t * 128 + kg * 8 + kk]; }
    *(f32x4*)(red + kg * 128 + vg * 4) = part;
    lds_barrier();
    f32x4 r = {0.f, 0.f, 0.f, 0.f};
#pragma unroll
    for (int g2 = 0; g2 < 16; ++g2) r += *(const f32x4*)(red + g2 * 128 + vg * 4);
    const f32x4 dlt = (*(const f32x4*)(vs + t * 128 + vg * 4) - r) * beta;
    f32x4 po = {0.f, 0.f, 0.f, 0.f};
#pragma unroll
    for (int kk = 0; kk < 8; ++kk) { S[kk] += dlt * ks[t * 128 + kg * 8 + kk]; po += S[kk] * qs[t * 128 + kg * 8 + kk]; }
    lds_barrier();
    *(f32x4*)(red + kg * 128 + vg * 4) = po;
    lds_barrier();
    if (tid < 128) { float o = 0.f; for (int g2 = 0; g2 < 16; ++g2) o += red[g2 * 128 + tid]; os[t * 128 + tid] = o; }
    lds_barrier();
  }
  float* so = p.out + OFF_ND_S + ((size_t)s * 128 + kg * 8) * 128 + vg * 4;
#pragma unroll
  for (int kk = 0; kk < 8; ++kk) stnt4(so + kk * 128, S[kk]);
  if (tid < 64) {
    const int t = tid >> 4, seg = tid & 15; float o[8]; float ss = 0.f;
#pragma unroll
    for (int e = 0; e < 8; ++e) { o[e] = os[t * 128 + seg * 8 + e]; ss += o[e] * o[e]; }
    ss += __shfl_xor(ss, 1); ss += __shfl_xor(ss, 2); ss += __shfl_xor(ss, 4); ss += __shfl_xor(ss, 8);
    const float rstd = rsqrtf(ss * (1.f / 128.f) + EPS); float z[8];
    unpack8(zt, z);
#pragma unroll
    for (int e = 0; e < 8; ++e) o[e] = o[e] * rstd * ow[e] * z[e];
    *(u32x4*)(p.QKV + (Tb + t) * QW + 2048 + h * 128 + seg * 8) = pack8(o);
  }
  lds_barrier();
}

__device__ void phase3(const Params& p) {
  const int G = gridDim.x, bid = blockIdx.x;
  const bool split = G > 64;
#ifndef P3_NO_SCAN
  if (!split || bid < 64) for (int seq = bid; seq < 64; seq += (split ? 64 : G)) scan_seq(p, seq);
#endif
  if (!split || bid >= 64) {
    const int wk = split ? bid - 64 : bid, NW = split ? G - 64 : G;
#ifndef P3_NO_GEMM
    { extern __shared__ __attribute__((aligned(16))) unsigned char smem[];
      Sched S; S.init_strided(wk, NW, 264); gemm_phase<1>(p, (LAS unsigned char*)smem, p.GATE, DM, p.WOA, S); }
#endif
#ifndef P3_NO_SAMPLE
    {
      const int n2 = (264 > NW && 264 < 2 * NW) ? 264 - NW : 0, n1 = NW - n2;
      const int s_first = wk < n2 ? 1024 : (wk - n2), s_step = n1, s_end = 1024;
      f32x4 Sn[8];
      if (s_first < s_end) { const int tid_ = launder(threadIdx.x); const float* sn = p.sd + ((size_t)s_first * 128 + (tid_ >> 5) * 8) * 128 + (tid_ & 31) * 4;
#pragma unroll
        for (int kk = 0; kk < 8; ++kk) Sn[kk] = ldnt4(sn + kk * 128); }
      for (int s = s_first; s < s_end; s += s_step) sample_seq(p, s, Sn, s + s_step < s_end ? s + s_step : -1);
    }
#endif
  }
}

__device__ void phase4(const Params& p) {
  extern __shared__ __attribute__((aligned(16))) unsigned char smem[];
  Sched S; S.init_strided(blockIdx.x, gridDim.x, 256); gemm_phase<2>(p, (LAS unsigned char*)smem, p.QKV + 2048, QW, p.WOB, S);
  gemm_tail<2>(p, p.QKV + 2048, QW, p.WOB, 256, 8);
}
__device__ void phase5(const Params& p) {
  extern __shared__ __attribute__((aligned(16))) unsigned char smem[];
  Sched S; S.init_strided(blockIdx.x, gridDim.x, 256);
  gemm_phase<4>(p, (LAS unsigned char*)smem, p.UW, DM, p.WO, S);
  gemm_tail<3>(p, p.UW, DM, p.WO, 256, 8);
}
__device__ void phase6(const Params& p) {
  const int tid = launder(threadIdx.x), wid = tid >> 6, lane = tid & 63, G = gridDim.x;
  f32x4 w[4];
#pragma unroll
  for (int i = 0; i < 4; ++i) w[i] = *(const f32x4*)(p.fnw + i * 256 + lane * 4);
  const int row_lo = (G == 256) ? NTP : 0;
#pragma unroll 1
  for (int row = row_lo + (blockIdx.x * 8 + wid) * 4; row < NT; row += G * 8 * 4) {
    f32x4 v[4][4];
#pragma unroll
    for (int q = 0; q < 4; ++q)
#pragma unroll
      for (int i = 0; i < 4; ++i) v[q][i] = *(const f32x4*)(p.out + (size_t)(row + q) * DM + i * 256 + lane * 4);
#pragma unroll
    for (int q = 0; q < 4; ++q) {
      float ss = 0.f;
#pragma unroll
      for (int i = 0; i < 4; ++i) ss += (v[q][i].x * v[q][i].x + v[q][i].y * v[q][i].y) + (v[q][i].z * v[q][i].z + v[q][i].w * v[q][i].w);
      ss = wave_sum(ss);
      const float rstd = rsqrtf(ss * (1.f / DM) + EPS);
#pragma unroll
      for (int i = 0; i < 4; ++i) *(f32x4*)(p.out + (size_t)(row + q) * DM + i * 256 + lane * 4) = v[q][i] * rstd * w[i];
    }
  }
}

#define XB_TMO      128
#define XB_XCNT(j)  (256  + 64 * (j))
#define XB_XSUB(j)  (1280 + 64 * (j))
#define XB_XGEN(j)  (2304 + 64 * (j))
#define XB_TOP      3328
#define XB_TOPGEN   3392
#define XCD_BAR_WORDS 3456
#define XB_SPIN_CAP (1u << 18)
DI unsigned xb_ld(unsigned* p) { return __hip_atomic_load(p, __ATOMIC_RELAXED, __HIP_MEMORY_SCOPE_AGENT); }
DI unsigned xb_add(unsigned* p, unsigned v) { return __hip_atomic_fetch_add(p, v, __ATOMIC_RELAXED, __HIP_MEMORY_SCOPE_AGENT); }
DI unsigned xb_xcc_id() { return (unsigned)__builtin_amdgcn_s_getreg((3 << 11) | 20) & 0xFu; }
#define XB_SPIN(cond, bar) do { unsigned _sp = 0; while (cond) { __builtin_amdgcn_s_sleep(1); \
    if ((++_sp & 255u) == 0u) { if (xb_ld(&(bar)[XB_TMO])) break; if (_sp > XB_SPIN_CAP) { atomicAdd(&(bar)[XB_TMO], 1u); break; } } } } while (0)
struct XcdBarrier { unsigned* bar; unsigned x; volatile LAS unsigned* st; };
DI XcdBarrier xcd_barrier_post(unsigned* bar, volatile LAS unsigned* st) {
  XcdBarrier b; b.bar = bar; b.x = xb_xcc_id(); b.st = st;
  if (threadIdx.x == 0) (void)xb_add(&bar[XB_XCNT(b.x)], 1u);
  return b;
}
DI void xcd_barrier_complete(unsigned* bar, unsigned x, unsigned& nloc, unsigned& nx) {
  const unsigned G = gridDim.x * gridDim.y * gridDim.z;
  unsigned sum, cnt, mine, sp = 0u;
  for (;;) {
    sum = 0u; cnt = 0u; mine = 0u;
#pragma unroll
    for (unsigned j = 0; j < 16; ++j) { const unsigned c = xb_ld(&bar[XB_XCNT(j)]); sum += c; cnt += (c > 0u) ? 1u : 0u; mine = (j == x) ? c : mine; }
    if (sum == G) break;
    __builtin_amdgcn_s_sleep(1);
    if ((++sp & 255u) == 0u) { if (xb_ld(&bar[XB_TMO])) break; if (sp > XB_SPIN_CAP) { atomicAdd(&bar[XB_TMO], 1u); break; } }
  }
  nloc = mine > 0u ? mine : 1u; nx = cnt > 0u ? cnt : 1u;
}
DI void xcd_barrier(const XcdBarrier& b) {
  asm volatile("s_waitcnt vmcnt(0)" ::: "memory");
  __syncthreads();
  if (threadIdx.x == 0) {
    unsigned* bar = b.bar;
    __builtin_amdgcn_s_waitcnt(0);
    unsigned nloc = b.st[0], nx = b.st[1];
    if (nloc == 0u) { xcd_barrier_complete(bar, b.x, nloc, nx); b.st[0] = nloc; b.st[1] = nx; }
    const unsigned old = xb_add(&bar[XB_XSUB(b.x)], 1u);
    const unsigned gen = old / nloc;
    if (old + 1u == (gen + 1u) * nloc) {
      __builtin_amdgcn_fence(__ATOMIC_RELEASE, "agent");
      asm volatile("s_waitcnt vmcnt(0)" ::: "memory");
      const unsigned og = xb_add(&bar[XB_TOP], 1u);
      const unsigned tg = og / nx;
      if (og + 1u == (tg + 1u) * nx) xb_add(&bar[XB_TOPGEN], 1u);
      else XB_SPIN(xb_ld(&bar[XB_TOPGEN]) == tg, bar);
      __builtin_amdgcn_fence(__ATOMIC_ACQUIRE, "agent");
      xb_add(&bar[XB_XGEN(b.x)], 1u);
      asm volatile("s_waitcnt vmcnt(0)" ::: "memory");
    } else {
      XB_SPIN(xb_ld(&bar[XB_XGEN(b.x)]) == gen, bar);
      __builtin_amdgcn_fence(__ATOMIC_ACQUIRE, "agent");
      asm volatile("s_waitcnt vmcnt(0)" ::: "memory");
    }
  }
  __syncthreads();
}

__global__ void __launch_bounds__(512, 2) mega(Params p, int ph_lo, int ph_hi) {
  cg::grid_group grid = cg::this_grid();
  const int lo = ph_lo, hi = ph_hi;
  extern __shared__ __attribute__((aligned(16))) unsigned char smem[];
  volatile LAS unsigned* st = (volatile LAS unsigned*)((LAS unsigned char*)smem + 149504);
  if (threadIdx.x < 4) st[threadIdx.x] = 0u;
  __syncthreads();
  XcdBarrier xb; xb.bar = p.bar; xb.x = 0; xb.st = st;
  if (hi - lo > 1) xb = xcd_barrier_post(p.bar, st);
  if (hi > 100) grid.sync();
#define GRID_SYNC() xcd_barrier(xb)
#define IN(k) (lo <= (k) && (k) < hi)
#define BOTH(k) (IN(k) && IN((k) + 1))
  if (IN(0)) { phase0(p); if (BOTH(0)) GRID_SYNC(); }
  if (IN(1)) { phase1(p); if (BOTH(1)) GRID_SYNC(); }
  if (IN(2)) { phase2(p); if (BOTH(2)) GRID_SYNC(); }
  if (IN(3)) { phase3(p); if (BOTH(3)) GRID_SYNC(); }
  if (IN(4)) { phase4(p); if (BOTH(4)) GRID_SYNC(); }
  if (IN(5)) { phase5(p); if (BOTH(5)) GRID_SYNC(); }
  if (IN(6)) { phase6(p); }
}

extern "C" void kernel_launch(void* const* d_in, const int* in_sizes, int n_in, void* d_out, int out_size, void* d_ws, size_t ws_size, hipStream_t stream) {
  static int grid = 0;
  if (grid == 0) {
    int dev = 0, cus = 0, per_cu = 0;
    hipGetDevice(&dev);
    hipDeviceGetAttribute(&cus, hipDeviceAttributeMultiprocessorCount, dev);
    if (hipFuncSetAttribute((const void*)mega, hipFuncAttributeMaxDynamicSharedMemorySize, LDS_BYTES) != hipSuccess) fprintf(stderr, "hipFuncSetAttribute failed\n");
    hipOccupancyMaxActiveBlocksPerMultiprocessor(&per_cu, (const void*)mega, 512, LDS_BYTES);
    if (per_cu < 1) { fprintf(stderr, "occupancy query says %d\n", per_cu); per_cu = 1; }
    (void)hipGetLastError();
    grid = cus;
  }
  Params p{};
  p.x_p = (const float*)d_in[0]; p.x_s = (const float*)d_in[1]; p.sca = (const float*)d_in[2]; p.scq = (const float*)d_in[3]; p.sd = (const float*)d_in[4];
  p.w_in = (const float*)d_in[5]; p.caw = (const float*)d_in[6]; p.cbw = (const float*)d_in[7]; p.a_log = (const float*)d_in[8]; p.dt_bias = (const float*)d_in[9];
  p.onw = (const float*)d_in[10]; p.w_oa = (const float*)d_in[11]; p.w_ob = (const float*)d_in[12]; p.w_o = (const float*)d_in[13]; p.nw = (const float*)d_in[14]; p.fnw = (const float*)d_in[15];
  p.out = (float*)d_out;
  unsigned char* ws = (unsigned char*)d_ws; size_t o = 0;
  auto take = [&](size_t bytes) { unsigned char* r = ws + o; o += (bytes + 255) & ~(size_t)255; return r; };
  p.QKV = (bf16_t*)take((size_t)NT * QW * 2);
  p.SBZ = (bf16_t*)take((size_t)NT * DM * 2);
  p.GATE = (bf16_t*)take((size_t)NT * DM * 2);
  p.UW = (bf16_t*)take((size_t)NT * DM * 2);
  p.AQK = (bf16_t*)take((size_t)2048 * 4096 * 2);
  p.WOA = (bf16_t*)take((size_t)DM * DM * 2); p.WOB = (bf16_t*)take((size_t)DM * DM * 2); p.WO = (bf16_t*)take((size_t)DM * DM * 2);
  p.WB16 = (bf16_t*)take(16 * DM * 2);
  p.BG = (float*)take((size_t)NT * 16 * 4);
  p.DL = (float*)take(2048 * 4);
  p.bar = (unsigned*)take((XCD_BAR_WORDS + 64 * 64) * 4);
  p.RS = (float*)take(64 * 4 * 256 * 4);
  if (o > ws_size) { fprintf(stderr, "workspace too small: need %zu have %zu\n", o, ws_size); return; }
  p.SGA = (bf16_t*)d_out; p.SGB = p.SGA + (size_t)NT * DM;
  unsigned char* nds = (unsigned char*)((float*)d_out + OFF_ND_S);
  p.WIN = (bf16_t*)nds; p.P = (bf16_t*)(nds + (size_t)10240 * DM * 2); p.HALO = (bf16_t*)(nds + (size_t)10240 * DM * 2 + (size_t)NT * DM * 2);
#if COOP
  if (hipMemsetAsync(p.bar, 0, (XCD_BAR_WORDS + 64 * 64) * 4, stream) != hipSuccess) fprintf(stderr, "memset of barrier words failed\n");
  int lo = 0, hi = 7; void* args[] = {&p, &lo, &hi};
  hipError_t e = hipLaunchCooperativeKernel((const void*)mega, dim3(grid), dim3(512), args, LDS_BYTES, stream);
  if (e != hipSuccess) fprintf(stderr, "cooperative launch failed: %s\n", hipGetErrorString(e));
#else
  for (int ph = 0; ph < 7; ++ph) { hipLaunchKernelGGL(mega, dim3(grid), dim3(512), LDS_BYTES, stream, p, ph, ph + 1); if (ph == DUP) hipLaunchKernelGGL(mega, dim3(grid), dim3(512), LDS_BYTES, stream, p, ph, ph + 1); }
#endif
}
```

```cpp
#include <hip/hip_runtime.h>
#include <hip/hip_cooperative_groups.h>
#include <cstdio>
#include <cstdint>
namespace cg = cooperative_groups;

#ifndef COOP
#define COOP 1
#endif
#ifndef DUP
#define DUP -1
#endif

typedef unsigned short bf16_t;
typedef short bf16x8 __attribute__((ext_vector_type(8)));
typedef float f32x4 __attribute__((ext_vector_type(4)));
typedef float f32x2 __attribute__((ext_vector_type(2)));
typedef float f32x16 __attribute__((ext_vector_type(16)));
typedef unsigned u32x4 __attribute__((ext_vector_type(4)));
typedef unsigned u32x2 __attribute__((ext_vector_type(2)));
typedef __bf16 bf16x2_t __attribute__((ext_vector_type(2)));

#define DI __device__ __forceinline__

constexpr int NT = 16896, NTP = 16384, DM = 1024, QW = 3072, NIN = 10256;
constexpr float EPS = 1e-6f;
constexpr size_t OFF_NCA_P = 17301504, OFF_NCQ_P = 17317888, OFF_ND_P = 17391616, OFF_NCA_S = 18440192, OFF_NCQ_S = 18702336, OFF_ND_S = 19881984;
constexpr int LDS_BYTES = 149504 + 16;

struct Params {
  const float *x_p, *x_s, *sca, *scq, *sd, *w_in, *caw, *cbw, *a_log, *dt_bias, *onw, *w_oa, *w_ob, *w_o, *nw, *fnw;
  float* out;
  bf16_t *QKV, *SBZ, *GATE, *UW, *AQK, *WOA, *WOB, *WO, *WB16;
  float *BG, *DL;
  bf16_t *SGA, *SGB, *WIN, *P, *HALO;
  unsigned* bar;
  float* RS;
};

DI unsigned pk2(float a, float b) { bf16x2_t v = __builtin_convertvector((f32x2){a, b}, bf16x2_t); return __builtin_bit_cast(unsigned, v); }
DI float bflo(unsigned w) { return __uint_as_float(w << 16); }
DI float bfhi(unsigned w) { return __uint_as_float(w & 0xffff0000u); }
DI float bf2f(bf16_t v) { return __uint_as_float(((unsigned)v) << 16); }
DI float siluf(float x) { return x * __builtin_amdgcn_rcpf(1.f + __expf(-x)); }
DI float sigmf(float x) { return __builtin_amdgcn_rcpf(1.f + __expf(-x)); }
DI f32x4 ldnt4(const float* q) { return __builtin_nontemporal_load((const f32x4*)q); }
DI void stnt4(float* q, f32x4 v) { __builtin_nontemporal_store(v, (f32x4*)q); }
DI float wave_sum(float v) {
#pragma unroll
  for (int o = 1; o < 64; o <<= 1) v += __shfl_xor(v, o);
  return v;
}
DI void unpack8(u32x4 w, float* f) { f[0] = bflo(w.x); f[1] = bfhi(w.x); f[2] = bflo(w.y); f[3] = bfhi(w.y); f[4] = bflo(w.z); f[5] = bfhi(w.z); f[6] = bflo(w.w); f[7] = bfhi(w.w); }
DI u32x4 pack8(const float* f) { u32x4 w; w.x = pk2(f[0], f[1]); w.y = pk2(f[2], f[3]); w.z = pk2(f[4], f[5]); w.w = pk2(f[6], f[7]); return w; }

DI int perm32(int rho) { const int n = rho >> 4, i = rho & 15; return 8 * (i >> 2) + 4 * n + (i & 3); }
DI int colmap_in(int R) {
  const int pn = R >> 8, l = R & 255, bj = l >> 7, wc = (l & 127) >> 5, rho = l & 31;
  if (pn < 16) { const int n = rho >> 4, i = rho & 15; return (bj * 2 + n) * 1024 + 64 * pn + wc * 16 + i; }
  const int base = pn < 32 ? 4096 + (pn - 16) * 256 : 8208 + (pn - 32) * 256;
  return base + bj * 128 + wc * 32 + perm32(rho);
}
DI int colmap_sq(int R) { return (R & ~31) + perm32(R & 31); }

constexpr int BM = 256, BK = 64, HALF = 128, NXCD = 8, WGM = 8, HT = HALF * BK;
DI void lds_barrier() { asm volatile("s_waitcnt lgkmcnt(0)" ::: "memory"); __builtin_amdgcn_s_barrier(); asm volatile("" ::: "memory"); }
DI int launder(int x) { asm volatile("" : "+v"(x)); return x; }
DI int lds_byte(int r, int c) { const int st = (r >> 4) * 2 + (c >> 5), rr = r & 15, cc = c & 31, ob = rr * 64 + cc * 2; return st * 1024 + (ob ^ (((ob >> 9) & 1) << 5)); }
DI void stage_rc(int b, int& R, int& C) { const int st = b / 1024, sb = b % 1024, swz = sb ^ (((sb >> 9) & 1) << 5); R = (st >> 1) * 16 + swz / 64; C = (st & 1) * 32 + (swz % 64) / 2; }

struct TileOrder {
  int nM, nN, nwg, G, c;
  DI void init(int M, int N, int G_, int c_) { nM = M / BM; nN = N / BM; nwg = nM * nN; G = G_; c = c_; }
  DI bool next(int i, int& pm, int& pn) const {
    const long L = (long)i * G + c; if (L >= nwg) return false;
    int wgid = (int)L; { const int q = nwg / NXCD, r = nwg % NXCD, xcd = wgid % NXCD, off = wgid / NXCD; wgid = (xcd < r ? xcd * (q + 1) : r * (q + 1) + (xcd - r) * q) + off; }
    const int nig = WGM * nN, gid = wgid / nig, fm = gid * WGM, gsz = (nM - fm) < WGM ? (nM - fm) : WGM;
    pm = fm + ((wgid % nig) % gsz); pn = (wgid % nig) / gsz; return true;
  }
};

#define FN_CNT(pm) (XCD_BAR_WORDS_C + 64 * (pm))
constexpr int XCD_BAR_WORDS_C = 3456;
DI void epilogue_final(const Params& p, f32x4 (&acc)[2][2][4][2], int pm, int pn, int wr, int wc, int fr, int fq, unsigned char* smem_, int tid) {
  float* PS = (float*)(smem_ + 131072);
  float* RSTD = (float*)(smem_ + 131072 + 4096);
  const int col0 = pn * BM + wc * 32 + 8 * fq;
#pragma unroll
  for (int ai = 0; ai < 2; ++ai)
#pragma unroll
    for (int m = 0; m < 4; ++m) {
      const int rl = ai * HALF + wr * 64 + m * 16 + fr; const size_t row = (size_t)pm * BM + rl;
      const float* xr = p.x_p + row * DM;
      float ss = 0.f;
#pragma unroll
      for (int bj = 0; bj < 2; ++bj) {
        const f32x4 x0 = ldnt4(xr + col0 + bj * HALF), x1 = ldnt4(xr + col0 + bj * HALF + 4);
        acc[ai][bj][m][0] += x0; acc[ai][bj][m][1] += x1;
        const f32x4 a = acc[ai][bj][m][0], b = acc[ai][bj][m][1];
        ss += (a.x * a.x + a.y * a.y) + (a.z * a.z + a.w * a.w) + (b.x * b.x + b.y * b.y) + (b.z * b.z + b.w * b.w);
      }
      ss += __shfl_xor(ss, 16); ss += __shfl_xor(ss, 32);
      if (fq == 0) PS[rl * 4 + wc] = ss;
      __builtin_amdgcn_sched_barrier(0);
    }
  lds_barrier();
  unsigned* cnt = p.bar + FN_CNT(pm);
  if (tid < 256) {
    const f32x4 s4 = *(const f32x4*)(PS + tid * 4);
    __hip_atomic_store((unsigned*)p.RS + ((size_t)(pm * 4 + pn) * 256 + tid), __float_as_uint((s4.x + s4.y) + (s4.z + s4.w)), __ATOMIC_RELAXED, __HIP_MEMORY_SCOPE_AGENT);
  }
  asm volatile("s_waitcnt vmcnt(0)" ::: "memory");
  lds_barrier();
  if (tid == 0) __hip_atomic_fetch_add(cnt, 1u, __ATOMIC_RELAXED, __HIP_MEMORY_SCOPE_AGENT);
  if (tid < 64) {
    unsigned sp = 0;
    while ((unsigned)__builtin_amdgcn_readfirstlane(__hip_atomic_load(cnt, __ATOMIC_RELAXED, __HIP_MEMORY_SCOPE_AGENT)) < 4u) { __builtin_amdgcn_s_sleep(2); if (++sp > (1u << 20)) break; }
    __builtin_amdgcn_fence(__ATOMIC_ACQUIRE, "agent");
  }
  asm volatile("s_waitcnt vmcnt(0) lgkmcnt(0)" ::: "memory");
  lds_barrier();
  if (tid < 256) {
    float tot = 0.f;
#pragma unroll
    for (int t = 0; t < 4; ++t) tot += __uint_as_float(__hip_atomic_load((unsigned*)p.RS + ((size_t)(pm * 4 + t) * 256 + tid), __ATOMIC_RELAXED, __HIP_MEMORY_SCOPE_AGENT));
    RSTD[tid] = rsqrtf(tot * (1.f / DM) + EPS);
  }
  lds_barrier();
#pragma unroll
  for (int bj = 0; bj < 2; ++bj) {
    const f32x4 fw0 = *(const f32x4*)(p.fnw + col0 + bj * HALF), fw1 = *(const f32x4*)(p.fnw + col0 + bj * HALF + 4);
#pragma unroll
    for (int ai = 0; ai < 2; ++ai)
#pragma unroll
      for (int m = 0; m < 4; ++m) {
        const int rl = ai * HALF + wr * 64 + m * 16 + fr; const size_t row = (size_t)pm * BM + rl; const float r = RSTD[rl];
        float* o = p.out + row * DM + col0 + bj * HALF;
        stnt4(o, acc[ai][bj][m][0] * r * fw0); stnt4(o + 4, acc[ai][bj][m][1] * r * fw1);
        __builtin_amdgcn_sched_barrier(0);
      }
  }
}

template <int EPI>
DI void epilogue(const Params& p, const f32x4 (&acc)[2][2][4][2], int pm, int pn, int wr, int wc, int fr, int fq) {
  const int row0 = pm * BM + wr * 64 + fr;
  if (EPI == 0) {
    if (pn < 16) {
      const int ch = pn * 64 + wc * 16 + fq * 4;
#pragma unroll
      for (int ai = 0; ai < 2; ++ai)
#pragma unroll
        for (int m = 0; m < 4; ++m) {
          const size_t row = row0 + ai * HALF + m * 16;
          const f32x4 b = acc[ai][0][m][0], c = acc[ai][0][m][1], h = acc[ai][1][m][0], z = acc[ai][1][m][1];
          u32x2 pp, gg;
          pp.x = pk2(c[0] * h[0], c[1] * h[1]); pp.y = pk2(c[2] * h[2], c[3] * h[3]);
          gg.x = pk2(siluf(z[0]) * b[0], siluf(z[1]) * b[1]); gg.y = pk2(siluf(z[2]) * b[2], siluf(z[3]) * b[3]);
          *(u32x2*)(p.P + row * DM + ch) = pp;
          *(u32x2*)(p.GATE + row * DM + ch) = gg;
        }
    } else {
      const int kind = pn < 28 ? 0 : (pn < 32 ? 1 : 2);
      bf16_t* dst; int ld, colt;
      if (kind == 0) { dst = p.QKV; ld = QW; colt = (pn - 16) * 256; }
      else if (kind == 1) { dst = p.SBZ; ld = DM; colt = (pn - 28) * 256; }
      else { dst = pn < 36 ? p.SGA : p.SGB; ld = DM; colt = ((pn - 32) & 3) * 256; }
      const int col0 = colt + wc * 32 + 8 * fq;
#pragma unroll
      for (int ai = 0; ai < 2; ++ai)
#pragma unroll
        for (int m = 0; m < 4; ++m) {
          const int row = row0 + ai * HALF + m * 16;
#pragma unroll
          for (int bj = 0; bj < 2; ++bj) {
            f32x4 v0 = acc[ai][bj][m][0], v1 = acc[ai][bj][m][1];
            if (kind == 1) { for (int j = 0; j < 4; ++j) { v0[j] = siluf(v0[j]); v1[j] = siluf(v1[j]); } }
            if (kind == 2) { for (int j = 0; j < 4; ++j) { v0[j] = sigmf(v0[j]); v1[j] = sigmf(v1[j]); } }
            u32x4 w; w.x = pk2(v0[0], v0[1]); w.y = pk2(v0[2], v0[3]); w.z = pk2(v1[0], v1[1]); w.w = pk2(v1[2], v1[3]);
            *(u32x4*)(dst + (size_t)row * ld + col0 + bj * HALF) = w;
            if (kind == 0 && row < NTP && (row & 63) >= 61)
              *(u32x4*)(p.HALO + ((size_t)(row >> 6) * 3 + ((row & 63) - 61)) * QW + col0 + bj * HALF) = w;
          }
        }
    }
  } else {
    const int col0 = pn * BM + wc * 32 + 8 * fq;
#pragma unroll
    for (int ai = 0; ai < 2; ++ai)
#pragma unroll
      for (int m = 0; m < 4; ++m) {
        const size_t row = row0 + ai * HALF + m * 16;
#pragma unroll
        for (int bj = 0; bj < 2; ++bj) {
          const f32x4 v0 = acc[ai][bj][m][0], v1 = acc[ai][bj][m][1];
          const size_t o = row * DM + col0 + bj * HALF;
          if (EPI == 1) {
            float s[8]; unpack8(*(const u32x4*)(p.SGA + o), s);
            u32x4 w; w.x = pk2(s[0] * v0[0], s[1] * v0[1]); w.y = pk2(s[2] * v0[2], s[3] * v0[3]); w.z = pk2(s[4] * v1[0], s[5] * v1[1]); w.w = pk2(s[6] * v1[2], s[7] * v1[3]);
            *(u32x4*)(p.SGA + o) = w;
          } else if (EPI == 2) {
            float s[8], a[8]; unpack8(*(const u32x4*)(p.SGB + o), s); unpack8(*(const u32x4*)(p.SGA + o), a);
            u32x4 w; w.x = pk2(a[0] + s[0] * v0[0], a[1] + s[1] * v0[1]); w.y = pk2(a[2] + s[2] * v0[2], a[3] + s[3] * v0[3]);
            w.z = pk2(a[4] + s[4] * v1[0], a[5] + s[5] * v1[1]); w.w = pk2(a[6] + s[6] * v1[2], a[7] + s[7] * v1[3]);
            *(u32x4*)(p.UW + o) = w;
          } else {
            const float* xr = row < NTP ? p.x_p + row * DM : p.x_s + (row - NTP) * DM;
            const f32x4 x0 = *(const f32x4*)(xr + col0 + bj * HALF), x1 = *(const f32x4*)(xr + col0 + bj * HALF + 4);
            *(f32x4*)(p.out + o) = x0 + v0; *(f32x4*)(p.out + o + 4) = x1 + v1;
          }
        }
      }
  }
}

#define LAS __attribute__((address_space(3)))
struct Sched {
  int mode, nM, nN, nwg, G, c, start, stride, count;
  DI void init_static(int M, int N, int G_, int c_) { mode = 0; nM = M / BM; nN = N / BM; nwg = nM * nN; G = G_; c = c_; start = stride = count = 0; }
  DI void init_strided(int start_, int stride_, int count_) { mode = 1; start = start_; stride = stride_; count = count_; nM = nN = nwg = G = c = 0; }
  DI bool next(int i, int& pm, int& pn) const {
    if (mode == 0) {
      const long L = (long)i * G + c; if (L >= nwg) return false;
      int wgid = (int)L; { const int q = nwg / NXCD, r = nwg % NXCD, xcd = wgid % NXCD, off = wgid / NXCD; wgid = (xcd < r ? xcd * (q + 1) : r * (q + 1) + (xcd - r) * q) + off; }
      const int nig = WGM * nN, gid = wgid / nig, fm = gid * WGM, gsz = (nM - fm) < WGM ? (nM - fm) : WGM;
      pm = fm + ((wgid % nig) % gsz); pn = (wgid % nig) / gsz; return true;
    }
    const int t = start + i * stride; if (t >= count) return false;
    pm = t >> 2; pn = t & 3; return true;
  }
};

template <int EPI>
DI void gemm_phase(const Params& p, LAS unsigned char* lds, const bf16_t* A, int lda, const bf16_t* Bt, const Sched& S) {
  constexpr int K = 1024, nt = K / BK, HTB = HALF * BK * 2;
  const int tid = launder(threadIdx.x), wid = __builtin_amdgcn_readfirstlane(tid >> 6), lane = tid & 63, wr = wid >> 2, wc = wid & 3, fr = lane & 15, fq = lane >> 4;
  unsigned voffA[2], voffB[2];
#pragma unroll
  for (int i = 0; i < 2; ++i) { int R, C; stage_rc(tid * 16 + i * 8192, R, C); voffA[i] = (unsigned)(R * lda + C) * 2u; voffB[i] = (unsigned)(R * K + C) * 2u; }
  const size_t kstep = (size_t)(BK * 2);
  const size_t hstepA = (size_t)HALF * lda * 2, tstepA = 2 * hstepA, hstepB = (size_t)HALF * K * 2, tstepB = 2 * hstepB;
  const unsigned ldsw = (unsigned)wid * 1024u;
  const int aoff = lds_byte(wr * 64 + fr, fq * 8), boff = lds_byte(wc * 32 + fr, fq * 8);
#define PG8_SA(b, h) (((b) * 2 + (h)) * HTB)
#define PG8_SB(b, h) ((4 + (b) * 2 + (h)) * HTB)
#define PG8_STAGE(bufoff, gbase, voff) do { _Pragma("unroll") for (int _i = 0; _i < 2; ++_i) \
    __builtin_amdgcn_global_load_lds((const unsigned*)((const char*)(gbase) + (voff)[_i]), (LAS unsigned*)(lds + (bufoff) + ldsw + _i * 8192), 16, 0, 0); } while (0)
#define PG8_LDA(dst, b, h) do { _Pragma("unroll") for (int m = 0; m < 4; ++m) _Pragma("unroll") for (int k = 0; k < 2; ++k) dst[m][k] = *(const LAS bf16x8*)(lds + PG8_SA(b, h) + aoff + m * 2048 + k * 1024); } while (0)
#define PG8_LDB(dst, b, h) do { _Pragma("unroll") for (int n = 0; n < 2; ++n) _Pragma("unroll") for (int k = 0; k < 2; ++k) dst[n][k] = *(const LAS bf16x8*)(lds + PG8_SB(b, h) + boff + n * 2048 + k * 1024); } while (0)
#define PG8_MMA(ai, bj, At, Bt_) do { __builtin_amdgcn_s_setprio(1); _Pragma("unroll") for (int m = 0; m < 4; ++m) _Pragma("unroll") for (int n = 0; n < 2; ++n) _Pragma("unroll") for (int k = 0; k < 2; ++k) \
    acc[ai][bj][m][n] = __builtin_amdgcn_mfma_f32_16x16x32_bf16(Bt_[n][k], At[m][k], acc[ai][bj][m][n], 0, 0, 0); __builtin_amdgcn_s_setprio(0); } while (0)
#define PG8_WAIT_V(n) asm volatile("s_waitcnt vmcnt(" #n ")" ::: "memory")
#define PG8_WAIT_L(n) asm volatile("s_waitcnt lgkmcnt(" #n ")" ::: "memory")
#define PG8_BAR __builtin_amdgcn_s_barrier()
#define PG8_SCHED __builtin_amdgcn_sched_barrier(0)
  int cpm, cpn, npm = 0, npn = 0; int ui = 0;
  if (!S.next(0, cpm, cpn)) return;
  f32x4 acc[2][2][4][2];
#pragma unroll
  for (int a = 0; a < 2; ++a)
#pragma unroll
    for (int b = 0; b < 2; ++b)
#pragma unroll
      for (int m = 0; m < 4; ++m)
#pragma unroll
        for (int n = 0; n < 2; ++n) acc[a][b][m][n] = (f32x4){0.f, 0.f, 0.f, 0.f};
  bf16x8 At[4][2], B0[2][2], B1[2][2];
  const char* cA = (const char*)A + (size_t)cpm * tstepA; const char* cB = (const char*)Bt + (size_t)cpn * tstepB;
  PG8_STAGE(PG8_SB(0, 0), cB, voffB); PG8_STAGE(PG8_SB(0, 1), cB + hstepB, voffB); PG8_STAGE(PG8_SA(0, 0), cA, voffA); PG8_STAGE(PG8_SA(0, 1), cA + hstepA, voffA);
  if (wr == 1) PG8_BAR;
  PG8_WAIT_V(2); PG8_BAR;
  PG8_STAGE(PG8_SB(1, 0), cB + kstep, voffB); PG8_STAGE(PG8_SA(1, 0), cA + kstep, voffA); PG8_STAGE(PG8_SB(1, 1), cB + hstepB + kstep, voffB);
  PG8_WAIT_V(6); PG8_BAR;
  for (;;) {
    const bool has_next = S.next(ui + 1, npm, npn);
    const char* nA = has_next ? (const char*)A + (size_t)npm * tstepA : cA; const char* nB = has_next ? (const char*)Bt + (size_t)npn * tstepB : cB;
#pragma unroll 1
    for (int t = 0; t < nt; t += 2) {
      const bool last = (t == nt - 2);
      const char* a1 = cA + (size_t)(t + 1) * kstep;
      const char* a2 = last ? nA : cA + (size_t)(t + 2) * kstep; const char* b2 = last ? nB : cB + (size_t)(t + 2) * kstep;
      const char* a3 = a2 + kstep; const char* b3 = b2 + kstep;
      PG8_LDB(B0, 0, 0); PG8_LDB(B1, 0, 1); PG8_SCHED; PG8_LDA(At, 0, 0); PG8_STAGE(PG8_SA(1, 1), a1 + hstepA, voffA);
      PG8_WAIT_V(8); PG8_WAIT_L(0); PG8_BAR; PG8_MMA(0, 0, At, B0); PG8_MMA(0, 1, At, B1); PG8_BAR; PG8_SCHED;
      PG8_LDA(At, 0, 1); PG8_STAGE(PG8_SB(0, 0), b2, voffB); PG8_STAGE(PG8_SB(0, 1), b2 + hstepB, voffB); PG8_STAGE(PG8_SA(0, 0), a2, voffA);
      PG8_WAIT_V(8); PG8_WAIT_L(0); PG8_BAR; PG8_MMA(1, 0, At, B0); PG8_MMA(1, 1, At, B1); PG8_BAR; PG8_SCHED;
      PG8_LDB(B0, 1, 0); PG8_LDB(B1, 1, 1); PG8_SCHED; PG8_LDA(At, 1, 0); PG8_STAGE(PG8_SA(0, 1), a2 + hstepA, voffA);
      PG8_WAIT_V(8); PG8_WAIT_L(0); PG8_BAR; PG8_MMA(0, 0, At, B0); PG8_MMA(0, 1, At, B1); PG8_BAR; PG8_SCHED;
      PG8_LDA(At, 1, 1); PG8_STAGE(PG8_SB(1, 0), b3, voffB); PG8_STAGE(PG8_SB(1, 1), b3 + hstepB, voffB); PG8_STAGE(PG8_SA(1, 0), a3, voffA);
      PG8_WAIT_V(8); PG8_WAIT_L(0); PG8_BAR; PG8_MMA(1, 0, At, B0); PG8_MMA(1, 1, At, B1); PG8_BAR; PG8_SCHED;
    }
    if (wr == 0) PG8_BAR;
    if (!(EPI == 4 && gridDim.x == 256)) epilogue<EPI == 4 ? 3 : EPI>(p, acc, cpm, cpn, wr, wc, fr, fq);
    if (!has_next) break;
#pragma unroll
    for (int a = 0; a < 2; ++a)
#pragma unroll
      for (int b = 0; b < 2; ++b)
#pragma unroll
        for (int m = 0; m < 4; ++m)
#pragma unroll
          for (int n = 0; n < 2; ++n) acc[a][b][m][n] = (f32x4){0.f, 0.f, 0.f, 0.f};
    cpm = npm; cpn = npn; cA = nA; cB = nB; ++ui;
    if (wr == 1) PG8_BAR;
  }
  PG8_WAIT_V(0);
  PG8_BAR;
  if (EPI == 4 && gridDim.x == 256) epilogue_final(p, acc, cpm, cpn, wr, wc, fr, fq, (unsigned char*)lds, tid);
#undef PG8_SA
#undef PG8_SB
#undef PG8_STAGE
#undef PG8_LDA
#undef PG8_LDB
#undef PG8_MMA
}

template <int EPI>
DI void gemm_tail(const Params& p, const bf16_t* A, int lda, const bf16_t* Bt, int tile0, int ntiles) {
  const int tid = launder(threadIdx.x), wid = tid >> 6, lane = tid & 63, fr = lane & 15, fq = lane >> 4;
  for (int q = blockIdx.x; q < ntiles * 32; q += gridDim.x) {
    const int t = tile0 + (q >> 5), sub = q & 31, pm = t >> 2, pn = t & 3;
    const int row0 = pm * 256 + (sub >> 3) * 64 + (wid >> 1) * 16, R0 = pn * 256 + (sub & 7) * 32 + (wid & 1) * 16;
    const bf16_t* ap = A + (size_t)(row0 + fr) * lda + fq * 8; const bf16_t* bp = Bt + (size_t)(R0 + fr) * DM + fq * 8;
    f32x4 acc = {0.f, 0.f, 0.f, 0.f};
#pragma unroll 16
    for (int ks = 0; ks < 32; ++ks) { const bf16x8 a = *(const bf16x8*)(ap + ks * 32), b = *(const bf16x8*)(bp + ks * 32); acc = __builtin_amdgcn_mfma_f32_16x16x32_bf16(b, a, acc, 0, 0, 0); }
    const size_t row = row0 + fr; const int col0 = (R0 & ~31) + 8 * fq + 4 * ((R0 >> 4) & 1);
    const size_t o = row * DM + col0;
    if (EPI == 2) {
      const u32x2 sw = *(const u32x2*)(p.SGB + o), aw = *(const u32x2*)(p.SGA + o);
      u32x2 w; w.x = pk2(bflo(aw.x) + bflo(sw.x) * acc[0], bfhi(aw.x) + bfhi(sw.x) * acc[1]); w.y = pk2(bflo(aw.y) + bflo(sw.y) * acc[2], bfhi(aw.y) + bfhi(sw.y) * acc[3]);
      *(u32x2*)(p.UW + o) = w;
    } else {
      const float* xr = row < NTP ? p.x_p + row * DM : p.x_s + (row - NTP) * DM;
      *(f32x4*)(p.out + o) = *(const f32x4*)(xr + col0) + acc;
    }
  }
}

DI void wtile_desc(const Params& p, int tile, const float*& src, bf16_t*& dst, int& N, int& kt, int& R0, int& kind) {
  if (tile < 2560) { src = p.w_in; dst = p.WIN; N = NIN; kt = tile & 15; R0 = (tile >> 4) * 64; kind = 0; }
  else { const int t2 = tile - 2560, mat = t2 >> 8; src = mat == 0 ? p.w_oa : (mat == 1 ? p.w_ob : p.w_o); dst = mat == 0 ? p.WOA : (mat == 1 ? p.WOB : p.WO); N = DM; kt = t2 & 15; R0 = ((t2 & 255) >> 4) * 64; kind = 1; }
}
DI void convert_tiles(const Params& p, int first, int end, int stride) {
  extern __shared__ __attribute__((aligned(16))) unsigned char smem[];
  float* lds = (float*)smem;
  const int tid = launder(threadIdx.x);
#pragma unroll 1
  for (int t0 = first; t0 < end; t0 += 4 * stride) {
    f32x4 v[4][2];
#pragma unroll
    for (int q = 0; q < 4; ++q) {
      const int tile = t0 + q * stride;
      if (tile < end) {
        const float* src; bf16_t* dst; int N, kt, R0, kind; wtile_desc(p, tile, src, dst, N, kt, R0, kind);
        const int r4 = tid & 15, R = R0 + r4 * 4, c = kind == 0 ? colmap_in(R) : colmap_sq(R);
#pragma unroll
        for (int ps = 0; ps < 2; ++ps) v[q][ps] = ldnt4(src + (size_t)(kt * 64 + ps * 32 + (tid >> 4)) * N + c);
      }
    }
#pragma unroll
    for (int q = 0; q < 4; ++q) {
      if (t0 + q * stride < end) {
#pragma unroll
        for (int ps = 0; ps < 2; ++ps) { float* d = lds + q * (64 * 65) + (ps * 32 + (tid >> 4)) * 65 + (tid & 15) * 4; d[0] = v[q][ps].x; d[1] = v[q][ps].y; d[2] = v[q][ps].z; d[3] = v[q][ps].w; }
      }
    }
    lds_barrier();
#pragma unroll
    for (int q = 0; q < 4; ++q) {
      const int tile = t0 + q * stride;
      if (tile < end) {
        const float* src; bf16_t* dst; int N, kt, R0, kind; wtile_desc(p, tile, src, dst, N, kt, R0, kind);
        const int R = tid >> 3, kg = tid & 7; float f[8];
#pragma unroll
        for (int i = 0; i < 8; ++i) f[i] = lds[q * (64 * 65) + (kg * 8 + i) * 65 + R];
        *(u32x4*)(dst + (size_t)(R0 + R) * DM + kt * 64 + kg * 8) = pack8(f);
      }
    }
    lds_barrier();
  }
}

__device__ void phase0(const Params& p) {
  extern __shared__ __attribute__((aligned(16))) unsigned char smem[];
  float* lds = (float*)smem;
  const int tid = threadIdx.x, wid = tid >> 6, lane = tid & 63, G = gridDim.x;
  {
    f32x4 w[4];
#pragma unroll
    for (int i = 0; i < 4; ++i) w[i] = *(const f32x4*)(p.nw + i * 256 + lane * 4);
#pragma unroll 1
    for (int row = (blockIdx.x * 8 + wid) * 4; row < NT; row += G * 8 * 4) {
      f32x4 v[4][4];
#pragma unroll
      for (int q = 0; q < 4; ++q) { const int r = row + q; const float* xr = r < NTP ? p.x_p + (size_t)r * DM : p.x_s + (size_t)(r - NTP) * DM;
#pragma unroll
        for (int i = 0; i < 4; ++i) v[q][i] = ldnt4(xr + i * 256 + lane * 4); }
#pragma unroll
      for (int q = 0; q < 4; ++q) {
        float ss = 0.f;
#pragma unroll
        for (int i = 0; i < 4; ++i) ss += (v[q][i].x * v[q][i].x + v[q][i].y * v[q][i].y) + (v[q][i].z * v[q][i].z + v[q][i].w * v[q][i].w);
        ss = wave_sum(ss);
        const float rstd = rsqrtf(ss * (1.f / DM) + EPS);
#pragma unroll
        for (int i = 0; i < 4; ++i) { u32x2 o; o.x = pk2(v[q][i].x * rstd * w[i].x, v[q][i].y * rstd * w[i].y); o.y = pk2(v[q][i].z * rstd * w[i].z, v[q][i].w * rstd * w[i].w);
          *(u32x2*)(p.UW + (size_t)(row + q) * DM + i * 256 + lane * 4) = o; }
      }
    }
  }
  convert_tiles(p, blockIdx.x, 2560, G);
  for (int idx = blockIdx.x * 512 + tid; idx < 16 * DM; idx += G * 512) { const int c = idx >> 10, k = idx & 1023; p.WB16[idx] = (bf16_t)(pk2(p.w_in[(size_t)k * NIN + 8192 + c], 0.f) & 0xffffu); }
}

__device__ void phase1(const Params& p) {
  const int G = gridDim.x;
  { extern __shared__ __attribute__((aligned(16))) unsigned char smem[];
    Sched S; S.init_static(NT, 10240, G, blockIdx.x); gemm_phase<0>(p, (LAS unsigned char*)smem, p.UW, DM, p.WIN, S); }
  const int nfull = G == 256 ? 80 : 0, nside = G - nfull, sidx = (int)blockIdx.x - nfull;
  if (sidx >= 0) convert_tiles(p, 2560 + sidx, 2560 + 768, nside);
  const int tid = launder(threadIdx.x), wid = tid >> 6, lane = tid & 63, fr = lane & 15, fq = lane >> 4;
  if (sidx >= 0)
  for (int task = sidx * 8 + wid; task < NT / 16; task += nside * 8) {
    const int base = task * 16; f32x4 acc = {0.f, 0.f, 0.f, 0.f};
    const bf16_t* ap = p.UW + (size_t)(base + fr) * DM + fq * 8; const bf16_t* bp = p.WB16 + fr * DM + fq * 8;
#pragma unroll 8
    for (int ks = 0; ks < 32; ++ks) { const bf16x8 a = *(const bf16x8*)(ap + ks * 32), b = *(const bf16x8*)(bp + ks * 32); acc = __builtin_amdgcn_mfma_f32_16x16x32_bf16(a, b, acc, 0, 0, 0); }
    const int c = fr, h = c & 7; const float na = -__expf(p.a_log[h]), db = p.dt_bias[h];
#pragma unroll
    for (int j = 0; j < 4; ++j) {
      const int tok = base + fq * 4 + j; const float v = acc[j]; float r;
      if (c < 8) r = sigmf(v); else { const float xx = v + db; r = na * (xx > 20.f ? xx : log1pf(__expf(xx))); }
      p.BG[(size_t)tok * 16 + c] = r;
    }
  }
}

DI u32x4 raw_unit_load(const Params& p, int cgi, int h, int u) {
  const int r = u / 48, rem = u % 48, part = rem >> 4, c8 = rem & 15;
  u32x4 v = {0u, 0u, 0u, 0u};
  if (r < 3) { if ((cgi & 31) > 0) v = *(const u32x4*)(p.HALO + ((size_t)(cgi - 1) * 3 + r) * QW + part * 1024 + h * 128 + c8 * 8); }
  else v = *(const u32x4*)(p.QKV + (size_t)(cgi * 64 + r - 3) * QW + part * 1024 + h * 128 + c8 * 8);
  return v;
}
DI int crow(int r, int lh) { return (r & 3) + 8 * (r >> 2) + 4 * lh; }
DI bf16x8 packfrag(const f32x16& x, int s) {
  u32x4 w; w.x = pk2(x[8 * s], x[8 * s + 1]); w.y = pk2(x[8 * s + 2], x[8 * s + 3]); w.z = pk2(x[8 * s + 4], x[8 * s + 5]); w.w = pk2(x[8 * s + 6], x[8 * s + 7]);
  return __builtin_bit_cast(bf16x8, w);
}
DI bf16x8 ld_permk(const bf16_t* rowp, int s, int lh) {
  const u32x2 a = *(const u32x2*)(rowp + 16 * s + 4 * lh), b = *(const u32x2*)(rowp + 16 * s + 8 + 4 * lh);
  u32x4 w; w.x = a.x; w.y = a.y; w.z = b.x; w.w = b.y; return __builtin_bit_cast(bf16x8, w);
}

DI void chunk_task(const Params& p, int cgi, int h, u32x4 (&pre)[7], float& pg, float& pb, int next_cgi, int next_h, bool has_next) {
  extern __shared__ __attribute__((aligned(16))) unsigned char smem[];
  bf16_t* raw = (bf16_t*)smem;
  bf16_t* qh = (bf16_t*)(smem + 52736);
  bf16_t* kh = (bf16_t*)(smem + 70144);
  bf16_t* vh = (bf16_t*)(smem + 87552);
  float* Mm = (float*)(smem + 104960);
  bf16_t* M10n = (bf16_t*)(smem + 121344);
  bf16_t* Tb = (bf16_t*)(smem + 123904);
  float* gcs = (float*)(smem + 129024);
  float* bet = (float*)(smem + 129280);
  float* rsk = (float*)(smem + 129536);
  const float* cw = (const float*)(smem + 129792);
  const int tid = launder(threadIdx.x), wid = tid >> 6, lane = tid & 63;
  const int n = cgi & 31, b = cgi >> 5, T0 = cgi * 64, ci = cgi * 8 + h;
#pragma unroll
  for (int k = 0; k < 7; ++k) { const int u = k * 512 + tid; if (u < 67 * 48) { const int r = u / 48, rem = u % 48; *(u32x4*)(raw + r * 392 + (rem >> 4) * 128 + (rem & 15) * 8) = pre[k]; } }
  if (has_next) {
#pragma unroll
    for (int k = 0; k < 7; ++k) { const int u = k * 512 + tid; if (u < 67 * 48) pre[k] = raw_unit_load(p, next_cgi, next_h, u); }
  }
  if (wid == 0) {
    float g = pg; const float be = pb;
    if (has_next) { pg = p.BG[(size_t)(next_cgi * 64 + lane) * 16 + 8 + next_h]; pb = p.BG[(size_t)(next_cgi * 64 + lane) * 16 + next_h]; }
#pragma unroll
    for (int o = 1; o < 64; o <<= 1) { const float t = __shfl_up(g, o); if (lane >= o) g += t; }
    gcs[lane] = g; bet[lane] = be; rsk[lane] = be * __expf(g);
  }
  lds_barrier();
  const float glast = gcs[63];
#pragma unroll 1
  for (int part = 0; part < 3; ++part) {
    const int c8 = tid & 15, row = (tid >> 4) * 2;
    f32x2 w2[4][4];
#pragma unroll
    for (int j = 0; j < 4; ++j) { const f32x4 wa = *(const f32x4*)(cw + (part * 4 + j) * 128 + c8 * 8), wb = *(const f32x4*)(cw + (part * 4 + j) * 128 + c8 * 8 + 4);
      w2[j][0] = (f32x2){wa.x, wa.y}; w2[j][1] = (f32x2){wa.z, wa.w}; w2[j][2] = (f32x2){wb.x, wb.y}; w2[j][3] = (f32x2){wb.z, wb.w}; }
    f32x2 a2[2][4];
#pragma unroll
    for (int k = 0; k < 4; ++k) { a2[0][k] = (f32x2){0.f, 0.f}; a2[1][k] = (f32x2){0.f, 0.f}; }
#pragma unroll
    for (int rr = 0; rr < 5; ++rr) {
      const u32x4 xw = *(const u32x4*)(raw + (row + rr) * 392 + part * 128 + c8 * 8);
      f32x2 x2[4]; x2[0] = (f32x2){bflo(xw.x), bfhi(xw.x)}; x2[1] = (f32x2){bflo(xw.y), bfhi(xw.y)}; x2[2] = (f32x2){bflo(xw.z), bfhi(xw.z)}; x2[3] = (f32x2){bflo(xw.w), bfhi(xw.w)};
#pragma unroll
      for (int q = 0; q < 2; ++q) { const int j = rr - q; if (j >= 0 && j < 4) {
#pragma unroll
        for (int k = 0; k < 4; ++k) a2[q][k] = x2[k] * w2[j][k] + a2[q][k]; } }
    }
#pragma unroll
    for (int q = 0; q < 2; ++q) {
      f32x2 s2 = {0.f, 0.f};
#pragma unroll
      for (int k = 0; k < 4; ++k) {
        const f32x2 t = a2[q][k] * (-1.4426950408889634f);
        f32x2 d; d.x = __builtin_amdgcn_exp2f(t.x); d.y = __builtin_amdgcn_exp2f(t.y); d = d + 1.0f;
        f32x2 r; r.x = __builtin_amdgcn_rcpf(d.x); r.y = __builtin_amdgcn_rcpf(d.y);
        a2[q][k] = a2[q][k] * r; s2 = a2[q][k] * a2[q][k] + s2;
      }
      float ss = s2.x + s2.y;
      ss += __shfl_xor(ss, 1); ss += __shfl_xor(ss, 2); ss += __shfl_xor(ss, 4); ss += __shfl_xor(ss, 8);
      if (part < 2) { const float sc = rsqrtf(ss + EPS) * (part == 0 ? 0.08838834764831845f : 1.f);
#pragma unroll
        for (int k = 0; k < 4; ++k) a2[q][k] = a2[q][k] * sc; }
      bf16_t* dstl = part == 0 ? qh : (part == 1 ? kh : vh);
      { u32x4 o; o.x = pk2(a2[q][0].x, a2[q][0].y); o.y = pk2(a2[q][1].x, a2[q][1].y); o.z = pk2(a2[q][2].x, a2[q][2].y); o.w = pk2(a2[q][3].x, a2[q][3].y);
        *(u32x4*)(dstl + (row + q) * 136 + c8 * 8) = o; }
      if (part == 0) { const float eg = __expf(gcs[row + q]);
#pragma unroll
        for (int k = 0; k < 4; ++k) a2[q][k] = a2[q][k] * eg;
        u32x4 o; o.x = pk2(a2[q][0].x, a2[q][0].y); o.y = pk2(a2[q][1].x, a2[q][1].y); o.z = pk2(a2[q][2].x, a2[q][2].y); o.w = pk2(a2[q][3].x, a2[q][3].y);
        *(u32x4*)(p.QKV + (size_t)(T0 + row + q) * QW + h * 128 + c8 * 8) = o; }
    }
  }
  if (n == 31) {
    for (int u = tid; u < 3 * 384; u += 512) { const int j = u / 384, cc = u % 384, part = cc >> 7, col = cc & 127;
      p.out[OFF_NCQ_P + ((size_t)b * 3 + j) * QW + part * 1024 + h * 128 + col] = bf2f(raw[(64 + j) * 392 + cc]); }
  }
  lds_barrier();
#define KQ_BLOCK(bidx, isq) do { \
      const int ib = (bidx) >= 6 ? 3 : ((bidx) >= 3 ? 2 : ((bidx) >= 1 ? 1 : 0)), jb = (bidx) - (ib * (ib + 1)) / 2; \
      const bf16_t* Y = (isq) ? qh : kh; \
      const int i = ib * 16 + fr; const float gi = gcs[i], bi = bet[i]; \
      f32x4 d = {0.f, 0.f, 0.f, 0.f}; \
      _Pragma("unroll") for (int ks = 0; ks < 4; ++ks) { \
        const bf16x8 xa = *(const bf16x8*)(kh + (jb * 16 + fr) * 136 + ks * 32 + fq * 8), yb = *(const bf16x8*)(Y + (ib * 16 + fr) * 136 + ks * 32 + fq * 8); \
        d = __builtin_amdgcn_mfma_f32_16x16x32_bf16(xa, yb, d, 0, 0, 0); } \
      const int j0 = jb * 16 + fq * 4; float r[4]; \
      _Pragma("unroll") for (int jj = 0; jj < 4; ++jj) { const int j = j0 + jj; const bool keep = (isq) ? (i >= j) : (i > j); r[jj] = keep ? d[jj] * __expf(gi - gcs[j]) * ((isq) ? 1.f : bi) : 0.f; } \
      if (isq) { u32x2 w; w.x = pk2(r[0], r[1]); w.y = pk2(r[2], r[3]); *(u32x2*)(p.AQK + (size_t)ci * 4096 + i * 64 + j0) = w; } \
      else { \
        *(f32x4*)(Mm + i * 64 + j0) = (f32x4){r[0], r[1], r[2], r[3]}; \
        if (ib >= 2 && jb < 2) { u32x2 w; w.x = pk2(-r[0], -r[1]); w.y = pk2(-r[2], -r[3]); *(u32x2*)(M10n + (i - 32) * 40 + j0) = w; } \
      } } while (0)
  {
    const int fr = lane & 15, fq = lane >> 4;
#pragma unroll 1
    for (int bidx = wid; bidx < 10; bidx += 8) KQ_BLOCK(bidx, false);
  }
  lds_barrier();
  if (wid == 0) {
    const int blk = lane >> 5, c = lane & 31; const float* Mb = Mm + (blk * 32) * 64 + blk * 32;
    float X[32];
    f32x4 mb[2][8];
#pragma unroll
    for (int r = 0; r < 32; ++r) {
      if (r + 1 < 32) {
#pragma unroll
        for (int j4 = 0; j4 < (r + 4) / 4; ++j4) mb[(r + 1) & 1][j4] = *(const f32x4*)(Mb + (r + 1) * 64 + j4 * 4);
      }
      float s0 = (r == c) ? 1.f : 0.f, s1 = 0.f;
#pragma unroll
      for (int j4 = 0; j4 < (r + 3) / 4; ++j4) {
        const f32x4 m = mb[r & 1][j4];
        if (j4 * 4 + 0 < r) s0 -= m.x * X[j4 * 4 + 0];
        if (j4 * 4 + 1 < r) s1 -= m.y * X[j4 * 4 + 1];
        if (j4 * 4 + 2 < r) s0 -= m.z * X[j4 * 4 + 2];
        if (j4 * 4 + 3 < r) s1 -= m.w * X[j4 * 4 + 3];
      }
      X[r] = s0 + s1;
    }
#pragma unroll
    for (int r = 0; r < 32; ++r) Tb[(blk * 32 + r) * 40 + c] = (bf16_t)(pk2(X[r], 0.f) & 0xffffu);
  } else {
    {
      const int fr = lane & 15, fq = lane >> 4;
#pragma unroll 1
      for (int bidx = wid - 1; bidx < 10; bidx += 7) KQ_BLOCK(bidx, true);
      for (int u = wid - 1; u < 6; u += 7) { const int ib = u < 3 ? 0 : (u < 5 ? 1 : 2), jb = u < 3 ? u + 1 : (u < 5 ? u - 1 : 3);
        *(u32x2*)(p.AQK + (size_t)ci * 4096 + (ib * 16 + fr) * 64 + jb * 16 + fq * 4) = (u32x2){0u, 0u}; }
    }
    for (int u = tid - 64; u < 1024; u += 448) {
      const int i8 = u & 7, d = u >> 3; float f[8];
#pragma unroll
      for (int e = 0; e < 8; ++e) { const int i = i8 * 8 + e; f[e] = bf2f(kh[i * 136 + d]) * __expf(glast - gcs[i]); }
      *(u32x4*)(p.QKV + (size_t)(T0 + (d >> 1)) * QW + 1024 + h * 128 + (d & 1) * 64 + i8 * 8) = pack8(f);
    }
    if (tid == 64) p.DL[ci] = __expf(glast);
  }
  lds_barrier();
  {
    const int l32 = lane & 31, lh = lane >> 5; const bool isV = wid >= 4;
    const bf16_t* srcl = (isV ? vh : kh) + (wid & 3) * 32 + l32; const float* rs = isV ? bet : rsk;
    bf16x8 r0[2];
#pragma unroll
    for (int s = 0; s < 2; ++s) { float f[8];
#pragma unroll
      for (int e = 0; e < 8; ++e) { const int k = 16 * s + 8 * lh + e; f[e] = bf2f(srcl[k * 136]) * rs[k]; }
      r0[s] = __builtin_bit_cast(bf16x8, pack8(f)); }
    f32x16 x0 = {};
#pragma unroll
    for (int s = 0; s < 2; ++s) x0 = __builtin_amdgcn_mfma_f32_32x32x16_bf16(*(const bf16x8*)(Tb + l32 * 40 + 16 * s + 8 * lh), r0[s], x0, 0, 0, 0);
    f32x16 y1;
#pragma unroll
    for (int r = 0; r < 16; ++r) { const int k = 32 + crow(r, lh); y1[r] = bf2f(srcl[k * 136]) * rs[k]; }
#pragma unroll
    for (int s = 0; s < 2; ++s) y1 = __builtin_amdgcn_mfma_f32_32x32x16_bf16(ld_permk(M10n + l32 * 40, s, lh), packfrag(x0, s), y1, 0, 0, 0);
    f32x16 x1 = {};
#pragma unroll
    for (int s = 0; s < 2; ++s) x1 = __builtin_amdgcn_mfma_f32_32x32x16_bf16(ld_permk(Tb + (32 + l32) * 40, s, lh), packfrag(y1, s), x1, 0, 0, 0);
    const int col = (wid & 3) * 32 + l32;
    if (!isV) {
      bf16_t* wp = p.UW + (size_t)ci * 8192 + col;
#pragma unroll
      for (int r = 0; r < 16; ++r) { const int i = crow(r, lh); wp[i * 128] = (bf16_t)(pk2(-x0[r], 0.f) & 0xffffu); wp[(32 + i) * 128] = (bf16_t)(pk2(-x1[r], 0.f) & 0xffffu); }
    } else {
      bf16_t* up = p.QKV + (size_t)(T0 + (col >> 1)) * QW + 2048 + h * 128 + (col & 1) * 64;
#pragma unroll
      for (int q = 0; q < 4; ++q) {
        u32x2 w0, w1; w0.x = pk2(x0[q * 4], x0[q * 4 + 1]); w0.y = pk2(x0[q * 4 + 2], x0[q * 4 + 3]); w1.x = pk2(x1[q * 4], x1[q * 4 + 1]); w1.y = pk2(x1[q * 4 + 2], x1[q * 4 + 3]);
        *(u32x2*)(up + q * 8 + lh * 4) = w0; *(u32x2*)(up + 32 + q * 8 + lh * 4) = w1;
      }
    }
  }
  lds_barrier();
}

__device__ void phase2(const Params& p) {
  const int G = gridDim.x;
  const int tid = launder(threadIdx.x);
  {
    const int c8 = (tid & 127) * 8;
    float w0[8], w1[8], w2[8];
#pragma unroll
    for (int e = 0; e < 8; ++e) { w0[e] = p.caw[c8 + e]; w1[e] = p.caw[DM + c8 + e]; w2[e] = p.caw[2 * DM + c8 + e]; }
#pragma unroll 1
    for (int grp = blockIdx.x * 4 + (tid >> 7); grp < NT / 8; grp += G * 4) {
      const int r0 = grp * 8;
      u32x4 pw[10], gw[8];
#pragma unroll
      for (int k = 0; k < 10; ++k) { const int r = r0 - 2 + k; pw[k] = (u32x4){0u, 0u, 0u, 0u}; if (r >= 0) pw[k] = *(const u32x4*)(p.P + (size_t)r * DM + c8); }
#pragma unroll
      for (int k = 0; k < 8; ++k) gw[k] = *(const u32x4*)(p.GATE + (size_t)(r0 + k) * DM + c8);
#pragma unroll
      for (int k = 0; k < 8; ++k) {
        const int r = r0 + k;
        float cur[8], p1[8], p2[8], g[8];
        unpack8(pw[k + 2], cur); unpack8(pw[k + 1], p1); unpack8(pw[k], p2); unpack8(gw[k], g);
        if (r < NTP) {
          const int t = r & 2047;
          if (t < 1) { for (int e = 0; e < 8; ++e) p1[e] = 0.f; }
          if (t < 2) { for (int e = 0; e < 8; ++e) p2[e] = 0.f; }
          if (t >= 2046) { float* o = p.out + OFF_NCA_P + ((size_t)(r >> 11) * 2 + (t - 2046)) * DM + c8; *(f32x4*)o = (f32x4){cur[0], cur[1], cur[2], cur[3]}; *(f32x4*)(o + 4) = (f32x4){cur[4], cur[5], cur[6], cur[7]}; }
        } else {
          const int bs = (r - NTP) >> 2, t = (r - NTP) & 3;
          const float* past = p.sca + (size_t)bs * 2 * DM + c8;
          if (t < 1) { for (int e = 0; e < 8; ++e) p1[e] = past[DM + e]; }
          if (t < 2) { for (int e = 0; e < 8; ++e) p2[e] = past[(t == 1 ? DM : 0) + e]; }
          if (t >= 2) { float* o = p.out + OFF_NCA_S + ((size_t)bs * 2 + (t - 2)) * DM + c8; *(f32x4*)o = (f32x4){cur[0], cur[1], cur[2], cur[3]}; *(f32x4*)(o + 4) = (f32x4){cur[4], cur[5], cur[6], cur[7]}; }
        }
        float o8[8];
#pragma unroll
        for (int e = 0; e < 8; ++e) o8[e] = g[e] * (w0[e] * p2[e] + w1[e] * p1[e] + w2[e] * cur[e]);
        *(u32x4*)(p.GATE + (size_t)r * DM + c8) = pack8(o8);
      }
    }
  }
  {
    extern __shared__ __attribute__((aligned(16))) unsigned char smem[];
    float* cw = (float*)(smem + 129792);
    const int tid0 = launder(threadIdx.x);
    int cur_h = -1; u32x4 pre[7];
    int task = blockIdx.x;
#pragma unroll
    for (int k = 0; k < 7; ++k) { const int u = k * 512 + tid0; pre[k] = (u32x4){0u, 0u, 0u, 0u}; if (task < 2048 && u < 67 * 48) pre[k] = raw_unit_load(p, task >> 3, task & 7, u); }
    float pg = 0.f, pb = 0.f;
    if (task < 2048 && tid0 < 64) { pg = p.BG[(size_t)((task >> 3) * 64 + tid0) * 16 + 8 + (task & 7)]; pb = p.BG[(size_t)((task >> 3) * 64 + tid0) * 16 + (task & 7)]; }
    for (; task < 2048; task += G) {
      const int h = task & 7;
      if (h != cur_h) {
        lds_barrier();
        for (int u = tid0; u < 3 * 4 * 128; u += 512) { const int part = u / 512, j = (u >> 7) & 3, col = u & 127; cw[u] = p.cbw[(size_t)j * QW + part * 1024 + h * 128 + col]; }
        cur_h = h;
      }
      const int nt = task + G;
      chunk_task(p, task >> 3, h, pre, pg, pb, nt >> 3, nt & 7, nt < 2048);
    }
  }
}

DI void cvt16(f32x16& a, int q, u32x2 w) { a[q * 4 + 0] = bflo(w.x); a[q * 4 + 1] = bfhi(w.x); a[q * 4 + 2] = bflo(w.y); a[q * 4 + 3] = bfhi(w.y); }
__device__ __forceinline__ void scan_seq(const Params& p, int seq) {
  extern __shared__ __attribute__((aligned(16))) unsigned char smem[];
  bf16_t* A1 = (bf16_t*)smem;
  bf16_t* AQ = (bf16_t*)(smem + 34816);
  bf16_t* KT = (bf16_t*)(smem + 44032);
  bf16_t* ST = (bf16_t*)(smem + 62464);
  bf16_t* UT = (bf16_t*)(smem + 97280);
  float* OS = (float*)(smem + 115712);
  const int tid = launder(threadIdx.x), wid = tid >> 6, lane = tid & 63, vb = wid & 3, hw = wid >> 2, l32 = lane & 31, lh = lane >> 5;
  const int b = seq >> 3, h = seq & 7;
  f32x16 S0 = {}, S1 = {};
  for (int i = tid; i < 128 * 136 / 8; i += 512) ((u32x4*)ST)[i] = (u32x4){0u, 0u, 0u, 0u};
  const int v = vb * 32 + l32;
  u32x4 pA[4], pQ, pK[2]; u32x2 pU[8]; float pdl;
  float onw16[16];
  { const int seg = tid & 7;
#pragma unroll
    for (int e = 0; e < 16; ++e) onw16[e] = p.onw[seg * 16 + e]; }
#define SCAN_SRC_A(nn, it) ({ const int ci_ = (b * 32 + (nn)) * 8 + h, T0_ = (b * 32 + (nn)) * 64; const int u_ = (it) * 512 + tid, r_ = u_ >> 4, c_ = (u_ & 15) * 8; \
    (const u32x4*)(r_ < 64 ? p.UW + ((size_t)ci_ * 64 + r_) * 128 + c_ : p.QKV + (size_t)(T0_ + r_ - 64) * QW + h * 128 + c_); })
#define SCAN_LOAD_A(nn) do { _Pragma("unroll") for (int it = 0; it < 4; ++it) pA[it] = *SCAN_SRC_A(nn, it); } while (0)
#define SCAN_LOAD_QK(nn) do { const int ci_ = (b * 32 + (nn)) * 8 + h, T0_ = (b * 32 + (nn)) * 64; \
    { const int r = tid >> 3, c = (tid & 7) * 8; pQ = *(const u32x4*)(p.AQK + (size_t)ci_ * 4096 + r * 64 + c); } \
    _Pragma("unroll") for (int it = 0; it < 2; ++it) { const int u = it * 512 + tid, d = u >> 3, c = (u & 7) * 8; \
      pK[it] = *(const u32x4*)(p.QKV + (size_t)(T0_ + (d >> 1)) * QW + 1024 + h * 128 + (d & 1) * 64 + c); } } while (0)
#define SCAN_LOAD_U(nn) do { const int ci_ = (b * 32 + (nn)) * 8 + h, T0_ = (b * 32 + (nn)) * 64; \
    if (hw == 0) { const bf16_t* base_ = p.QKV + (size_t)(T0_ + (v >> 1)) * QW + 2048 + h * 128 + (v & 1) * 64; \
      _Pragma("unroll") for (int q = 0; q < 4; ++q) { pU[q] = *(const u32x2*)(base_ + q * 8 + lh * 4); pU[4 + q] = *(const u32x2*)(base_ + 32 + q * 8 + lh * 4); } } \
    pdl = p.DL[ci_]; } while (0)
#define SCAN_FILL_A() do { _Pragma("unroll") for (int it = 0; it < 4; ++it) { const int u = it * 512 + tid, r = u >> 4, c = (u & 15) * 8; *(u32x4*)(A1 + r * 136 + c) = pA[it]; } } while (0)
#define SCAN_FILL_QK() do { { const int r = tid >> 3, c = (tid & 7) * 8; *(u32x4*)(AQ + r * 72 + c) = pQ; } \
    _Pragma("unroll") for (int it = 0; it < 2; ++it) { const int u = it * 512 + tid, d = u >> 3, c = (u & 7) * 8; *(u32x4*)(KT + d * 72 + c) = pK[it]; } } while (0)
  SCAN_LOAD_A(0); SCAN_LOAD_QK(0); SCAN_LOAD_U(0);
  SCAN_FILL_A(); SCAN_FILL_QK();
  SCAN_LOAD_A(1); SCAN_LOAD_QK(1);
  lds_barrier();
#pragma unroll 1
  for (int n = 0; n < 32; ++n) {
    const int cgi = b * 32 + n, T0 = cgi * 64;
    f32x16 a0 = {}, a1 = {};
    if (hw == 0) {
#pragma unroll
      for (int q = 0; q < 4; ++q) { cvt16(a0, q, pU[q]); cvt16(a1, q, pU[4 + q]); }
    }
    const float dl = pdl;
    if (n + 1 < 32) SCAN_LOAD_U(n + 1);
    u32x4 zz0, zz1;
    { const int i = tid >> 3, seg = tid & 7; const size_t tok = (size_t)T0 + i; zz0 = *(const u32x4*)(p.SBZ + tok * DM + h * 128 + seg * 16); zz1 = *(const u32x4*)(p.SBZ + tok * DM + h * 128 + seg * 16 + 8); }
#pragma unroll
    for (int ks = 0; ks < 8; ++ks) {
      const bf16x8 bfr = *(const bf16x8*)(ST + v * 136 + ks * 16 + lh * 8);
      const bf16x8 x0 = *(const bf16x8*)(A1 + (hw * 64 + l32) * 136 + ks * 16 + lh * 8), x1 = *(const bf16x8*)(A1 + (hw * 64 + 32 + l32) * 136 + ks * 16 + lh * 8);
      a0 = __builtin_amdgcn_mfma_f32_32x32x16_bf16(x0, bfr, a0, 0, 0, 0);
      a1 = __builtin_amdgcn_mfma_f32_32x32x16_bf16(x1, bfr, a1, 0, 0, 0);
    }
    if (hw == 0) {
#pragma unroll
      for (int q = 0; q < 4; ++q) {
        u32x2 w0, w1; w0.x = pk2(a0[q * 4], a0[q * 4 + 1]); w0.y = pk2(a0[q * 4 + 2], a0[q * 4 + 3]); w1.x = pk2(a1[q * 4], a1[q * 4 + 1]); w1.y = pk2(a1[q * 4 + 2], a1[q * 4 + 3]);
        *(u32x2*)(UT + v * 72 + q * 8 + lh * 4) = w0; *(u32x2*)(UT + v * 72 + 32 + q * 8 + lh * 4) = w1;
      }
    }
    lds_barrier();
    S0 *= dl; S1 *= dl;
#pragma unroll
    for (int ks = 0; ks < 4; ++ks) {
      const bf16x8 bfr = *(const bf16x8*)(UT + v * 72 + ks * 16 + lh * 8);
      if (hw == 1) {
        const bf16x8 x0 = *(const bf16x8*)(AQ + l32 * 72 + ks * 16 + lh * 8), x1 = *(const bf16x8*)(AQ + (32 + l32) * 72 + ks * 16 + lh * 8);
        a0 = __builtin_amdgcn_mfma_f32_32x32x16_bf16(x0, bfr, a0, 0, 0, 0);
        a1 = __builtin_amdgcn_mfma_f32_32x32x16_bf16(x1, bfr, a1, 0, 0, 0);
      }
      const bf16x8 k0 = *(const bf16x8*)(KT + ((2 * hw) * 32 + l32) * 72 + ks * 16 + lh * 8), k1 = *(const bf16x8*)(KT + ((2 * hw + 1) * 32 + l32) * 72 + ks * 16 + lh * 8);
      S0 = __builtin_amdgcn_mfma_f32_32x32x16_bf16(k0, bfr, S0, 0, 0, 0);
      S1 = __builtin_amdgcn_mfma_f32_32x32x16_bf16(k1, bfr, S1, 0, 0, 0);
    }
    if (n + 1 < 32) { SCAN_FILL_A(); if (n + 2 < 32) SCAN_LOAD_A(n + 2); }
#pragma unroll
    for (int q = 0; q < 4; ++q) {
      u32x2 w0, w1; w0.x = pk2(S0[q * 4], S0[q * 4 + 1]); w0.y = pk2(S0[q * 4 + 2], S0[q * 4 + 3]); w1.x = pk2(S1[q * 4], S1[q * 4 + 1]); w1.y = pk2(S1[q * 4 + 2], S1[q * 4 + 3]);
      *(u32x2*)(ST + v * 136 + (2 * hw) * 32 + q * 8 + lh * 4) = w0; *(u32x2*)(ST + v * 136 + (2 * hw + 1) * 32 + q * 8 + lh * 4) = w1;
    }
    if (hw == 1) {
#pragma unroll
      for (int r = 0; r < 16; ++r) { const int i = (r & 3) + 8 * (r >> 2) + 4 * lh; OS[i * 132 + v] = a0[r]; OS[(32 + i) * 132 + v] = a1[r]; }
    }
    lds_barrier();
    {
      const int i = tid >> 3, seg = tid & 7; const float* orow = OS + i * 132 + seg * 16; float o[16]; float ss = 0.f;
#pragma unroll
      for (int e4 = 0; e4 < 4; ++e4) { const f32x4 t = *(const f32x4*)(orow + e4 * 4); o[e4 * 4] = t.x; o[e4 * 4 + 1] = t.y; o[e4 * 4 + 2] = t.z; o[e4 * 4 + 3] = t.w; ss += (t.x * t.x + t.y * t.y) + (t.z * t.z + t.w * t.w); }
      ss += __shfl_xor(ss, 1); ss += __shfl_xor(ss, 2); ss += __shfl_xor(ss, 4);
      const float rstd = rsqrtf(ss * (1.f / 128.f) + EPS);
      const size_t tok = (size_t)T0 + i; float z[16];
      unpack8(zz0, z); unpack8(zz1, z + 8);
#pragma unroll
      for (int e = 0; e < 16; ++e) o[e] = o[e] * rstd * onw16[e] * z[e];
      bf16_t* dst = p.QKV + tok * QW + 2048 + h * 128 + seg * 16;
      *(u32x4*)dst = pack8(o); *(u32x4*)(dst + 8) = pack8(o + 8);
    }
    if (n + 1 < 32) { SCAN_FILL_QK(); if (n + 2 < 32) SCAN_LOAD_QK(n + 2); }
  }
  float* sp = p.out + OFF_ND_P + (size_t)(b * 8 + h) * 16384;
#pragma unroll
  for (int r = 0; r < 16; ++r) { const int dd = (r & 3) + 8 * (r >> 2) + 4 * lh; sp[(size_t)((2 * hw) * 32 + dd) * 128 + v] = S0[r]; sp[(size_t)((2 * hw + 1) * 32 + dd) * 128 + v] = S1[r]; }
  lds_barrier();
}

__device__ __forceinline__ void sample_seq(const Params& p, int s, f32x4 (&Sn)[8], int s_next) {
  extern __shared__ __attribute__((aligned(16))) unsigned char smem[];
  float* qs = (float*)smem;
  float* ks = qs + 512;
  float* vs = ks + 512;
  float* os = vs + 512;
  float* red = os + 512;
  const int tid = launder(threadIdx.x), bs = s >> 3, h = s & 7;
  const size_t Tb = (size_t)NTP + bs * 4;
  const int kg = tid >> 5, vg = tid & 31;
  f32x4 S[8];
#pragma unroll
  for (int kk = 0; kk < 8; ++kk) S[kk] = Sn[kk];
  if (s_next >= 0) { const float* sn = p.sd + ((size_t)s_next * 128 + kg * 8) * 128 + vg * 4;
#pragma unroll
    for (int kk = 0; kk < 8; ++kk) Sn[kk] = ldnt4(sn + kk * 128); }
  float ga[4], be[4];
#pragma unroll
  for (int t = 0; t < 4; ++t) { ga[t] = p.BG[(Tb + t) * 16 + 8 + h]; be[t] = p.BG[(Tb + t) * 16 + h]; }
  u32x4 zt = {0u, 0u, 0u, 0u}; float ow[8];
  { const int t = (tid >> 4) & 3, seg = tid & 15; zt = *(const u32x4*)(p.SBZ + (Tb + t) * DM + h * 128 + seg * 8);
#pragma unroll
    for (int e = 0; e < 8; ++e) ow[e] = p.onw[seg * 8 + e]; }
  if (tid < 192) {
    const int c8 = tid & 15, grp = tid >> 4, part = grp % 3, t = grp / 3;
    const int colw = part * 1024 + h * 128 + c8 * 8;
    float a[8] = {0.f, 0.f, 0.f, 0.f, 0.f, 0.f, 0.f, 0.f};
#pragma unroll
    for (int j = 0; j < 4; ++j) {
      const int e_ = t + j; float x[8];
      if (e_ < 3) { const float* ps = p.scq + ((size_t)bs * 3 + e_) * QW + colw; for (int e = 0; e < 8; ++e) x[e] = ps[e]; }
      else unpack8(*(const u32x4*)(p.QKV + (Tb + e_ - 3) * QW + colw), x);
      const float* w = p.cbw + j * QW + colw;
#pragma unroll
      for (int e = 0; e < 8; ++e) a[e] += x[e] * w[e];
      if (j == 3 && t >= 1) { float* o = p.out + OFF_NCQ_S + ((size_t)bs * 3 + (t - 1)) * QW + colw; for (int e = 0; e < 8; ++e) o[e] = x[e]; }
    }
    float ss = 0.f;
#pragma unroll
    for (int e = 0; e < 8; ++e) { a[e] = siluf(a[e]); ss += a[e] * a[e]; }
    ss += __shfl_xor(ss, 1); ss += __shfl_xor(ss, 2); ss += __shfl_xor(ss, 4); ss += __shfl_xor(ss, 8);
    if (part < 2) { const float sc = rsqrtf(ss + EPS) * (part == 0 ? 0.08838834764831845f : 1.f); for (int e = 0; e < 8; ++e) a[e] *= sc; }
    float* d = (part == 0 ? qs : (part == 1 ? ks : vs)) + t * 128 + c8 * 8;
#pragma unroll
    for (int e = 0; e < 8; ++e) d[e] = a[e];
  }
  lds_barrier();
#pragma unroll
  for (int t = 0; t < 4; ++t) {
    const float a = __expf(ga[t]), beta = be[t];
    f32x4 part = {0.f, 0.f, 0.f, 0.f};
#pragma unroll
    for (int kk = 0; kk < 8; ++kk) { S[kk] *= a; part += S[kk] * ks[t * 128 + kg * 8 + kk]; }
    *(f32x4*)(red + kg * 128 + vg * 4) = part;
    lds_barrier();
    f32x4 r = {0.f, 0.f, 0.f, 0.f};
#pragma unroll
    for (int g2 = 0; g2 < 16; ++g2) r += *(const f32x4*)(red + g2 * 128 + vg * 4);
    const f32x4 dlt = (*(const f32x4*)(vs + t * 128 + vg * 4) - r) * beta;
    f32x4 po = {0.f, 0.f, 0.f, 0.f};
#pragma unroll
    for (int kk = 0; kk < 8; ++kk) { S[kk] += dlt * ks[t * 128 + kg * 8 + kk]; po += S[kk] * qs[t * 128 + kg * 8 + kk]; }
    lds_barrier();
    *(f32x4*)(red + kg * 128 + vg * 4) = po;
    lds_barrier();
    if (tid < 128) { float o = 0.f; for (int g2 = 0; g2 < 16; ++g2) o += red[g2 * 128 + tid]; os[t * 128 + tid] = o; }
    lds_barrier();
  }
  float* so = p.out + OFF_ND_S + ((size_t)s * 128 + kg * 8) * 128 + vg * 4;
#pragma unroll
  for (int kk = 0; kk < 8; ++kk) stnt4(so + kk * 128, S[kk]);
  if (tid < 64) {
    const int t = tid >> 4, seg = tid & 15; float o[8]; float ss = 0.f;
#pragma unroll
    for (int e = 0; e < 8; ++e) { o[e] = os[t * 128 + seg * 8 + e]; ss += o[e] * o[e]; }
    ss += __shfl_xor(ss, 1); ss += __shfl_xor(ss, 2); ss += __shfl_xor(ss, 4); ss += __shfl_xor(ss, 8);
    const float rstd = rsqrtf(ss * (1.f / 128.f) + EPS); float z[8];
    unpack8(zt, z);
#pragma unroll
    for (int e = 0; e < 8; ++e) o[e] = o[e] * rstd * ow[e] * z[e];
    *(u32x4*)(p.QKV + (Tb + t) * QW + 2048 + h * 128 + seg * 8) = pack8(o);
  }
  lds_barrier();
}

__device__ void phase3(const Params& p) {
  const int G = gridDim.x, bid = blockIdx.x;
  const bool split = G > 64;
#ifndef P3_NO_SCAN
  if (!split || bid < 64) for (int seq = bid; seq < 64; seq += (split ? 64 : G)) scan_seq(p, seq);
#endif
  if (!split || bid >= 64) {
    const int wk = split ? bid - 64 : bid, NW = split ? G - 64 : G;
#ifndef P3_NO_GEMM
    { extern __shared__ __attribute__((aligned(16))) unsigned char smem[];
      Sched S; S.init_strided(wk, NW, 264); gemm_phase<1>(p, (LAS unsigned char*)smem, p.GATE, DM, p.WOA, S); }
#endif
#ifndef P3_NO_SAMPLE
    {
      const int n2 = (264 > NW && 264 < 2 * NW) ? 264 - NW : 0, n1 = NW - n2;
      const int s_first = wk < n2 ? 1024 : (wk - n2), s_step = n1, s_end = 1024;
      f32x4 Sn[8];
      if (s_first < s_end) { const int tid_ = launder(threadIdx.x); const float* sn = p.sd + ((size_t)s_first * 128 + (tid_ >> 5) * 8) * 128 + (tid_ & 31) * 4;
#pragma unroll
        for (int kk = 0; kk < 8; ++kk) Sn[kk] = ldnt4(sn + kk * 128); }
      for (int s = s_first; s < s_end; s += s_step) sample_seq(p, s, Sn, s + s_step < s_end ? s + s_step : -1);
    }
#endif
  }
}

__device__ void phase4(const Params& p) {
  extern __shared__ __attribute__((aligned(16))) unsigned char smem[];
  Sched S; S.init_strided(blockIdx.x, gridDim.x, 256); gemm_phase<2>(p, (LAS unsigned char*)smem, p.QKV + 2048, QW, p.WOB, S);
  gemm_tail<2>(p, p.QKV + 2048, QW, p.WOB, 256, 8);
}
__device__ void phase5(const Params& p) {
  extern __shared__ __attribute__((aligned(16))) unsigned char smem[];
  Sched S; S.init_strided(blockIdx.x, gridDim.x, 256);
  gemm_phase<4>(p, (LAS unsigned char*)smem, p.UW, DM, p.WO, S);
  gemm_tail<3>(p, p.UW, DM, p.WO, 256, 8);
}
__device__ void phase6(const Params& p) {
  const int tid = launder(threadIdx.x), wid = tid >> 6, lane = tid & 63, G = gridDim.x;
  f32x4 w[4];
#pragma unroll
  for (int i = 0; i < 4; ++i) w[i] = *(const f32x4*)(p.fnw + i * 256 + lane * 4);
  const int row_lo = (G == 256) ? NTP : 0;
#pragma unroll 1
  for (int row = row_lo + (blockIdx.x * 8 + wid) * 4; row < NT; row += G * 8 * 4) {
    f32x4 v[4][4];
#pragma unroll
    for (int q = 0; q < 4; ++q)
#pragma unroll
      for (int i = 0; i < 4; ++i) v[q][i] = *(const f32x4*)(p.out + (size_t)(row + q) * DM + i * 256 + lane * 4);
#pragma unroll
    for (int q = 0; q < 4; ++q) {
      float ss = 0.f;
#pragma unroll
      for (int i = 0; i < 4; ++i) ss += (v[q][i].x * v[q][i].x + v[q][i].y * v[q][i].y) + (v[q][i].z * v[q][i].z + v[q][i].w * v[q][i].w);
      ss = wave_sum(ss);
      const float rstd = rsqrtf(ss * (1.f / DM) + EPS);
#pragma unroll
      for (int i = 0; i < 4; ++i) *(f32x4*)(p.out + (size_t)(row + q) * DM + i * 256 + lane * 4) = v[q][i] * rstd * w[i];
    }
  }
}

#define XB_TMO      128
#define XB_XCNT(j)  (256  + 64 * (j))
#define XB_XSUB(j)  (1280 + 64 * (j))
#define XB_XGEN(j)  (2304 + 64 * (j))
#define XB_TOP      3328
#define XB_TOPGEN   3392
#define XCD_BAR_WORDS 3456
#define XB_SPIN_CAP (1u << 18)
DI unsigned xb_ld(unsigned* p) { return __hip_atomic_load(p, __ATOMIC_RELAXED, __HIP_MEMORY_SCOPE_AGENT); }
DI unsigned xb_add(unsigned* p, unsigned v) { return __hip_atomic_fetch_add(p, v, __ATOMIC_RELAXED, __HIP_MEMORY_SCOPE_AGENT); }
DI unsigned xb_xcc_id() { return (unsigned)__builtin_amdgcn_s_getreg((3 << 11) | 20) & 0xFu; }
#define XB_SPIN(cond, bar) do { unsigned _sp = 0; while (cond) { __builtin_amdgcn_s_sleep(1); \
    if ((++_sp & 255u) == 0u) { if (xb_ld(&(bar)[XB_TMO])) break; if (_sp > XB_SPIN_CAP) { atomicAdd(&(bar)[XB_TMO], 1u); break; } } } } while (0)
struct XcdBarrier { unsigned* bar; unsigned x; volatile LAS unsigned* st; };
DI XcdBarrier xcd_barrier_post(unsigned* bar, volatile LAS unsigned* st) {
  XcdBarrier b; b.bar = bar; b.x = xb_xcc_id(); b.st = st;
  if (threadIdx.x == 0) (void)xb_add(&bar[XB_XCNT(b.x)], 1u);
  return b;
}
DI void xcd_barrier_complete(unsigned* bar, unsigned x, unsigned& nloc, unsigned& nx) {
  const unsigned G = gridDim.x * gridDim.y * gridDim.z;
  unsigned sum, cnt, mine, sp = 0u;
  for (;;) {
    sum = 0u; cnt = 0u; mine = 0u;
#pragma unroll
    for (unsigned j = 0; j < 16; ++j) { const unsigned c = xb_ld(&bar[XB_XCNT(j)]); sum += c; cnt += (c > 0u) ? 1u : 0u; mine = (j == x) ? c : mine; }
    if (sum == G) break;
    __builtin_amdgcn_s_sleep(1);
    if ((++sp & 255u) == 0u) { if (xb_ld(&bar[XB_TMO])) break; if (sp > XB_SPIN_CAP) { atomicAdd(&bar[XB_TMO], 1u); break; } }
  }
  nloc = mine > 0u ? mine : 1u; nx = cnt > 0u ? cnt : 1u;
}
DI void xcd_barrier(const XcdBarrier& b) {
  asm volatile("s_waitcnt vmcnt(0)" ::: "memory");
  __syncthreads();
  if (threadIdx.x == 0) {
    unsigned* bar = b.bar;
    __builtin_amdgcn_s_waitcnt(0);
    unsigned nloc = b.st[0], nx = b.st[1];
    if (nloc == 0u) { xcd_barrier_complete(bar, b.x, nloc, nx); b.st[0] = nloc; b.st[1] = nx; }
    const unsigned old = xb_add(&bar[XB_XSUB(b.x)], 1u);
    const unsigned gen = old / nloc;
    if (old + 1u == (gen + 1u) * nloc) {
      __builtin_amdgcn_fence(__ATOMIC_RELEASE, "agent");
      asm volatile("s_waitcnt vmcnt(0)" ::: "memory");
      const unsigned og = xb_add(&bar[XB_TOP], 1u);
      const unsigned tg = og / nx;
      if (og + 1u == (tg + 1u) * nx) xb_add(&bar[XB_TOPGEN], 1u);
      else XB_SPIN(xb_ld(&bar[XB_TOPGEN]) == tg, bar);
      __builtin_amdgcn_fence(__ATOMIC_ACQUIRE, "agent");
      xb_add(&bar[XB_XGEN(b.x)], 1u);
      asm volatile("s_waitcnt vmcnt(0)" ::: "memory");
    } else {
      XB_SPIN(xb_ld(&bar[XB_XGEN(b.x)]) == gen, bar);
      __builtin_amdgcn_fence(__ATOMIC_ACQUIRE, "agent");
      asm volatile("s_waitcnt vmcnt(0)" ::: "memory");
    }
  }
  __syncthreads();
}

__global__ void __launch_bounds__(512, 2) mega(Params p, int ph_lo, int ph_hi) {
  cg::grid_group grid = cg::this_grid();
  const int lo = ph_lo, hi = ph_hi;
  extern __shared__ __attribute__((aligned(16))) unsigned char smem[];
  volatile LAS unsigned* st = (volatile LAS unsigned*)((LAS unsigned char*)smem + 149504);
  if (threadIdx.x < 4) st[threadIdx.x] = 0u;
  __syncthreads();
  XcdBarrier xb; xb.bar = p.bar; xb.x = 0; xb.st = st;
  if (hi - lo > 1) xb = xcd_barrier_post(p.bar, st);
  if (hi > 100) grid.sync();
#define GRID_SYNC() xcd_barrier(xb)
#define IN(k) (lo <= (k) && (k) < hi)
#define BOTH(k) (IN(k) && IN((k) + 1))
  if (IN(0)) { phase0(p); if (BOTH(0)) GRID_SYNC(); }
  if (IN(1)) { phase1(p); if (BOTH(1)) GRID_SYNC(); }
  if (IN(2)) { phase2(p); if (BOTH(2)) GRID_SYNC(); }
  if (IN(3)) { phase3(p); if (BOTH(3)) GRID_SYNC(); }
  if (IN(4)) { phase4(p); if (BOTH(4)) GRID_SYNC(); }
  if (IN(5)) { phase5(p); if (BOTH(5)) GRID_SYNC(); }
  if (IN(6)) { phase6(p); }
}

extern "C" void kernel_launch(void* const* d_in, const int* in_sizes, int n_in, void* d_out, int out_size, void* d_ws, size_t ws_size, hipStream_t stream) {
  static int grid = 0;
  if (grid == 0) {
    int dev = 0, cus = 0, per_cu = 0;
    hipGetDevice(&dev);
    hipDeviceGetAttribute(&cus, hipDeviceAttributeMultiprocessorCount, dev);
    if (hipFuncSetAttribute((const void*)mega, hipFuncAttributeMaxDynamicSharedMemorySize, LDS_BYTES) != hipSuccess) fprintf(stderr, "hipFuncSetAttribute failed\n");
    hipOccupancyMaxActiveBlocksPerMultiprocessor(&per_cu, (const void*)mega, 512, LDS_BYTES);
    if (per_cu < 1) { fprintf(stderr, "occupancy query says %d\n", per_cu); per_cu = 1; }
    (void)hipGetLastError();
    grid = cus;
  }
  Params p{};
  p.x_p = (const float*)d_in[0]; p.x_s = (const float*)d_in[1]; p.sca = (const float*)d_in[2]; p.scq = (const float*)d_in[3]; p.sd = (const float*)d_in[4];
  p.w_in = (const float*)d_in[5]; p.caw = (const float*)d_in[6]; p.cbw = (const float*)d_in[7]; p.a_log = (const float*)d_in[8]; p.dt_bias = (const float*)d_in[9];
  p.onw = (const float*)d_in[10]; p.w_oa = (const float*)d_in[11]; p.w_ob = (const float*)d_in[12]; p.w_o = (const float*)d_in[13]; p.nw = (const float*)d_in[14]; p.fnw = (const float*)d_in[15];
  p.out = (float*)d_out;
  unsigned char* ws = (unsigned char*)d_ws; size_t o = 0;
  auto take = [&](size_t bytes) { unsigned char* r = ws + o; o += (bytes + 255) & ~(size_t)255; return r; };
  p.QKV = (bf16_t*)take((size_t)NT * QW * 2);
  p.SBZ = (bf16_t*)take((size_t)NT * DM * 2);
  p.GATE = (bf16_t*)take((size_t)NT * DM * 2);
  p.UW = (bf16_t*)take((size_t)NT * DM * 2);
  p.AQK = (bf16_t*)take((size_t)2048 * 4096 * 2);
  p.WOA = (bf16_t*)take((size_t)DM * DM * 2); p.WOB = (bf16_t*)take((size_t)DM * DM * 2); p.WO = (bf16_t*)take((size_t)DM * DM * 2);
  p.WB16 = (bf16_t*)take(16 * DM * 2);
  p.BG = (float*)take((size_t)NT * 16 * 4);
  p.DL = (float*)take(2048 * 4);
  p.bar = (unsigned*)take((XCD_BAR_WORDS + 64 * 64) * 4);
  p.RS = (float*)take(64 * 4 * 256 * 4);
  if (o > ws_size) { fprintf(stderr, "workspace too small: need %zu have %zu\n", o, ws_size); return; }
  p.SGA = (bf16_t*)d_out; p.SGB = p.SGA + (size_t)NT * DM;
  unsigned char* nds = (unsigned char*)((float*)d_out + OFF_ND_S);
  p.WIN = (bf16_t*)nds; p.P = (bf16_t*)(nds + (size_t)10240 * DM * 2); p.HALO = (bf16_t*)(nds + (size_t)10240 * DM * 2 + (size_t)NT * DM * 2);
#if COOP
  if (hipMemsetAsync(p.bar, 0, (XCD_BAR_WORDS + 64 * 64) * 4, stream) != hipSuccess) fprintf(stderr, "memset of barrier words failed\n");
  int lo = 0, hi = 7; void* args[] = {&p, &lo, &hi};
  hipError_t e = hipLaunchCooperativeKernel((const void*)mega, dim3(grid), dim3(512), args, LDS_BYTES, stream);
  if (e != hipSuccess) fprintf(stderr, "cooperative launch failed: %s\n", hipGetErrorString(e));
#else
  for (int ph = 0; ph < 7; ++ph) { hipLaunchKernelGGL(mega, dim3(grid), dim3(512), LDS_BYTES, stream, p, ph, ph + 1); if (ph == DUP) hipLaunchKernelGGL(mega, dim3(grid), dim3(512), LDS_BYTES, stream, p, ph, ph + 1); }
#endif
}
```

```cpp
#include <hip/hip_runtime.h>
#include <hip/hip_cooperative_groups.h>
#include <cstdio>
#include <cstdint>
namespace cg = cooperative_groups;

#ifndef COOP
#define COOP 1
#endif
#ifndef DUP
#define DUP -1
#endif

typedef unsigned short bf16_t;
typedef short bf16x8 __attribute__((ext_vector_type(8)));
typedef float f32x4 __attribute__((ext_vector_type(4)));
typedef float f32x2 __attribute__((ext_vector_type(2)));
typedef float f32x16 __attribute__((ext_vector_type(16)));
typedef unsigned u32x4 __attribute__((ext_vector_type(4)));
typedef unsigned u32x2 __attribute__((ext_vector_type(2)));
typedef __bf16 bf16x2_t __attribute__((ext_vector_type(2)));

#define DI __device__ __forceinline__

constexpr int NT = 16896, NTP = 16384, DM = 1024, QW = 3072, NIN = 10256;
constexpr float EPS = 1e-6f;
constexpr size_t OFF_NCA_P = 17301504, OFF_NCQ_P = 17317888, OFF_ND_P = 17391616, OFF_NCA_S = 18440192, OFF_NCQ_S = 18702336, OFF_ND_S = 19881984;
constexpr int LDS_BYTES = 149504 + 16;

struct Params {
  const float *x_p, *x_s, *sca, *scq, *sd, *w_in, *caw, *cbw, *a_log, *dt_bias, *onw, *w_oa, *w_ob, *w_o, *nw, *fnw;
  float* out;
  bf16_t *QKV, *SBZ, *GATE, *UW, *AQK, *WOA, *WOB, *WO, *WB16;
  float *BG, *DL;
  bf16_t *SGA, *SGB, *WIN, *P, *HALO;
  unsigned* bar;
  float* RS;
};

DI unsigned pk2(float a, float b) { bf16x2_t v = __builtin_convertvector((f32x2){a, b}, bf16x2_t); return __builtin_bit_cast(unsigned, v); }
DI float bflo(unsigned w) { return __uint_as_float(w << 16); }
DI float bfhi(unsigned w) { return __uint_as_float(w & 0xffff0000u); }
DI float bf2f(bf16_t v) { return __uint_as_float(((unsigned)v) << 16); }
DI float siluf(float x) { return x * __builtin_amdgcn_rcpf(1.f + __expf(-x)); }
DI float sigmf(float x) { return __builtin_amdgcn_rcpf(1.f + __expf(-x)); }
DI f32x4 ldnt4(const float* q) { return __builtin_nontemporal_load((const f32x4*)q); }
DI void stnt4(float* q, f32x4 v) { __builtin_nontemporal_store(v, (f32x4*)q); }
DI float wave_sum(float v) {
#pragma unroll
  for (int o = 1; o < 64; o <<= 1) v += __shfl_xor(v, o);
  return v;
}
DI void unpack8(u32x4 w, float* f) { f[0] = bflo(w.x); f[1] = bfhi(w.x); f[2] = bflo(w.y); f[3] = bfhi(w.y); f[4] = bflo(w.z); f[5] = bfhi(w.z); f[6] = bflo(w.w); f[7] = bfhi(w.w); }
DI u32x4 pack8(const float* f) { u32x4 w; w.x = pk2(f[0], f[1]); w.y = pk2(f[2], f[3]); w.z = pk2(f[4], f[5]); w.w = pk2(f[6], f[7]); return w; }

DI int perm32(int rho) { const int n = rho >> 4, i = rho & 15; return 8 * (i >> 2) + 4 * n + (i & 3); }
DI int colmap_in(int R) {
  const int pn = R >> 8, l = R & 255, bj = l >> 7, wc = (l & 127) >> 5, rho = l & 31;
  if (pn < 16) { const int n = rho >> 4, i = rho & 15; return (bj * 2 + n) * 1024 + 64 * pn + wc * 16 + i; }
  const int base = pn < 32 ? 4096 + (pn - 16) * 256 : 8208 + (pn - 32) * 256;
  return base + bj * 128 + wc * 32 + perm32(rho);
}
DI int colmap_sq(int R) { return (R & ~31) + perm32(R & 31); }

constexpr int BM = 256, BK = 64, HALF = 128, NXCD = 8, WGM = 8, HT = HALF * BK;
DI void lds_barrier() { asm volatile("s_waitcnt lgkmcnt(0)" ::: "memory"); __builtin_amdgcn_s_barrier(); asm volatile("" ::: "memory"); }
DI int launder(int x) { asm volatile("" : "+v"(x)); return x; }
DI int lds_byte(int r, int c) { const int st = (r >> 4) * 2 + (c >> 5), rr = r & 15, cc = c & 31, ob = rr * 64 + cc * 2; return st * 1024 + (ob ^ (((ob >> 9) & 1) << 5)); }
DI void stage_rc(int b, int& R, int& C) { const int st = b / 1024, sb = b % 1024, swz = sb ^ (((sb >> 9) & 1) << 5); R = (st >> 1) * 16 + swz / 64; C = (st & 1) * 32 + (swz % 64) / 2; }

struct TileOrder {
  int nM, nN, nwg, G, c;
  DI void init(int M, int N, int G_, int c_) { nM = M / BM; nN = N / BM; nwg = nM * nN; G = G_; c = c_; }
  DI bool next(int i, int& pm, int& pn) const {
    const long L = (long)i * G + c; if (L >= nwg) return false;
    int wgid = (int)L; { const int q = nwg / NXCD, r = nwg % NXCD, xcd = wgid % NXCD, off = wgid / NXCD; wgid = (xcd < r ? xcd * (q + 1) : r * (q + 1) + (xcd - r) * q) + off; }
    const int nig = WGM * nN, gid = wgid / nig, fm = gid * WGM, gsz = (nM - fm) < WGM ? (nM - fm) : WGM;
    pm = fm + ((wgid % nig) % gsz); pn = (wgid % nig) / gsz; return true;
  }
};

#define FN_CNT(pm) (XCD_BAR_WORDS_C + 64 * (pm))
constexpr int XCD_BAR_WORDS_C = 3456;
DI void epilogue_final(const Params& p, f32x4 (&acc)[2][2][4][2], int pm, int pn, int wr, int wc, int fr, int fq, unsigned char* smem_, int tid) {
  float* PS = (float*)(smem_ + 131072);
  float* RSTD = (float*)(smem_ + 131072 + 4096);
  const int col0 = pn * BM + wc * 32 + 8 * fq;
#pragma unroll
  for (int ai = 0; ai < 2; ++ai)
#pragma unroll
    for (int m = 0; m < 4; ++m) {
      const int rl = ai * HALF + wr * 64 + m * 16 + fr; const size_t row = (size_t)pm * BM + rl;
      const float* xr = p.x_p + row * DM;
      float ss = 0.f;
#pragma unroll
      for (int bj = 0; bj < 2; ++bj) {
        const f32x4 x0 = ldnt4(xr + col0 + bj * HALF), x1 = ldnt4(xr + col0 + bj * HALF + 4);
        acc[ai][bj][m][0] += x0; acc[ai][bj][m][1] += x1;
        const f32x4 a = acc[ai][bj][m][0], b = acc[ai][bj][m][1];
        ss += (a.x * a.x + a.y * a.y) + (a.z * a.z + a.w * a.w) + (b.x * b.x + b.y * b.y) + (b.z * b.z + b.w * b.w);
      }
      ss += __shfl_xor(ss, 16); ss += __shfl_xor(ss, 32);
      if (fq == 0) PS[rl * 4 + wc] = ss;
      __builtin_amdgcn_sched_barrier(0);
    }
  lds_barrier();
  unsigned* cnt = p.bar + FN_CNT(pm);
  if (tid < 256) {
    const f32x4 s4 = *(const f32x4*)(PS + tid * 4);
    __hip_atomic_store((unsigned*)p.RS + ((size_t)(pm * 4 + pn) * 256 + tid), __float_as_uint((s4.x + s4.y) + (s4.z + s4.w)), __ATOMIC_RELAXED, __HIP_MEMORY_SCOPE_AGENT);
  }
  asm volatile("s_waitcnt vmcnt(0)" ::: "memory");
  lds_barrier();
  if (tid == 0) __hip_atomic_fetch_add(cnt, 1u, __ATOMIC_RELAXED, __HIP_MEMORY_SCOPE_AGENT);
  if (tid < 64) {
    unsigned sp = 0;
    while ((unsigned)__builtin_amdgcn_readfirstlane(__hip_atomic_load(cnt, __ATOMIC_RELAXED, __HIP_MEMORY_SCOPE_AGENT)) < 4u) { __builtin_amdgcn_s_sleep(2); if (++sp > (1u << 20)) break; }
    __builtin_amdgcn_fence(__ATOMIC_ACQUIRE, "agent");
  }
  asm volatile("s_waitcnt vmcnt(0) lgkmcnt(0)" ::: "memory");
  lds_barrier();
  if (tid < 256) {
    float tot = 0.f;
#pragma unroll
    for (int t = 0; t < 4; ++t) tot += __uint_as_float(__hip_atomic_load((unsigned*)p.RS + ((size_t)(pm * 4 + t) * 256 + tid), __ATOMIC_RELAXED, __HIP_MEMORY_SCOPE_AGENT));
    RSTD[tid] = rsqrtf(tot * (1.f / DM) + EPS);
  }
  lds_barrier();
#pragma unroll
  for (int bj = 0; bj < 2; ++bj) {
    const f32x4 fw0 = *(const f32x4*)(p.fnw + col0 + bj * HALF), fw1 = *(const f32x4*)(p.fnw + col0 + bj * HALF + 4);
#pragma unroll
    for (int ai = 0; ai < 2; ++ai)
#pragma unroll
      for (int m = 0; m < 4; ++m) {
        const int rl = ai * HALF + wr * 64 + m * 16 + fr; const size_t row = (size_t)pm * BM + rl; const float r = RSTD[rl];
        float* o = p.out + row * DM + col0 + bj * HALF;
        stnt4(o, acc[ai][bj][m][0] * r * fw0); stnt4(o + 4, acc[ai][bj][m][1] * r * fw1);
        __builtin_amdgcn_sched_barrier(0);
      }
  }
}

template <int EPI>
DI void epilogue(const Params& p, const f32x4 (&acc)[2][2][4][2], int pm, int pn, int wr, int wc, int fr, int fq) {
  const int row0 = pm * BM + wr * 64 + fr;
  if (EPI == 0) {
    if (pn < 16) {
      const int ch = pn * 64 + wc * 16 + fq * 4;
#pragma unroll
      for (int ai = 0; ai < 2; ++ai)
#pragma unroll
        for (int m = 0; m < 4; ++m) {
          const size_t row = row0 + ai * HALF + m * 16;
          const f32x4 b = acc[ai][0][m][0], c = acc[ai][0][m][1], h = acc[ai][1][m][0], z = acc[ai][1][m][1];
          u32x2 pp, gg;
          pp.x = pk2(c[0] * h[0], c[1] * h[1]); pp.y = pk2(c[2] * h[2], c[3] * h[3]);
          gg.x = pk2(siluf(z[0]) * b[0], siluf(z[1]) * b[1]); gg.y = pk2(siluf(z[2]) * b[2], siluf(z[3]) * b[3]);
          *(u32x2*)(p.P + row * DM + ch) = pp;
          *(u32x2*)(p.GATE + row * DM + ch) = gg;
        }
    } else {
      const int kind = pn < 28 ? 0 : (pn < 32 ? 1 : 2);
      bf16_t* dst; int ld, colt;
      if (kind == 0) { dst = p.QKV; ld = QW; colt = (pn - 16) * 256; }
      else if (kind == 1) { dst = p.SBZ; ld = DM; colt = (pn - 28) * 256; }
      else { dst = pn < 36 ? p.SGA : p.SGB; ld = DM; colt = ((pn - 32) & 3) * 256; }
      const int col0 = colt + wc * 32 + 8 * fq;
#pragma unroll
      for (int ai = 0; ai < 2; ++ai)
#pragma unroll
        for (int m = 0; m < 4; ++m) {
          const int row = row0 + ai * HALF + m * 16;
#pragma unroll
          for (int bj = 0; bj < 2; ++bj) {
            f32x4 v0 = acc[ai][bj][m][0], v1 = acc[ai][bj][m][1];
            if (kind == 1) { for (int j = 0; j < 4; ++j) { v0[j] = siluf(v0[j]); v1[j] = siluf(v1[j]); } }
            if (kind == 2) { for (int j = 0; j < 4; ++j) { v0[j] = sigmf(v0[j]); v1[j] = sigmf(v1[j]); } }
            u32x4 w; w.x = pk2(v0[0], v0[1]); w.y = pk2(v0[2], v0[3]); w.z = pk2(v1[0], v1[1]); w.w = pk2(v1[2], v1[3]);
            *(u32x4*)(dst + (size_t)row * ld + col0 + bj * HALF) = w;
            if (kind == 0 && row < NTP && (row & 63) >= 61)
              *(u32x4*)(p.HALO + ((size_t)(row >> 6) * 3 + ((row & 63) - 61)) * QW + col0 + bj * HALF) = w;
          }
        }
    }
  } else {
    const int col0 = pn * BM + wc * 32 + 8 * fq;
#pragma unroll
    for (int ai = 0; ai < 2; ++ai)
#pragma unroll
      for (int m = 0; m < 4; ++m) {
        const size_t row = row0 + ai * HALF + m * 16;
#pragma unroll
        for (int bj = 0; bj < 2; ++bj) {
          const f32x4 v0 = acc[ai][bj][m][0], v1 = acc[ai][bj][m][1];
          const size_t o = row * DM + col0 + bj * HALF;
          if (EPI == 1) {
            float s[8]; unpack8(*(const u32x4*)(p.SGA + o), s);
            u32x4 w; w.x = pk2(s[0] * v0[0], s[1] * v0[1]); w.y = pk2(s[2] * v0[2], s[3] * v0[3]); w.z = pk2(s[4] * v1[0], s[5] * v1[1]); w.w = pk2(s[6] * v1[2], s[7] * v1[3]);
            *(u32x4*)(p.SGA + o) = w;
          } else if (EPI == 2) {
            float s[8], a[8]; unpack8(*(const u32x4*)(p.SGB + o), s); unpack8(*(const u32x4*)(p.SGA + o), a);
            u32x4 w; w.x = pk2(a[0] + s[0] * v0[0], a[1] + s[1] * v0[1]); w.y = pk2(a[2] + s[2] * v0[2], a[3] + s[3] * v0[3]);
            w.z = pk2(a[4] + s[4] * v1[0], a[5] + s[5] * v1[1]); w.w = pk2(a[6] + s[6] * v1[2], a[7] + s[7] * v1[3]);
            *(u32x4*)(p.UW + o) = w;
          } else {
            const float* xr = row < NTP ? p.x_p + row * DM : p.x_s + (row - NTP) * DM;
            const f32x4 x0 = *(const f32x4*)(xr + col0 + bj * HALF), x1 = *(const f32x4*)(xr + col0 + bj * HALF + 4);
            *(f32x4*)(p.out + o) = x0 + v0; *(f32x4*)(p.out + o + 4) = x1 + v1;
          }
        }
      }
  }
}

#define LAS __attribute__((address_space(3)))
struct Sched {
  int mode, nM, nN, nwg, G, c, start, stride, count;
  DI void init_static(int M, int N, int G_, int c_) { mode = 0; nM = M / BM; nN = N / BM; nwg = nM * nN; G = G_; c = c_; start = stride = count = 0; }
  DI void init_strided(int start_, int stride_, int count_) { mode = 1; start = start_; stride = stride_; count = count_; nM = nN = nwg = G = c = 0; }
  DI bool next(int i, int& pm, int& pn) const {
    if (mode == 0) {
      const long L = (long)i * G + c; if (L >= nwg) return false;
      int wgid = (int)L; { const int q = nwg / NXCD, r = nwg % NXCD, xcd = wgid % NXCD, off = wgid / NXCD; wgid = (xcd < r ? xcd * (q + 1) : r * (q + 1) + (xcd - r) * q) + off; }
      const int nig = WGM * nN, gid = wgid / nig, fm = gid * WGM, gsz = (nM - fm) < WGM ? (nM - fm) : WGM;
      pm = fm + ((wgid % nig) % gsz); pn = (wgid % nig) / gsz; return true;
    }
    const int t = start + i * stride; if (t >= count) return false;
    pm = t >> 2; pn = t & 3; return true;
  }
};

template <int EPI>
DI void gemm_phase(const Params& p, LAS unsigned char* lds, const bf16_t* A, int lda, const bf16_t* Bt, const Sched& S) {
  constexpr int K = 1024, nt = K / BK, HTB = HALF * BK * 2;
  const int tid = launder(threadIdx.x), wid = __builtin_amdgcn_readfirstlane(tid >> 6), lane = tid & 63, wr = wid >> 2, wc = wid & 3, fr = lane & 15, fq = lane >> 4;
  unsigned voffA[2], voffB[2];
#pragma unroll
  for (int i = 0; i < 2; ++i) { int R, C; stage_rc(tid * 16 + i * 8192, R, C); voffA[i] = (unsigned)(R * lda + C) * 2u; voffB[i] = (unsigned)(R * K + C) * 2u; }
  const size_t kstep = (size_t)(BK * 2);
  const size_t hstepA = (size_t)HALF * lda * 2, tstepA = 2 * hstepA, hstepB = (size_t)HALF * K * 2, tstepB = 2 * hstepB;
  const unsigned ldsw = (unsigned)wid * 1024u;
  const int aoff = lds_byte(wr * 64 + fr, fq * 8), boff = lds_byte(wc * 32 + fr, fq * 8);
#define PG8_SA(b, h) (((b) * 2 + (h)) * HTB)
#define PG8_SB(b, h) ((4 + (b) * 2 + (h)) * HTB)
#define PG8_STAGE(bufoff, gbase, voff) do { _Pragma("unroll") for (int _i = 0; _i < 2; ++_i) \
    __builtin_amdgcn_global_load_lds((const unsigned*)((const char*)(gbase) + (voff)[_i]), (LAS unsigned*)(lds + (bufoff) + ldsw + _i * 8192), 16, 0, 0); } while (0)
#define PG8_LDA(dst, b, h) do { _Pragma("unroll") for (int m = 0; m < 4; ++m) _Pragma("unroll") for (int k = 0; k < 2; ++k) dst[m][k] = *(const LAS bf16x8*)(lds + PG8_SA(b, h) + aoff + m * 2048 + k * 1024); } while (0)
#define PG8_LDB(dst, b, h) do { _Pragma("unroll") for (int n = 0; n < 2; ++n) _Pragma("unroll") for (int k = 0; k < 2; ++k) dst[n][k] = *(const LAS bf16x8*)(lds + PG8_SB(b, h) + boff + n * 2048 + k * 1024); } while (0)
#define PG8_MMA(ai, bj, At, Bt_) do { __builtin_amdgcn_s_setprio(1); _Pragma("unroll") for (int m = 0; m < 4; ++m) _Pragma("unroll") for (int n = 0; n < 2; ++n) _Pragma("unroll") for (int k = 0; k < 2; ++k) \
    acc[ai][bj][m][n] = __builtin_amdgcn_mfma_f32_16x16x32_bf16(Bt_[n][k], At[m][k], acc[ai][bj][m][n], 0, 0, 0); __builtin_amdgcn_s_setprio(0); } while (0)
#define PG8_WAIT_V(n) asm volatile("s_waitcnt vmcnt(" #n ")" ::: "memory")
#define PG8_WAIT_L(n) asm volatile("s_waitcnt lgkmcnt(" #n ")" ::: "memory")
#define PG8_BAR __builtin_amdgcn_s_barrier()
#define PG8_SCHED __builtin_amdgcn_sched_barrier(0)
  int cpm, cpn, npm = 0, npn = 0; int ui = 0;
  if (!S.next(0, cpm, cpn)) return;
  f32x4 acc[2][2][4][2];
#pragma unroll
  for (int a = 0; a < 2; ++a)
#pragma unroll
    for (int b = 0; b < 2; ++b)
#pragma unroll
      for (int m = 0; m < 4; ++m)
#pragma unroll
        for (int n = 0; n < 2; ++n) acc[a][b][m][n] = (f32x4){0.f, 0.f, 0.f, 0.f};
  bf16x8 At[4][2], B0[2][2], B1[2][2];
  const char* cA = (const char*)A + (size_t)cpm * tstepA; const char* cB = (const char*)Bt + (size_t)cpn * tstepB;
  PG8_STAGE(PG8_SB(0, 0), cB, voffB); PG8_STAGE(PG8_SB(0, 1), cB + hstepB, voffB); PG8_STAGE(PG8_SA(0, 0), cA, voffA); PG8_STAGE(PG8_SA(0, 1), cA + hstepA, voffA);
  if (wr == 1) PG8_BAR;
  PG8_WAIT_V(2); PG8_BAR;
  PG8_STAGE(PG8_SB(1, 0), cB + kstep, voffB); PG8_STAGE(PG8_SA(1, 0), cA + kstep, voffA); PG8_STAGE(PG8_SB(1, 1), cB + hstepB + kstep, voffB);
  PG8_WAIT_V(6); PG8_BAR;
  for (;;) {
    const bool has_next = S.next(ui + 1, npm, npn);
    const char* nA = has_next ? (const char*)A + (size_t)npm * tstepA : cA; const char* nB = has_next ? (const char*)Bt + (size_t)npn * tstepB : cB;
#pragma unroll 1
    for (int t = 0; t < nt; t += 2) {
      const bool last = (t == nt - 2);
      const char* a1 = cA + (size_t)(t + 1) * kstep;
      const char* a2 = last ? nA : cA + (size_t)(t + 2) * kstep; const char* b2 = last ? nB : cB + (size_t)(t + 2) * kstep;
      const char* a3 = a2 + kstep; const char* b3 = b2 + kstep;
      PG8_LDB(B0, 0, 0); PG8_LDB(B1, 0, 1); PG8_SCHED; PG8_LDA(At, 0, 0); PG8_STAGE(PG8_SA(1, 1), a1 + hstepA, voffA);
      PG8_WAIT_V(8); PG8_WAIT_L(0); PG8_BAR; PG8_MMA(0, 0, At, B0); PG8_MMA(0, 1, At, B1); PG8_BAR; PG8_SCHED;
      PG8_LDA(At, 0, 1); PG8_STAGE(PG8_SB(0, 0), b2, voffB); PG8_STAGE(PG8_SB(0, 1), b2 + hstepB, voffB); PG8_STAGE(PG8_SA(0, 0), a2, voffA);
      PG8_WAIT_V(8); PG8_WAIT_L(0); PG8_BAR; PG8_MMA(1, 0, At, B0); PG8_MMA(1, 1, At, B1); PG8_BAR; PG8_SCHED;
      PG8_LDB(B0, 1, 0); PG8_LDB(B1, 1, 1); PG8_SCHED; PG8_LDA(At, 1, 0); PG8_STAGE(PG8_SA(0, 1), a2 + hstepA, voffA);
      PG8_WAIT_V(8); PG8_WAIT_L(0); PG8_BAR; PG8_MMA(0, 0, At, B0); PG8_MMA(0, 1, At, B1); PG8_BAR; PG8_SCHED;
      PG8_LDA(At, 1, 1); PG8_STAGE(PG8_SB(1, 0), b3, voffB); PG8_STAGE(PG8_SB(1, 1), b3 + hstepB, voffB); PG8_STAGE(PG8_SA(1, 0), a3, voffA);
      PG8_WAIT_V(8); PG8_WAIT_L(0); PG8_BAR; PG8_MMA(1, 0, At, B0); PG8_MMA(1, 1, At, B1); PG8_BAR; PG8_SCHED;
    }
    if (wr == 0) PG8_BAR;
    if (!(EPI == 4 && gridDim.x == 256)) epilogue<EPI == 4 ? 3 : EPI>(p, acc, cpm, cpn, wr, wc, fr, fq);
    if (!has_next) break;
#pragma unroll
    for (int a = 0; a < 2; ++a)
#pragma unroll
      for (int b = 0; b < 2; ++b)
#pragma unroll
        for (int m = 0; m < 4; ++m)
#pragma unroll
          for (int n = 0; n < 2; ++n) acc[a][b][m][n] = (f32x4){0.f, 0.f, 0.f, 0.f};
    cpm = npm; cpn = npn; cA = nA; cB = nB; ++ui;
    if (wr == 1) PG8_BAR;
  }
  PG8_WAIT_V(0);
  PG8_BAR;
  if (EPI == 4 && gridDim.x == 256) epilogue_final(p, acc, cpm, cpn, wr, wc, fr, fq, (unsigned char*)lds, tid);
#undef PG8_SA
#undef PG8_SB
#undef PG8_STAGE
#undef PG8_LDA
#undef PG8_LDB
#undef PG8_MMA
}

template <int EPI>
DI void gemm_tail(const Params& p, const bf16_t* A, int lda, const bf16_t* Bt, int tile0, int ntiles) {
  const int tid = launder(threadIdx.x), wid = tid >> 6, lane = tid & 63, fr = lane & 15, fq = lane >> 4;
  for (int q = blockIdx.x; q < ntiles * 32; q += gridDim.x) {
    const int t = tile0 + (q >> 5), sub = q & 31, pm = t >> 2, pn = t & 3;
    const int row0 = pm * 256 + (sub >> 3) * 64 + (wid >> 1) * 16, R0 = pn * 256 + (sub & 7) * 32 + (wid & 1) * 16;
    const bf16_t* ap = A + (size_t)(row0 + fr) * lda + fq * 8; const bf16_t* bp = Bt + (size_t)(R0 + fr) * DM + fq * 8;
    f32x4 acc = {0.f, 0.f, 0.f, 0.f};
#pragma unroll 16
    for (int ks = 0; ks < 32; ++ks) { const bf16x8 a = *(const bf16x8*)(ap + ks * 32), b = *(const bf16x8*)(bp + ks * 32); acc = __builtin_amdgcn_mfma_f32_16x16x32_bf16(b, a, acc, 0, 0, 0); }
    const size_t row = row0 + fr; const int col0 = (R0 & ~31) + 8 * fq + 4 * ((R0 >> 4) & 1);
    const size_t o = row * DM + col0;
    if (EPI == 2) {
      const u32x2 sw = *(const u32x2*)(p.SGB + o), aw = *(const u32x2*)(p.SGA + o);
      u32x2 w; w.x = pk2(bflo(aw.x) + bflo(sw.x) * acc[0], bfhi(aw.x) + bfhi(sw.x) * acc[1]); w.y = pk2(bflo(aw.y) + bflo(sw.y) * acc[2], bfhi(aw.y) + bfhi(sw.y) * acc[3]);
      *(u32x2*)(p.UW + o) = w;
    } else {
      const float* xr = row < NTP ? p.x_p + row * DM : p.x_s + (row - NTP) * DM;
      *(f32x4*)(p.out + o) = *(const f32x4*)(xr + col0) + acc;
    }
  }
}

DI void wtile_desc(const Params& p, int tile, const float*& src, bf16_t*& dst, int& N, int& kt, int& R0, int& kind) {
  if (tile < 2560) { src = p.w_in; dst = p.WIN; N = NIN; kt = tile & 15; R0 = (tile >> 4) * 64; kind = 0; }
  else { const int t2 = tile - 2560, mat = t2 >> 8; src = mat == 0 ? p.w_oa : (mat == 1 ? p.w_ob : p.w_o); dst = mat == 0 ? p.WOA : (mat == 1 ? p.WOB : p.WO); N = DM; kt = t2 & 15; R0 = ((t2 & 255) >> 4) * 64; kind = 1; }
}
DI void convert_tiles(const Params& p, int first, int end, int stride) {
  extern __shared__ __attribute__((aligned(16))) unsigned char smem[];
  float* lds = (float*)smem;
  const int tid = launder(threadIdx.x);
#pragma unroll 1
  for (int t0 = first; t0 < end; t0 += 4 * stride) {
    f32x4 v[4][2];
#pragma unroll
    for (int q = 0; q < 4; ++q) {
      const int tile = t0 + q * stride;
      if (tile < end) {
        const float* src; bf16_t* dst; int N, kt, R0, kind; wtile_desc(p, tile, src, dst, N, kt, R0, kind);
        const int r4 = tid & 15, R = R0 + r4 * 4, c = kind == 0 ? colmap_in(R) : colmap_sq(R);
#pragma unroll
        for (int ps = 0; ps < 2; ++ps) v[q][ps] = ldnt4(src + (size_t)(kt * 64 + ps * 32 + (tid >> 4)) * N + c);
      }
    }
#pragma unroll
    for (int q = 0; q < 4; ++q) {
      if (t0 + q * stride < end) {
#pragma unroll
        for (int ps = 0; ps < 2; ++ps) { float* d = lds + q * (64 * 65) + (ps * 32 + (tid >> 4)) * 65 + (tid & 15) * 4; d[0] = v[q][ps].x; d[1] = v[q][ps].y; d[2] = v[q][ps].z; d[3] = v[q][ps].w; }
      }
    }
    lds_barrier();
#pragma unroll
    for (int q = 0; q < 4; ++q) {
      const int tile = t0 + q * stride;
      if (tile < end) {
        const float* src; bf16_t* dst; int N, kt, R0, kind; wtile_desc(p, tile, src, dst, N, kt, R0, kind);
        const int R = tid >> 3, kg = tid & 7; float f[8];
#pragma unroll
        for (int i = 0; i < 8; ++i) f[i] = lds[q * (64 * 65) + (kg * 8 + i) * 65 + R];
        *(u32x4*)(dst + (size_t)(R0 + R) * DM + kt * 64 + kg * 8) = pack8(f);
      }
    }
    lds_barrier();
  }
}

__device__ void phase0(const Params& p) {
  extern __shared__ __attribute__((aligned(16))) unsigned char smem[];
  float* lds = (float*)smem;
  const int tid = threadIdx.x, wid = tid >> 6, lane = tid & 63, G = gridDim.x;
  {
    f32x4 w[4];
#pragma unroll
    for (int i = 0; i < 4; ++i) w[i] = *(const f32x4*)(p.nw + i * 256 + lane * 4);
#pragma unroll 1
    for (int row = (blockIdx.x * 8 + wid) * 4; row < NT; row += G * 8 * 4) {
      f32x4 v[4][4];
#pragma unroll
      for (int q = 0; q < 4; ++q) { const int r = row + q; const float* xr = r < NTP ? p.x_p + (size_t)r * DM : p.x_s + (size_t)(r - NTP) * DM;
#pragma unroll
        for (int i = 0; i < 4; ++i) v[q][i] = ldnt4(xr + i * 256 + lane * 4); }
#pragma unroll
      for (int q = 0; q < 4; ++q) {
        float ss = 0.f;
#pragma unroll
        for (int i = 0; i < 4; ++i) ss += (v[q][i].x * v[q][i].x + v[q][i].y * v[q][i].y) + (v[q][i].z * v[q][i].z + v[q][i].w * v[q][i].w);
        ss = wave_sum(ss);
        const float rstd = rsqrtf(ss * (1.f / DM) + EPS);
#pragma unroll
        for (int i = 0; i < 4; ++i) { u32x2 o; o.x = pk2(v[q][i].x * rstd * w[i].x, v[q][i].y * rstd * w[i].y); o.y = pk2(v[q][i].z * rstd * w[i].z, v[q][i].w * rstd * w[i].w);
          *(u32x2*)(p.UW + (size_t)(row + q) * DM + i * 256 + lane * 4) = o; }
      }
    }
  }
  convert_tiles(p, blockIdx.x, 2560, G);
  for (int idx = blockIdx.x * 512 + tid; idx < 16 * DM; idx += G * 512) { const int c = idx >> 10, k = idx & 1023; p.WB16[idx] = (bf16_t)(pk2(p.w_in[(size_t)k * NIN + 8192 + c], 0.f) & 0xffffu); }
}

__device__ void phase1(const Params& p) {
  const int G = gridDim.x;
  { extern __shared__ __attribute__((aligned(16))) unsigned char smem[];
    Sched S; S.init_static(NT, 10240, G, blockIdx.x); gemm_phase<0>(p, (LAS unsigned char*)smem, p.UW, DM, p.WIN, S); }
  const int nfull = G == 256 ? 80 : 0, nside = G - nfull, sidx = (int)blockIdx.x - nfull;
  if (sidx >= 0) convert_tiles(p, 2560 + sidx, 2560 + 768, nside);
  const int tid = launder(threadIdx.x), wid = tid >> 6, lane = tid & 63, fr = lane & 15, fq = lane >> 4;
  if (sidx >= 0)
  for (int task = sidx * 8 + wid; task < NT / 16; task += nside * 8) {
    const int base = task * 16; f32x4 acc = {0.f, 0.f, 0.f, 0.f};
    const bf16_t* ap = p.UW + (size_t)(base + fr) * DM + fq * 8; const bf16_t* bp = p.WB16 + fr * DM + fq * 8;
#pragma unroll 8
    for (int ks = 0; ks < 32; ++ks) { const bf16x8 a = *(const bf16x8*)(ap + ks * 32), b = *(const bf16x8*)(bp + ks * 32); acc = __builtin_amdgcn_mfma_f32_16x16x32_bf16(a, b, acc, 0, 0, 0); }
    const int c = fr, h = c & 7; const float na = -__expf(p.a_log[h]), db = p.dt_bias[h];
#pragma unroll
    for (int j = 0; j < 4; ++j) {
      const int tok = base + fq * 4 + j; const float v = acc[j]; float r;
      if (c < 8) r = sigmf(v); else { const float xx = v + db; r = na * (xx > 20.f ? xx : log1pf(__expf(xx))); }
      p.BG[(size_t)tok * 16 + c] = r;
    }
  }
}

DI u32x4 raw_unit_load(const Params& p, int cgi, int h, int u) {
  const int r = u / 48, rem = u % 48, part = rem >> 4, c8 = rem & 15;
  u32x4 v = {0u, 0u, 0u, 0u};
  if (r < 3) { if ((cgi & 31) > 0) v = *(const u32x4*)(p.HALO + ((size_t)(cgi - 1) * 3 + r) * QW + part * 1024 + h * 128 + c8 * 8); }
  else v = *(const u32x4*)(p.QKV + (size_t)(cgi * 64 + r - 3) * QW + part * 1024 + h * 128 + c8 * 8);
  return v;
}
DI int crow(int r, int lh) { return (r & 3) + 8 * (r >> 2) + 4 * lh; }
DI bf16x8 packfrag(const f32x16& x, int s) {
  u32x4 w; w.x = pk2(x[8 * s], x[8 * s + 1]); w.y = pk2(x[8 * s + 2], x[8 * s + 3]); w.z = pk2(x[8 * s + 4], x[8 * s + 5]); w.w = pk2(x[8 * s + 6], x[8 * s + 7]);
  return __builtin_bit_cast(bf16x8, w);
}
DI bf16x8 ld_permk(const bf16_t* rowp, int s, int lh) {
  const u32x2 a = *(const u32x2*)(rowp + 16 * s + 4 * lh), b = *(const u32x2*)(rowp + 16 * s + 8 + 4 * lh);
  u32x4 w; w.x = a.x; w.y = a.y; w.z = b.x; w.w = b.y; return __builtin_bit_cast(bf16x8, w);
}

DI void conv_unit(const Params& p, int part, int c8, int row, const bf16_t* raw, const float* cw, bf16_t* qh, bf16_t* kh, bf16_t* vh, const float* gcs, int T0, int h) {
    f32x2 w2[4][4];
#pragma unroll
    for (int j = 0; j < 4; ++j) { const f32x4 wa = *(const f32x4*)(cw + (part * 4 + j) * 128 + c8 * 8), wb = *(const f32x4*)(cw + (part * 4 + j) * 128 + c8 * 8 + 4);
      w2[j][0] = (f32x2){wa.x, wa.y}; w2[j][1] = (f32x2){wa.z, wa.w}; w2[j][2] = (f32x2){wb.x, wb.y}; w2[j][3] = (f32x2){wb.z, wb.w}; }
    f32x2 a2[2][4];
#pragma unroll
    for (int k = 0; k < 4; ++k) { a2[0][k] = (f32x2){0.f, 0.f}; a2[1][k] = (f32x2){0.f, 0.f}; }
#pragma unroll
    for (int rr = 0; rr < 5; ++rr) {
      const u32x4 xw = *(const u32x4*)(raw + (row + rr) * 392 + part * 128 + c8 * 8);
      f32x2 x2[4]; x2[0] = (f32x2){bflo(xw.x), bfhi(xw.x)}; x2[1] = (f32x2){bflo(xw.y), bfhi(xw.y)}; x2[2] = (f32x2){bflo(xw.z), bfhi(xw.z)}; x2[3] = (f32x2){bflo(xw.w), bfhi(xw.w)};
#pragma unroll
      for (int q = 0; q < 2; ++q) { const int j = rr - q; if (j >= 0 && j < 4) {
#pragma unroll
        for (int k = 0; k < 4; ++k) a2[q][k] = x2[k] * w2[j][k] + a2[q][k]; } }
    }
#pragma unroll
    for (int q = 0; q < 2; ++q) {
      f32x2 s2 = {0.f, 0.f};
#pragma unroll
      for (int k = 0; k < 4; ++k) {
        const f32x2 t = a2[q][k] * (-1.4426950408889634f);
        f32x2 d; d.x = __builtin_amdgcn_exp2f(t.x); d.y = __builtin_amdgcn_exp2f(t.y); d = d + 1.0f;
        f32x2 r; r.x = __builtin_amdgcn_rcpf(d.x); r.y = __builtin_amdgcn_rcpf(d.y);
        a2[q][k] = a2[q][k] * r; s2 = a2[q][k] * a2[q][k] + s2;
      }
      float ss = s2.x + s2.y;
      ss += __shfl_xor(ss, 1); ss += __shfl_xor(ss, 2); ss += __shfl_xor(ss, 4); ss += __shfl_xor(ss, 8);
      if (part < 2) { const float sc = rsqrtf(ss + EPS) * (part == 0 ? 0.08838834764831845f : 1.f);
#pragma unroll
        for (int k = 0; k < 4; ++k) a2[q][k] = a2[q][k] * sc; }
      bf16_t* dstl = part == 0 ? qh : (part == 1 ? kh : vh);
      { u32x4 o; o.x = pk2(a2[q][0].x, a2[q][0].y); o.y = pk2(a2[q][1].x, a2[q][1].y); o.z = pk2(a2[q][2].x, a2[q][2].y); o.w = pk2(a2[q][3].x, a2[q][3].y);
        *(u32x4*)(dstl + (row + q) * 136 + c8 * 8) = o; }
      if (part == 0) { const float eg = __expf(gcs[row + q]);
#pragma unroll
        for (int k = 0; k < 4; ++k) a2[q][k] = a2[q][k] * eg;
        u32x4 o; o.x = pk2(a2[q][0].x, a2[q][0].y); o.y = pk2(a2[q][1].x, a2[q][1].y); o.z = pk2(a2[q][2].x, a2[q][2].y); o.w = pk2(a2[q][3].x, a2[q][3].y);
        *(u32x4*)(p.QKV + (size_t)(T0 + row + q) * QW + h * 128 + c8 * 8) = o; }
    }
  }

DI void chunk_task(const Params& p, int cgi, int h, u32x4 (&pre)[7], float& pg, float& pb, int next_cgi, int next_h, bool has_next) {
  extern __shared__ __attribute__((aligned(16))) unsigned char smem[];
  bf16_t* raw = (bf16_t*)smem;
  bf16_t* qh = (bf16_t*)(smem + 52736);
  bf16_t* kh = (bf16_t*)(smem + 70144);
  bf16_t* vh = (bf16_t*)(smem + 87552);
  float* Mm = (float*)(smem + 104960);
  bf16_t* M10n = (bf16_t*)(smem + 121344);
  bf16_t* Tb = (bf16_t*)(smem + 123904);
  float* gcs = (float*)(smem + 129024);
  float* bet = (float*)(smem + 129280);
  float* rsk = (float*)(smem + 129536);
  const float* cw = (const float*)(smem + 129792);
  const int tid = launder(threadIdx.x), wid = tid >> 6, lane = tid & 63;
  const int n = cgi & 31, b = cgi >> 5, T0 = cgi * 64, ci = cgi * 8 + h;
#pragma unroll
  for (int k = 0; k < 7; ++k) { const int u = k * 512 + tid; if (u < 67 * 48) { const int r = u / 48, rem = u % 48; *(u32x4*)(raw + r * 392 + (rem >> 4) * 128 + (rem & 15) * 8) = pre[k]; } }
  if (has_next) {
#pragma unroll
    for (int k = 0; k < 7; ++k) { const int u = k * 512 + tid; if (u < 67 * 48) pre[k] = raw_unit_load(p, next_cgi, next_h, u); }
  }
  if (wid == 0) {
    float g = pg; const float be = pb;
    if (has_next) { pg = p.BG[(size_t)(next_cgi * 64 + lane) * 16 + 8 + next_h]; pb = p.BG[(size_t)(next_cgi * 64 + lane) * 16 + next_h]; }
#pragma unroll
    for (int o = 1; o < 64; o <<= 1) { const float t = __shfl_up(g, o); if (lane >= o) g += t; }
    gcs[lane] = g; bet[lane] = be; rsk[lane] = be * __expf(g);
  }
  lds_barrier();
  const float glast = gcs[63];
#pragma unroll 1
  for (int part = 0; part < 2; ++part) conv_unit(p, part, tid & 15, (tid >> 4) * 2, raw, cw, qh, kh, vh, gcs, T0, h);
  if (n == 31) {
    for (int u = tid; u < 3 * 384; u += 512) { const int j = u / 384, cc = u % 384, part = cc >> 7, col = cc & 127;
      p.out[OFF_NCQ_P + ((size_t)b * 3 + j) * QW + part * 1024 + h * 128 + col] = bf2f(raw[(64 + j) * 392 + cc]); }
  }
  lds_barrier();
#define KQ_BLOCK(bidx, isq) do { \
      const int ib = (bidx) >= 6 ? 3 : ((bidx) >= 3 ? 2 : ((bidx) >= 1 ? 1 : 0)), jb = (bidx) - (ib * (ib + 1)) / 2; \
      const bf16_t* Y = (isq) ? qh : kh; \
      const int i = ib * 16 + fr; const float gi = gcs[i], bi = bet[i]; \
      f32x4 d = {0.f, 0.f, 0.f, 0.f}; \
      _Pragma("unroll") for (int ks = 0; ks < 4; ++ks) { \
        const bf16x8 xa = *(const bf16x8*)(kh + (jb * 16 + fr) * 136 + ks * 32 + fq * 8), yb = *(const bf16x8*)(Y + (ib * 16 + fr) * 136 + ks * 32 + fq * 8); \
        d = __builtin_amdgcn_mfma_f32_16x16x32_bf16(xa, yb, d, 0, 0, 0); } \
      const int j0 = jb * 16 + fq * 4; float r[4]; \
      _Pragma("unroll") for (int jj = 0; jj < 4; ++jj) { const int j = j0 + jj; const bool keep = (isq) ? (i >= j) : (i > j); r[jj] = keep ? d[jj] * __expf(gi - gcs[j]) * ((isq) ? 1.f : bi) : 0.f; } \
      if (isq) { u32x2 w; w.x = pk2(r[0], r[1]); w.y = pk2(r[2], r[3]); *(u32x2*)(p.AQK + (size_t)ci * 4096 + i * 64 + j0) = w; } \
      else { \
        *(f32x4*)(Mm + i * 64 + j0) = (f32x4){r[0], r[1], r[2], r[3]}; \
        if (ib >= 2 && jb < 2) { u32x2 w; w.x = pk2(-r[0], -r[1]); w.y = pk2(-r[2], -r[3]); *(u32x2*)(M10n + (i - 32) * 40 + j0) = w; } \
      } } while (0)
  {
    const int fr = lane & 15, fq = lane >> 4;
#pragma unroll 1
    for (int bidx = wid; bidx < 10; bidx += 8) KQ_BLOCK(bidx, false);
  }
  lds_barrier();
  if (wid == 0) {
    const int blk = lane >> 5, c = lane & 31; const float* Mb = Mm + (blk * 32) * 64 + blk * 32;
    float X[32];
    f32x4 mb[2][8];
#pragma unroll
    for (int r = 0; r < 32; ++r) {
      if (r + 1 < 32) {
#pragma unroll
        for (int j4 = 0; j4 < (r + 4) / 4; ++j4) mb[(r + 1) & 1][j4] = *(const f32x4*)(Mb + (r + 1) * 64 + j4 * 4);
      }
      float s0 = (r == c) ? 1.f : 0.f, s1 = 0.f;
#pragma unroll
      for (int j4 = 0; j4 < (r + 3) / 4; ++j4) {
        const f32x4 m = mb[r & 1][j4];
        if (j4 * 4 + 0 < r) s0 -= m.x * X[j4 * 4 + 0];
        if (j4 * 4 + 1 < r) s1 -= m.y * X[j4 * 4 + 1];
        if (j4 * 4 + 2 < r) s0 -= m.z * X[j4 * 4 + 2];
        if (j4 * 4 + 3 < r) s1 -= m.w * X[j4 * 4 + 3];
      }
      X[r] = s0 + s1;
    }
#pragma unroll
    for (int r = 0; r < 32; ++r) Tb[(blk * 32 + r) * 40 + c] = (bf16_t)(pk2(X[r], 0.f) & 0xffffu);
  } else {
    {
      const int fr = lane & 15, fq = lane >> 4;
#pragma unroll 1
      for (int bidx = wid - 1; bidx < 10; bidx += 7) KQ_BLOCK(bidx, true);
      for (int u = wid - 1; u < 6; u += 7) { const int ib = u < 3 ? 0 : (u < 5 ? 1 : 2), jb = u < 3 ? u + 1 : (u < 5 ? u - 1 : 3);
        *(u32x2*)(p.AQK + (size_t)ci * 4096 + (ib * 16 + fr) * 64 + jb * 16 + fq * 4) = (u32x2){0u, 0u}; }
    }
    for (int u = tid - 64; u < 512; u += 448) conv_unit(p, 2, u & 15, (u >> 4) * 2, raw, cw, qh, kh, vh, gcs, T0, h);
    for (int u = tid - 64; u < 1024; u += 448) {
      const int i8 = u & 7, d = u >> 3; float f[8];
#pragma unroll
      for (int e = 0; e < 8; ++e) { const int i = i8 * 8 + e; f[e] = bf2f(kh[i * 136 + d]) * __expf(glast - gcs[i]); }
      *(u32x4*)(p.QKV + (size_t)(T0 + (d >> 1)) * QW + 1024 + h * 128 + (d & 1) * 64 + i8 * 8) = pack8(f);
    }
    if (tid == 64) p.DL[ci] = __expf(glast);
  }
  lds_barrier();
  {
    const int l32 = lane & 31, lh = lane >> 5; const bool isV = wid >= 4;
    const bf16_t* srcl = (isV ? vh : kh) + (wid & 3) * 32 + l32; const float* rs = isV ? bet : rsk;
    bf16x8 r0[2];
#pragma unroll
    for (int s = 0; s < 2; ++s) { float f[8];
#pragma unroll
      for (int e = 0; e < 8; ++e) { const int k = 16 * s + 8 * lh + e; f[e] = bf2f(srcl[k * 136]) * rs[k]; }
      r0[s] = __builtin_bit_cast(bf16x8, pack8(f)); }
    f32x16 x0 = {};
#pragma unroll
    for (int s = 0; s < 2; ++s) x0 = __builtin_amdgcn_mfma_f32_32x32x16_bf16(*(const bf16x8*)(Tb + l32 * 40 + 16 * s + 8 * lh), r0[s], x0, 0, 0, 0);
    f32x16 y1;
#pragma unroll
    for (int r = 0; r < 16; ++r) { const int k = 32 + crow(r, lh); y1[r] = bf2f(srcl[k * 136]) * rs[k]; }
#pragma unroll
    for (int s = 0; s < 2; ++s) y1 = __builtin_amdgcn_mfma_f32_32x32x16_bf16(ld_permk(M10n + l32 * 40, s, lh), packfrag(x0, s), y1, 0, 0, 0);
    f32x16 x1 = {};
#pragma unroll
    for (int s = 0; s < 2; ++s) x1 = __builtin_amdgcn_mfma_f32_32x32x16_bf16(ld_permk(Tb + (32 + l32) * 40, s, lh), packfrag(y1, s), x1, 0, 0, 0);
    const int col = (wid & 3) * 32 + l32;
    if (!isV) {
      bf16_t* wp = p.UW + (size_t)ci * 8192 + col;
#pragma unroll
      for (int r = 0; r < 16; ++r) { const int i = crow(r, lh); wp[i * 128] = (bf16_t)(pk2(-x0[r], 0.f) & 0xffffu); wp[(32 + i) * 128] = (bf16_t)(pk2(-x1[r], 0.f) & 0xffffu); }
    } else {
      bf16_t* up = p.QKV + (size_t)(T0 + (col >> 1)) * QW + 2048 + h * 128 + (col & 1) * 64;
#pragma unroll
      for (int q = 0; q < 4; ++q) {
        u32x2 w0, w1; w0.x = pk2(x0[q * 4], x0[q * 4 + 1]); w0.y = pk2(x0[q * 4 + 2], x0[q * 4 + 3]); w1.x = pk2(x1[q * 4], x1[q * 4 + 1]); w1.y = pk2(x1[q * 4 + 2], x1[q * 4 + 3]);
        *(u32x2*)(up + q * 8 + lh * 4) = w0; *(u32x2*)(up + 32 + q * 8 + lh * 4) = w1;
      }
    }
  }
  lds_barrier();
}

__device__ void phase2(const Params& p) {
  const int G = gridDim.x;
  const int tid = launder(threadIdx.x);
  {
    const int c8 = (tid & 127) * 8;
    float w0[8], w1[8], w2[8];
#pragma unroll
    for (int e = 0; e < 8; ++e) { w0[e] = p.caw[c8 + e]; w1[e] = p.caw[DM + c8 + e]; w2[e] = p.caw[2 * DM + c8 + e]; }
#pragma unroll 1
    for (int grp = blockIdx.x * 4 + (tid >> 7); grp < NT / 8; grp += G * 4) {
      const int r0 = grp * 8;
      u32x4 pw[10], gw[8];
#pragma unroll
      for (int k = 0; k < 10; ++k) { const int r = r0 - 2 + k; pw[k] = (u32x4){0u, 0u, 0u, 0u}; if (r >= 0) pw[k] = *(const u32x4*)(p.P + (size_t)r * DM + c8); }
#pragma unroll
      for (int k = 0; k < 8; ++k) gw[k] = *(const u32x4*)(p.GATE + (size_t)(r0 + k) * DM + c8);
#pragma unroll
      for (int k = 0; k < 8; ++k) {
        const int r = r0 + k;
        float cur[8], p1[8], p2[8], g[8];
        unpack8(pw[k + 2], cur); unpack8(pw[k + 1], p1); unpack8(pw[k], p2); unpack8(gw[k], g);
        if (r < NTP) {
          const int t = r & 2047;
          if (t < 1) { for (int e = 0; e < 8; ++e) p1[e] = 0.f; }
          if (t < 2) { for (int e = 0; e < 8; ++e) p2[e] = 0.f; }
          if (t >= 2046) { float* o = p.out + OFF_NCA_P + ((size_t)(r >> 11) * 2 + (t - 2046)) * DM + c8; *(f32x4*)o = (f32x4){cur[0], cur[1], cur[2], cur[3]}; *(f32x4*)(o + 4) = (f32x4){cur[4], cur[5], cur[6], cur[7]}; }
        } else {
          const int bs = (r - NTP) >> 2, t = (r - NTP) & 3;
          const float* past = p.sca + (size_t)bs * 2 * DM + c8;
          if (t < 1) { for (int e = 0; e < 8; ++e) p1[e] = past[DM + e]; }
          if (t < 2) { for (int e = 0; e < 8; ++e) p2[e] = past[(t == 1 ? DM : 0) + e]; }
          if (t >= 2) { float* o = p.out + OFF_NCA_S + ((size_t)bs * 2 + (t - 2)) * DM + c8; *(f32x4*)o = (f32x4){cur[0], cur[1], cur[2], cur[3]}; *(f32x4*)(o + 4) = (f32x4){cur[4], cur[5], cur[6], cur[7]}; }
        }
        float o8[8];
#pragma unroll
        for (int e = 0; e < 8; ++e) o8[e] = g[e] * (w0[e] * p2[e] + w1[e] * p1[e] + w2[e] * cur[e]);
        *(u32x4*)(p.GATE + (size_t)r * DM + c8) = pack8(o8);
      }
    }
  }
  {
    extern __shared__ __attribute__((aligned(16))) unsigned char smem[];
    float* cw = (float*)(smem + 129792);
    const int tid0 = launder(threadIdx.x);
    int cur_h = -1; u32x4 pre[7];
    int task = blockIdx.x;
#pragma unroll
    for (int k = 0; k < 7; ++k) { const int u = k * 512 + tid0; pre[k] = (u32x4){0u, 0u, 0u, 0u}; if (task < 2048 && u < 67 * 48) pre[k] = raw_unit_load(p, task >> 3, task & 7, u); }
    float pg = 0.f, pb = 0.f;
    if (task < 2048 && tid0 < 64) { pg = p.BG[(size_t)((task >> 3) * 64 + tid0) * 16 + 8 + (task & 7)]; pb = p.BG[(size_t)((task >> 3) * 64 + tid0) * 16 + (task & 7)]; }
    for (; task < 2048; task += G) {
      const int h = task & 7;
      if (h != cur_h) {
        lds_barrier();
        for (int u = tid0; u < 3 * 4 * 128; u += 512) { const int part = u / 512, j = (u >> 7) & 3, col = u & 127; cw[u] = p.cbw[(size_t)j * QW + part * 1024 + h * 128 + col]; }
        cur_h = h;
      }
      const int nt = task + G;
      chunk_task(p, task >> 3, h, pre, pg, pb, nt >> 3, nt & 7, nt < 2048);
    }
  }
}

DI void cvt16(f32x16& a, int q, u32x2 w) { a[q * 4 + 0] = bflo(w.x); a[q * 4 + 1] = bfhi(w.x); a[q * 4 + 2] = bflo(w.y); a[q * 4 + 3] = bfhi(w.y); }
__device__ __forceinline__ void scan_seq(const Params& p, int seq) {
  extern __shared__ __attribute__((aligned(16))) unsigned char smem[];
  bf16_t* A1 = (bf16_t*)smem;
  bf16_t* AQ = (bf16_t*)(smem + 34816);
  bf16_t* KT = (bf16_t*)(smem + 44032);
  bf16_t* ST = (bf16_t*)(smem + 62464);
  bf16_t* UT = (bf16_t*)(smem + 97280);
  float* OS = (float*)(smem + 115712);
  const int tid = launder(threadIdx.x), wid = tid >> 6, lane = tid & 63, vb = wid & 3, hw = wid >> 2, l32 = lane & 31, lh = lane >> 5;
  const int b = seq >> 3, h = seq & 7;
  f32x16 S0 = {}, S1 = {};
  for (int i = tid; i < 128 * 136 / 8; i += 512) ((u32x4*)ST)[i] = (u32x4){0u, 0u, 0u, 0u};
  const int v = vb * 32 + l32;
  u32x4 pA[4], pQ, pK[2]; u32x2 pU[8]; float pdl;
  float onw16[16];
  { const int seg = tid & 7;
#pragma unroll
    for (int e = 0; e < 16; ++e) onw16[e] = p.onw[seg * 16 + e]; }
#define SCAN_SRC_A(nn, it) ({ const int ci_ = (b * 32 + (nn)) * 8 + h, T0_ = (b * 32 + (nn)) * 64; const int u_ = (it) * 512 + tid, r_ = u_ >> 4, c_ = (u_ & 15) * 8; \
    (const u32x4*)(r_ < 64 ? p.UW + ((size_t)ci_ * 64 + r_) * 128 + c_ : p.QKV + (size_t)(T0_ + r_ - 64) * QW + h * 128 + c_); })
#define SCAN_LOAD_A(nn) do { _Pragma("unroll") for (int it = 0; it < 4; ++it) pA[it] = *SCAN_SRC_A(nn, it); } while (0)
#define SCAN_LOAD_QK(nn) do { const int ci_ = (b * 32 + (nn)) * 8 + h, T0_ = (b * 32 + (nn)) * 64; \
    { const int r = tid >> 3, c = (tid & 7) * 8; pQ = *(const u32x4*)(p.AQK + (size_t)ci_ * 4096 + r * 64 + c); } \
    _Pragma("unroll") for (int it = 0; it < 2; ++it) { const int u = it * 512 + tid, d = u >> 3, c = (u & 7) * 8; \
      pK[it] = *(const u32x4*)(p.QKV + (size_t)(T0_ + (d >> 1)) * QW + 1024 + h * 128 + (d & 1) * 64 + c); } } while (0)
#define SCAN_LOAD_U(nn) do { const int ci_ = (b * 32 + (nn)) * 8 + h, T0_ = (b * 32 + (nn)) * 64; \
    if (hw == 0) { const bf16_t* base_ = p.QKV + (size_t)(T0_ + (v >> 1)) * QW + 2048 + h * 128 + (v & 1) * 64; \
      _Pragma("unroll") for (int q = 0; q < 4; ++q) { pU[q] = *(const u32x2*)(base_ + q * 8 + lh * 4); pU[4 + q] = *(const u32x2*)(base_ + 32 + q * 8 + lh * 4); } } \
    pdl = p.DL[ci_]; } while (0)
#define SCAN_FILL_A() do { _Pragma("unroll") for (int it = 0; it < 4; ++it) { const int u = it * 512 + tid, r = u >> 4, c = (u & 15) * 8; *(u32x4*)(A1 + r * 136 + c) = pA[it]; } } while (0)
#define SCAN_FILL_QK() do { { const int r = tid >> 3, c = (tid & 7) * 8; *(u32x4*)(AQ + r * 72 + c) = pQ; } \
    _Pragma("unroll") for (int it = 0; it < 2; ++it) { const int u = it * 512 + tid, d = u >> 3, c = (u & 7) * 8; *(u32x4*)(KT + d * 72 + c) = pK[it]; } } while (0)
  SCAN_LOAD_A(0); SCAN_LOAD_QK(0); SCAN_LOAD_U(0);
  SCAN_FILL_A(); SCAN_FILL_QK();
  SCAN_LOAD_A(1); SCAN_LOAD_QK(1);
  lds_barrier();
#pragma unroll 1
  for (int n = 0; n < 32; ++n) {
    const int cgi = b * 32 + n, T0 = cgi * 64;
    f32x16 a0 = {}, a1 = {};
    if (hw == 0) {
#pragma unroll
      for (int q = 0; q < 4; ++q) { cvt16(a0, q, pU[q]); cvt16(a1, q, pU[4 + q]); }
    }
    const float dl = pdl;
    if (n + 1 < 32) SCAN_LOAD_U(n + 1);
    u32x4 zz0, zz1;
    { const int i = tid >> 3, seg = tid & 7; const size_t tok = (size_t)T0 + i; zz0 = *(const u32x4*)(p.SBZ + tok * DM + h * 128 + seg * 16); zz1 = *(const u32x4*)(p.SBZ + tok * DM + h * 128 + seg * 16 + 8); }
#pragma unroll
    for (int ks = 0; ks < 8; ++ks) {
      const bf16x8 bfr = *(const bf16x8*)(ST + v * 136 + ks * 16 + lh * 8);
      const bf16x8 x0 = *(const bf16x8*)(A1 + (hw * 64 + l32) * 136 + ks * 16 + lh * 8), x1 = *(const bf16x8*)(A1 + (hw * 64 + 32 + l32) * 136 + ks * 16 + lh * 8);
      a0 = __builtin_amdgcn_mfma_f32_32x32x16_bf16(x0, bfr, a0, 0, 0, 0);
      a1 = __builtin_amdgcn_mfma_f32_32x32x16_bf16(x1, bfr, a1, 0, 0, 0);
    }
    if (hw == 0) {
#pragma unroll
      for (int q = 0; q < 4; ++q) {
        u32x2 w0, w1; w0.x = pk2(a0[q * 4], a0[q * 4 + 1]); w0.y = pk2(a0[q * 4 + 2], a0[q * 4 + 3]); w1.x = pk2(a1[q * 4], a1[q * 4 + 1]); w1.y = pk2(a1[q * 4 + 2], a1[q * 4 + 3]);
        *(u32x2*)(UT + v * 72 + q * 8 + lh * 4) = w0; *(u32x2*)(UT + v * 72 + 32 + q * 8 + lh * 4) = w1;
      }
    }
    lds_barrier();
    S0 *= dl; S1 *= dl;
#pragma unroll
    for (int ks = 0; ks < 4; ++ks) {
      const bf16x8 bfr = *(const bf16x8*)(UT + v * 72 + ks * 16 + lh * 8);
      if (hw == 1) {
        const bf16x8 x0 = *(const bf16x8*)(AQ + l32 * 72 + ks * 16 + lh * 8), x1 = *(const bf16x8*)(AQ + (32 + l32) * 72 + ks * 16 + lh * 8);
        a0 = __builtin_amdgcn_mfma_f32_32x32x16_bf16(x0, bfr, a0, 0, 0, 0);
        a1 = __builtin_amdgcn_mfma_f32_32x32x16_bf16(x1, bfr, a1, 0, 0, 0);
      }
      const bf16x8 k0 = *(const bf16x8*)(KT + ((2 * hw) * 32 + l32) * 72 + ks * 16 + lh * 8), k1 = *(const bf16x8*)(KT + ((2 * hw + 1) * 32 + l32) * 72 + ks * 16 + lh * 8);
      S0 = __builtin_amdgcn_mfma_f32_32x32x16_bf16(k0, bfr, S0, 0, 0, 0);
      S1 = __builtin_amdgcn_mfma_f32_32x32x16_bf16(k1, bfr, S1, 0, 0, 0);
    }
    if (n + 1 < 32) { SCAN_FILL_A(); if (n + 2 < 32) SCAN_LOAD_A(n + 2); }
#pragma unroll
    for (int q = 0; q < 4; ++q) {
      u32x2 w0, w1; w0.x = pk2(S0[q * 4], S0[q * 4 + 1]); w0.y = pk2(S0[q * 4 + 2], S0[q * 4 + 3]); w1.x = pk2(S1[q * 4], S1[q * 4 + 1]); w1.y = pk2(S1[q * 4 + 2], S1[q * 4 + 3]);
      *(u32x2*)(ST + v * 136 + (2 * hw) * 32 + q * 8 + lh * 4) = w0; *(u32x2*)(ST + v * 136 + (2 * hw + 1) * 32 + q * 8 + lh * 4) = w1;
    }
    if (hw == 1) {
#pragma unroll
      for (int r = 0; r < 16; ++r) { const int i = (r & 3) + 8 * (r >> 2) + 4 * lh; OS[i * 132 + v] = a0[r]; OS[(32 + i) * 132 + v] = a1[r]; }
    }
    lds_barrier();
    {
      const int i = tid >> 3, seg = tid & 7; const float* orow = OS + i * 132 + seg * 16; float o[16]; float ss = 0.f;
#pragma unroll
      for (int e4 = 0; e4 < 4; ++e4) { const f32x4 t = *(const f32x4*)(orow + e4 * 4); o[e4 * 4] = t.x; o[e4 * 4 + 1] = t.y; o[e4 * 4 + 2] = t.z; o[e4 * 4 + 3] = t.w; ss += (t.x * t.x + t.y * t.y) + (t.z * t.z + t.w * t.w); }
      ss += __shfl_xor(ss, 1); ss += __shfl_xor(ss, 2); ss += __shfl_xor(ss, 4);
      const float rstd = rsqrtf(ss * (1.f / 128.f) + EPS);
      const size_t tok = (size_t)T0 + i; float z[16];
      unpack8(zz0, z); unpack8(zz1, z + 8);
#pragma unroll
      for (int e = 0; e < 16; ++e) o[e] = o[e] * rstd * onw16[e] * z[e];
      bf16_t* dst = p.QKV + tok * QW + 2048 + h * 128 + seg * 16;
      *(u32x4*)dst = pack8(o); *(u32x4*)(dst + 8) = pack8(o + 8);
    }
    if (n + 1 < 32) { SCAN_FILL_QK(); if (n + 2 < 32) SCAN_LOAD_QK(n + 2); }
  }
  float* sp = p.out + OFF_ND_P + (size_t)(b * 8 + h) * 16384;
#pragma unroll
  for (int r = 0; r < 16; ++r) { const int dd = (r & 3) + 8 * (r >> 2) + 4 * lh; sp[(size_t)((2 * hw) * 32 + dd) * 128 + v] = S0[r]; sp[(size_t)((2 * hw + 1) * 32 + dd) * 128 + v] = S1[r]; }
  lds_barrier();
}

__device__ __forceinline__ void sample_seq(const Params& p, int s, f32x4 (&Sn)[8], int s_next) {
  extern __shared__ __attribute__((aligned(16))) unsigned char smem[];
  float* qs = (float*)smem;
  float* ks = qs + 512;
  float* vs = ks + 512;
  float* os = vs + 512;
  float* red = os + 512;
  const int tid = launder(threadIdx.x), bs = s >> 3, h = s & 7;
  const size_t Tb = (size_t)NTP + bs * 4;
  const int kg = tid >> 5, vg = tid & 31;
  f32x4 S[8];
#pragma unroll
  for (int kk = 0; kk < 8; ++kk) S[kk] = Sn[kk];
  if (s_next >= 0) { const float* sn = p.sd + ((size_t)s_next * 128 + kg * 8) * 128 + vg * 4;
#pragma unroll
    for (int kk = 0; kk < 8; ++kk) Sn[kk] = ldnt4(sn + kk * 128); }
  float ga[4], be[4];
#pragma unroll
  for (int t = 0; t < 4; ++t) { ga[t] = p.BG[(Tb + t) * 16 + 8 + h]; be[t] = p.BG[(Tb + t) * 16 + h]; }
  u32x4 zt = {0u, 0u, 0u, 0u}; float ow[8];
  { const int t = (tid >> 4) & 3, seg = tid & 15; zt = *(const u32x4*)(p.SBZ + (Tb + t) * DM + h * 128 + seg * 8);
#pragma unroll
    for (int e = 0; e < 8; ++e) ow[e] = p.onw[seg * 8 + e]; }
  if (tid < 192) {
    const int c8 = tid & 15, grp = tid >> 4, part = grp % 3, t = grp / 3;
    const int colw = part * 1024 + h * 128 + c8 * 8;
    float a[8] = {0.f, 0.f, 0.f, 0.f, 0.f, 0.f, 0.f, 0.f};
#pragma unroll
    for (int j = 0; j < 4; ++j) {
      const int e_ = t + j; float x[8];
      if (e_ < 3) { const float* ps = p.scq + ((size_t)bs * 3 + e_) * QW + colw; for (int e = 0; e < 8; ++e) x[e] = ps[e]; }
      else unpack8(*(const u32x4*)(p.QKV + (Tb + e_ - 3) * QW + colw), x);
      const float* w = p.cbw + j * QW + colw;
#pragma unroll
      for (int e = 0; e < 8; ++e) a[e] += x[e] * w[e];
      if (j == 3 && t >= 1) { float* o = p.out + OFF_NCQ_S + ((size_t)bs * 3 + (t - 1)) * QW + colw; for (int e = 0; e < 8; ++e) o[e] = x[e]; }
    }
    float ss = 0.f;
#pragma unroll
    for (int e = 0; e < 8; ++e) { a[e] = siluf(a[e]); ss += a[e] * a[e]; }
    ss += __shfl_xor(ss, 1); ss += __shfl_xor(ss, 2); ss += __shfl_xor(ss, 4); ss += __shfl_xor(ss, 8);
    if (part < 2) { const float sc = rsqrtf(ss + EPS) * (part == 0 ? 0.08838834764831845f : 1.f); for (int e = 0; e < 8; ++e) a[e] *= sc; }
    float* d = (part == 0 ? qs : (part == 1 ? ks : vs)) + t * 128 + c8 * 8;
#pragma unroll
    for (int e = 0; e < 8; ++e) d[e] = a[e];
  }
  lds_barrier();
#pragma unroll
  for (int t = 0; t < 4; ++t) {
    const float a = __expf(ga[t]), beta = be[t];
    f32x4 part = {0.f, 0.f, 0.f, 0.f};
#pragma unroll
    for (int kk = 0; kk < 8; ++kk) { S[kk] *= a; part += S[kk] * ks[t * 128 + kg * 8 + kk]; }
    *(f32x4*)(red + kg * 128 + vg * 4) = part;
    lds_barrier();
    f32x4 r = {0.f, 0.f, 0.f, 0.f};
#pragma unroll
    for (int g2 = 0; g2 < 16; ++g2) r += *(const f32x4*)(red + g2 * 128 + vg * 4);
    const f32x4 dlt = (*(const f32x4*)(vs + t * 128 + vg * 4) - r) * beta;
    f32x4 po = {0.f, 0.f, 0.f, 0.f};
#pragma unroll
    for (int kk = 0; kk < 8; ++kk) { S[kk] += dlt * ks[t * 128 + kg * 8 + kk]; po += S[kk] * qs[t * 128 + kg * 8 + kk]; }
    lds_barrier();
    *(f32x4*)(red + kg * 128 + vg * 4) = po;
    lds_barrier();
    if (tid < 128) { float o = 0.f; for (int g2 = 0; g2 < 16; ++g2) o += red[g2 * 128 + tid]; os[t * 128 + tid] = o; }
    lds_barrier();
  }
  float* so = p.out + OFF_ND_S + ((size_t)s * 128 + kg * 8) * 128 + vg * 4;
#pragma unroll
  for (int kk = 0; kk < 8; ++kk) stnt4(so + kk * 128, S[kk]);
  if (tid < 64) {
    const int t = tid >> 4, seg = tid & 15; float o[8]; float ss = 0.f;
#pragma unroll
    for (int e = 0; e < 8; ++e) { o[e] = os[t * 128 + seg * 8 + e]; ss += o[e] * o[e]; }
    ss += __shfl_xor(ss, 1); ss += __shfl_xor(ss, 2); ss += __shfl_xor(ss, 4); ss += __shfl_xor(ss, 8);
    const float rstd = rsqrtf(ss * (1.f / 128.f) + EPS); float z[8];
    unpack8(zt, z);
#pragma unroll
    for (int e = 0; e < 8; ++e) o[e] = o[e] * rstd * ow[e] * z[e];
    *(u32x4*)(p.QKV + (Tb + t) * QW + 2048 + h * 128 + seg * 8) = pack8(o);
  }
  lds_barrier();
}

__device__ void phase3(const Params& p) {
  const int G = gridDim.x, bid = blockIdx.x;
  const bool split = G > 64;
#ifndef P3_NO_SCAN
  if (!split || bid < 64) for (int seq = bid; seq < 64; seq += (split ? 64 : G)) scan_seq(p, seq);
#endif
  if (!split || bid >= 64) {
    const int wk = split ? bid - 64 : bid, NW = split ? G - 64 : G;
#ifndef P3_NO_GEMM
    { extern __shared__ __attribute__((aligned(16))) unsigned char smem[];
      Sched S; S.init_strided(wk, NW, 264); gemm_phase<1>(p, (LAS unsigned char*)smem, p.GATE, DM, p.WOA, S); }
#endif
#ifndef P3_NO_SAMPLE
    {
      const int n2 = (264 > NW && 264 < 2 * NW) ? 264 - NW : 0, n1 = NW - n2;
      const int s_first = wk < n2 ? 1024 : (wk - n2), s_step = n1, s_end = 1024;
      f32x4 Sn[8];
      if (s_first < s_end) { const int tid_ = launder(threadIdx.x); const float* sn = p.sd + ((size_t)s_first * 128 + (tid_ >> 5) * 8) * 128 + (tid_ & 31) * 4;
#pragma unroll
        for (int kk = 0; kk < 8; ++kk) Sn[kk] = ldnt4(sn + kk * 128); }
      for (int s = s_first; s < s_end; s += s_step) sample_seq(p, s, Sn, s + s_step < s_end ? s + s_step : -1);
    }
#endif
  }
}

__device__ void phase4(const Params& p) {
  extern __shared__ __attribute__((aligned(16))) unsigned char smem[];
  Sched S; S.init_strided(blockIdx.x, gridDim.x, 256); gemm_phase<2>(p, (LAS unsigned char*)smem, p.QKV + 2048, QW, p.WOB, S);
  gemm_tail<2>(p, p.QKV + 2048, QW, p.WOB, 256, 8);
}
__device__ void phase5(const Params& p) {
  extern __shared__ __attribute__((aligned(16))) unsigned char smem[];
  Sched S; S.init_strided(blockIdx.x, gridDim.x, 256);
  gemm_phase<4>(p, (LAS unsigned char*)smem, p.UW, DM, p.WO, S);
  gemm_tail<3>(p, p.UW, DM, p.WO, 256, 8);
}
__device__ void phase6(const Params& p) {
  const int tid = launder(threadIdx.x), wid = tid >> 6, lane = tid & 63, G = gridDim.x;
  f32x4 w[4];
#pragma unroll
  for (int i = 0; i < 4; ++i) w[i] = *(const f32x4*)(p.fnw + i * 256 + lane * 4);
  const int row_lo = (G == 256) ? NTP : 0;
#pragma unroll 1
  for (int row = row_lo + (blockIdx.x * 8 + wid) * 4; row < NT; row += G * 8 * 4) {
    f32x4 v[4][4];
#pragma unroll
    for (int q = 0; q < 4; ++q)
#pragma unroll
      for (int i = 0; i < 4; ++i) v[q][i] = *(const f32x4*)(p.out + (size_t)(row + q) * DM + i * 256 + lane * 4);
#pragma unroll
    for (int q = 0; q < 4; ++q) {
      float ss = 0.f;
#pragma unroll
      for (int i = 0; i < 4; ++i) ss += (v[q][i].x * v[q][i].x + v[q][i].y * v[q][i].y) + (v[q][i].z * v[q][i].z + v[q][i].w * v[q][i].w);
      ss = wave_sum(ss);
      const float rstd = rsqrtf(ss * (1.f / DM) + EPS);
#pragma unroll
      for (int i = 0; i < 4; ++i) *(f32x4*)(p.out + (size_t)(row + q) * DM + i * 256 + lane * 4) = v[q][i] * rstd * w[i];
    }
  }
}

#define XB_TMO      128
#define XB_XCNT(j)  (256  + 64 * (j))
#define XB_XSUB(j)  (1280 + 64 * (j))
#define XB_XGEN(j)  (2304 + 64 * (j))
#define XB_TOP      3328
#define XB_TOPGEN   3392
#define XCD_BAR_WORDS 3456
#define XB_SPIN_CAP (1u << 18)
DI unsigned xb_ld(unsigned* p) { return __hip_atomic_load(p, __ATOMIC_RELAXED, __HIP_MEMORY_SCOPE_AGENT); }
DI unsigned xb_add(unsigned* p, unsigned v) { return __hip_atomic_fetch_add(p, v, __ATOMIC_RELAXED, __HIP_MEMORY_SCOPE_AGENT); }
DI unsigned xb_xcc_id() { return (unsigned)__builtin_amdgcn_s_getreg((3 << 11) | 20) & 0xFu; }
#define XB_SPIN(cond, bar) do { unsigned _sp = 0; while (cond) { __builtin_amdgcn_s_sleep(1); \
    if ((++_sp & 255u) == 0u) { if (xb_ld(&(bar)[XB_TMO])) break; if (_sp > XB_SPIN_CAP) { atomicAdd(&(bar)[XB_TMO], 1u); break; } } } } while (0)
struct XcdBarrier { unsigned* bar; unsigned x; volatile LAS unsigned* st; };
DI XcdBarrier xcd_barrier_post(unsigned* bar, volatile LAS unsigned* st) {
  XcdBarrier b; b.bar = bar; b.x = xb_xcc_id(); b.st = st;
  if (threadIdx.x == 0) (void)xb_add(&bar[XB_XCNT(b.x)], 1u);
  return b;
}
DI void xcd_barrier_complete(unsigned* bar, unsigned x, unsigned& nloc, unsigned& nx) {
  const unsigned G = gridDim.x * gridDim.y * gridDim.z;
  unsigned sum, cnt, mine, sp = 0u;
  for (;;) {
    sum = 0u; cnt = 0u; mine = 0u;
#pragma unroll
    for (unsigned j = 0; j < 16; ++j) { const unsigned c = xb_ld(&bar[XB_XCNT(j)]); sum += c; cnt += (c > 0u) ? 1u : 0u; mine = (j == x) ? c : mine; }
    if (sum == G) break;
    __builtin_amdgcn_s_sleep(1);
    if ((++sp & 255u) == 0u) { if (xb_ld(&bar[XB_TMO])) break; if (sp > XB_SPIN_CAP) { atomicAdd(&bar[XB_TMO], 1u); break; } }
  }
  nloc = mine > 0u ? mine : 1u; nx = cnt > 0u ? cnt : 1u;
}
DI void xcd_barrier(const XcdBarrier& b) {
  asm volatile("s_waitcnt vmcnt(0)" ::: "memory");
  __syncthreads();
  if (threadIdx.x == 0) {
    unsigned* bar = b.bar;
    __builtin_amdgcn_s_waitcnt(0);
    unsigned nloc = b.st[0], nx = b.st[1];
    if (nloc == 0u) { xcd_barrier_complete(bar, b.x, nloc, nx); b.st[0] = nloc; b.st[1] = nx; }
    const unsigned old = xb_add(&bar[XB_XSUB(b.x)], 1u);
    const unsigned gen = old / nloc;
    if (old + 1u == (gen + 1u) * nloc) {
      __builtin_amdgcn_fence(__ATOMIC_RELEASE, "agent");
      asm volatile("s_waitcnt vmcnt(0)" ::: "memory");
      const unsigned og = xb_add(&bar[XB_TOP], 1u);
      const unsigned tg = og / nx;
      if (og + 1u == (tg + 1u) * nx) xb_add(&bar[XB_TOPGEN], 1u);
      else XB_SPIN(xb_ld(&bar[XB_TOPGEN]) == tg, bar);
      __builtin_amdgcn_fence(__ATOMIC_ACQUIRE, "agent");
      xb_add(&bar[XB_XGEN(b.x)], 1u);
      asm volatile("s_waitcnt vmcnt(0)" ::: "memory");
    } else {
      XB_SPIN(xb_ld(&bar[XB_XGEN(b.x)]) == gen, bar);
      __builtin_amdgcn_fence(__ATOMIC_ACQUIRE, "agent");
      asm volatile("s_waitcnt vmcnt(0)" ::: "memory");
    }
  }
  __syncthreads();
}

__global__ void __launch_bounds__(512, 2) mega(Params p, int ph_lo, int ph_hi) {
  cg::grid_group grid = cg::this_grid();
  const int lo = ph_lo, hi = ph_hi;
  extern __shared__ __attribute__((aligned(16))) unsigned char smem[];
  volatile LAS unsigned* st = (volatile LAS unsigned*)((LAS unsigned char*)smem + 149504);
  if (threadIdx.x < 4) st[threadIdx.x] = 0u;
  __syncthreads();
  XcdBarrier xb; xb.bar = p.bar; xb.x = 0; xb.st = st;
  if (hi - lo > 1) xb = xcd_barrier_post(p.bar, st);
  if (hi > 100) grid.sync();
#define GRID_SYNC() xcd_barrier(xb)
#define IN(k) (lo <= (k) && (k) < hi)
#define BOTH(k) (IN(k) && IN((k) + 1))
  if (IN(0)) { phase0(p); if (BOTH(0)) GRID_SYNC(); }
  if (IN(1)) { phase1(p); if (BOTH(1)) GRID_SYNC(); }
  if (IN(2)) { phase2(p); if (BOTH(2)) GRID_SYNC(); }
  if (IN(3)) { phase3(p); if (BOTH(3)) GRID_SYNC(); }
  if (IN(4)) { phase4(p); if (BOTH(4)) GRID_SYNC(); }
  if (IN(5)) { phase5(p); if (BOTH(5)) GRID_SYNC(); }
  if (IN(6)) { phase6(p); }
}

extern "C" void kernel_launch(void* const* d_in, const int* in_sizes, int n_in, void* d_out, int out_size, void* d_ws, size_t ws_size, hipStream_t stream) {
  static int grid = 0;
  if (grid == 0) {
    int dev = 0, cus = 0, per_cu = 0;
    hipGetDevice(&dev);
    hipDeviceGetAttribute(&cus, hipDeviceAttributeMultiprocessorCount, dev);
    if (hipFuncSetAttribute((const void*)mega, hipFuncAttributeMaxDynamicSharedMemorySize, LDS_BYTES) != hipSuccess) fprintf(stderr, "hipFuncSetAttribute failed\n");
    hipOccupancyMaxActiveBlocksPerMultiprocessor(&per_cu, (const void*)mega, 512, LDS_BYTES);
    if (per_cu < 1) { fprintf(stderr, "occupancy query says %d\n", per_cu); per_cu = 1; }
    (void)hipGetLastError();
    grid = cus;
  }
  Params p{};
  p.x_p = (const float*)d_in[0]; p.x_s = (const float*)d_in[1]; p.sca = (const float*)d_in[2]; p.scq = (const float*)d_in[3]; p.sd = (const float*)d_in[4];
  p.w_in = (const float*)d_in[5]; p.caw = (const float*)d_in[6]; p.cbw = (const float*)d_in[7]; p.a_log = (const float*)d_in[8]; p.dt_bias = (const float*)d_in[9];
  p.onw = (const float*)d_in[10]; p.w_oa = (const float*)d_in[11]; p.w_ob = (const float*)d_in[12]; p.w_o = (const float*)d_in[13]; p.nw = (const float*)d_in[14]; p.fnw = (const float*)d_in[15];
  p.out = (float*)d_out;
  unsigned char* ws = (unsigned char*)d_ws; size_t o = 0;
  auto take = [&](size_t bytes) { unsigned char* r = ws + o; o += (bytes + 255) & ~(size_t)255; return r; };
  p.QKV = (bf16_t*)take((size_t)NT * QW * 2);
  p.SBZ = (bf16_t*)take((size_t)NT * DM * 2);
  p.GATE = (bf16_t*)take((size_t)NT * DM * 2);
  p.UW = (bf16_t*)take((size_t)NT * DM * 2);
  p.AQK = (bf16_t*)take((size_t)2048 * 4096 * 2);
  p.WOA = (bf16_t*)take((size_t)DM * DM * 2); p.WOB = (bf16_t*)take((size_t)DM * DM * 2); p.WO = (bf16_t*)take((size_t)DM * DM * 2);
  p.WB16 = (bf16_t*)take(16 * DM * 2);
  p.BG = (float*)take((size_t)NT * 16 * 4);
  p.DL = (float*)take(2048 * 4);
  p.bar = (unsigned*)take((XCD_BAR_WORDS + 64 * 64) * 4);
  p.RS = (float*)take(64 * 4 * 256 * 4);
  if (o > ws_size) { fprintf(stderr, "workspace too small: need %zu have %zu\n", o, ws_size); return; }
  p.SGA = (bf16_t*)d_out; p.SGB = p.SGA + (size_t)NT * DM;
  unsigned char* nds = (unsigned char*)((float*)d_out + OFF_ND_S);
  p.WIN = (bf16_t*)nds; p.P = (bf16_t*)(nds + (size_t)10240 * DM * 2); p.HALO = (bf16_t*)(nds + (size_t)10240 * DM * 2 + (size_t)NT * DM * 2);
#if COOP
  if (hipMemsetAsync(p.bar, 0, (XCD_BAR_WORDS + 64 * 64) * 4, stream) != hipSuccess) fprintf(stderr, "memset of barrier words failed\n");
  int lo = 0, hi = 7; void* args[] = {&p, &lo, &hi};
  hipError_t e = hipLaunchCooperativeKernel((const void*)mega, dim3(grid), dim3(512), args, LDS_BYTES, stream);
  if (e != hipSuccess) fprintf(stderr, "cooperative launch failed: %s\n", hipGetErrorString(e));
#else
  for (int ph = 0; ph < 7; ++ph) { hipLaunchKernelGGL(mega, dim3(grid), dim3(512), LDS_BYTES, stream, p, ph, ph + 1); if (ph == DUP) hipLaunchKernelGGL(mega, dim3(grid), dim3(512), LDS_BYTES, stream, p, ph, ph + 1); }
#endif
}
```

```cpp
#include <hip/hip_runtime.h>
#include <hip/hip_cooperative_groups.h>
#include <cstdio>
#include <cstdint>
namespace cg = cooperative_groups;

#ifndef COOP
#define COOP 1
#endif
#ifndef DUP
#define DUP -1
#endif

typedef unsigned short bf16_t;
typedef short bf16x8 __attribute__((ext_vector_type(8)));
typedef float f32x4 __attribute__((ext_vector_type(4)));
typedef float f32x2 __attribute__((ext_vector_type(2)));
typedef float f32x16 __attribute__((ext_vector_type(16)));
typedef unsigned u32x4 __attribute__((ext_vector_type(4)));
typedef unsigned u32x2 __attribute__((ext_vector_type(2)));
typedef __bf16 bf16x2_t __attribute__((ext_vector_type(2)));

#define DI __device__ __forceinline__

constexpr int NT = 16896, NTP = 16384, DM = 1024, QW = 3072, NIN = 10256;
constexpr float EPS = 1e-6f;
constexpr size_t OFF_NCA_P = 17301504, OFF_NCQ_P = 17317888, OFF_ND_P = 17391616, OFF_NCA_S = 18440192, OFF_NCQ_S = 18702336, OFF_ND_S = 19881984;
constexpr int LDS_BYTES = 149504 + 16;

struct Params {
  const float *x_p, *x_s, *sca, *scq, *sd, *w_in, *caw, *cbw, *a_log, *dt_bias, *onw, *w_oa, *w_ob, *w_o, *nw, *fnw;
  float* out;
  bf16_t *QKV, *SBZ, *GATE, *UW, *AQK, *WOA, *WOB, *WO, *WB16;
  float *BG, *DL;
  bf16_t *SGA, *SGB, *WIN, *P, *HALO;
  unsigned* bar;
  float* RS;
};

DI unsigned pk2(float a, float b) { bf16x2_t v = __builtin_convertvector((f32x2){a, b}, bf16x2_t); return __builtin_bit_cast(unsigned, v); }
DI float bflo(unsigned w) { return __uint_as_float(w << 16); }
DI float bfhi(unsigned w) { return __uint_as_float(w & 0xffff0000u); }
DI float bf2f(bf16_t v) { return __uint_as_float(((unsigned)v) << 16); }
DI float siluf(float x) { return x * __builtin_amdgcn_rcpf(1.f + __expf(-x)); }
DI float sigmf(float x) { return __builtin_amdgcn_rcpf(1.f + __expf(-x)); }
DI f32x4 ldnt4(const float* q) { return __builtin_nontemporal_load((const f32x4*)q); }
DI void stnt4(float* q, f32x4 v) { __builtin_nontemporal_store(v, (f32x4*)q); }
DI float wave_sum(float v) {
#pragma unroll
  for (int o = 1; o < 64; o <<= 1) v += __shfl_xor(v, o);
  return v;
}
DI void unpack8(u32x4 w, float* f) { f[0] = bflo(w.x); f[1] = bfhi(w.x); f[2] = bflo(w.y); f[3] = bfhi(w.y); f[4] = bflo(w.z); f[5] = bfhi(w.z); f[6] = bflo(w.w); f[7] = bfhi(w.w); }
DI u32x4 pack8(const float* f) { u32x4 w; w.x = pk2(f[0], f[1]); w.y = pk2(f[2], f[3]); w.z = pk2(f[4], f[5]); w.w = pk2(f[6], f[7]); return w; }

DI int perm32(int rho) { const int n = rho >> 4, i = rho & 15; return 8 * (i >> 2) + 4 * n + (i & 3); }
DI int colmap_in(int R) {
  const int pn = R >> 8, l = R & 255, bj = l >> 7, wc = (l & 127) >> 5, rho = l & 31;
  if (pn < 16) { const int n = rho >> 4, i = rho & 15; return (bj * 2 + n) * 1024 + 64 * pn + wc * 16 + i; }
  const int base = pn < 32 ? 4096 + (pn - 16) * 256 : 8208 + (pn - 32) * 256;
  return base + bj * 128 + wc * 32 + perm32(rho);
}
DI int colmap_sq(int R) { return (R & ~31) + perm32(R & 31); }

constexpr int BM = 256, BK = 64, HALF = 128, NXCD = 8, WGM = 8, HT = HALF * BK;
DI void lds_barrier() { asm volatile("s_waitcnt lgkmcnt(0)" ::: "memory"); __builtin_amdgcn_s_barrier(); asm volatile("" ::: "memory"); }
DI int launder(int x) { asm volatile("" : "+v"(x)); return x; }
DI int lds_byte(int r, int c) { const int st = (r >> 4) * 2 + (c >> 5), rr = r & 15, cc = c & 31, ob = rr * 64 + cc * 2; return st * 1024 + (ob ^ (((ob >> 9) & 1) << 5)); }
DI void stage_rc(int b, int& R, int& C) { const int st = b / 1024, sb = b % 1024, swz = sb ^ (((sb >> 9) & 1) << 5); R = (st >> 1) * 16 + swz / 64; C = (st & 1) * 32 + (swz % 64) / 2; }

struct TileOrder {
  int nM, nN, nwg, G, c;
  DI void init(int M, int N, int G_, int c_) { nM = M / BM; nN = N / BM; nwg = nM * nN; G = G_; c = c_; }
  DI bool next(int i, int& pm, int& pn) const {
    const long L = (long)i * G + c; if (L >= nwg) return false;
    int wgid = (int)L; { const int q = nwg / NXCD, r = nwg % NXCD, xcd = wgid % NXCD, off = wgid / NXCD; wgid = (xcd < r ? xcd * (q + 1) : r * (q + 1) + (xcd - r) * q) + off; }
    const int nig = WGM * nN, gid = wgid / nig, fm = gid * WGM, gsz = (nM - fm) < WGM ? (nM - fm) : WGM;
    pm = fm + ((wgid % nig) % gsz); pn = (wgid % nig) / gsz; return true;
  }
};

#define FN_CNT(pm) (XCD_BAR_WORDS_C + 64 * (pm))
constexpr int XCD_BAR_WORDS_C = 3456;
DI void epilogue_final(const Params& p, f32x4 (&acc)[2][2][4][2], int pm, int pn, int wr, int wc, int fr, int fq, unsigned char* smem_, int tid) {
  float* PS = (float*)(smem_ + 131072);
  float* RSTD = (float*)(smem_ + 131072 + 4096);
  const int col0 = pn * BM + wc * 32 + 8 * fq;
#pragma unroll
  for (int ai = 0; ai < 2; ++ai)
#pragma unroll
    for (int m = 0; m < 4; ++m) {
      const int rl = ai * HALF + wr * 64 + m * 16 + fr; const size_t row = (size_t)pm * BM + rl;
      const float* xr = p.x_p + row * DM;
      float ss = 0.f;
#pragma unroll
      for (int bj = 0; bj < 2; ++bj) {
        const f32x4 x0 = ldnt4(xr + col0 + bj * HALF), x1 = ldnt4(xr + col0 + bj * HALF + 4);
        acc[ai][bj][m][0] += x0; acc[ai][bj][m][1] += x1;
        const f32x4 a = acc[ai][bj][m][0], b = acc[ai][bj][m][1];
        ss += (a.x * a.x + a.y * a.y) + (a.z * a.z + a.w * a.w) + (b.x * b.x + b.y * b.y) + (b.z * b.z + b.w * b.w);
      }
      ss += __shfl_xor(ss, 16); ss += __shfl_xor(ss, 32);
      if (fq == 0) PS[rl * 4 + wc] = ss;
      __builtin_amdgcn_sched_barrier(0);
    }
  lds_barrier();
  unsigned* cnt = p.bar + FN_CNT(pm);
  if (tid < 256) {
    const f32x4 s4 = *(const f32x4*)(PS + tid * 4);
    __hip_atomic_store((unsigned*)p.RS + ((size_t)(pm * 4 + pn) * 256 + tid), __float_as_uint((s4.x + s4.y) + (s4.z + s4.w)), __ATOMIC_RELAXED, __HIP_MEMORY_SCOPE_AGENT);
  }
  asm volatile("s_waitcnt vmcnt(0)" ::: "memory");
  lds_barrier();
  if (tid == 0) __hip_atomic_fetch_add(cnt, 1u, __ATOMIC_RELAXED, __HIP_MEMORY_SCOPE_AGENT);
  if (tid < 64) {
    unsigned sp = 0;
    while ((unsigned)__builtin_amdgcn_readfirstlane(__hip_atomic_load(cnt, __ATOMIC_RELAXED, __HIP_MEMORY_SCOPE_AGENT)) < 4u) { __builtin_amdgcn_s_sleep(2); if (++sp > (1u << 20)) break; }
    __builtin_amdgcn_fence(__ATOMIC_ACQUIRE, "agent");
  }
  asm volatile("s_waitcnt vmcnt(0) lgkmcnt(0)" ::: "memory");
  lds_barrier();
  if (tid < 256) {
    float tot = 0.f;
#pragma unroll
    for (int t = 0; t < 4; ++t) tot += __uint_as_float(__hip_atomic_load((unsigned*)p.RS + ((size_t)(pm * 4 + t) * 256 + tid), __ATOMIC_RELAXED, __HIP_MEMORY_SCOPE_AGENT));
    RSTD[tid] = rsqrtf(tot * (1.f / DM) + EPS);
  }
  lds_barrier();
#pragma unroll
  for (int bj = 0; bj < 2; ++bj) {
    const f32x4 fw0 = *(const f32x4*)(p.fnw + col0 + bj * HALF), fw1 = *(const f32x4*)(p.fnw + col0 + bj * HALF + 4);
#pragma unroll
    for (int ai = 0; ai < 2; ++ai)
#pragma unroll
      for (int m = 0; m < 4; ++m) {
        const int rl = ai * HALF + wr * 64 + m * 16 + fr; const size_t row = (size_t)pm * BM + rl; const float r = RSTD[rl];
        float* o = p.out + row * DM + col0 + bj * HALF;
        stnt4(o, acc[ai][bj][m][0] * r * fw0); stnt4(o + 4, acc[ai][bj][m][1] * r * fw1);
        __builtin_amdgcn_sched_barrier(0);
      }
  }
}

template <int EPI>
DI void epilogue(const Params& p, const f32x4 (&acc)[2][2][4][2], int pm, int pn, int wr, int wc, int fr, int fq) {
  const int row0 = pm * BM + wr * 64 + fr;
  if (EPI == 0) {
    if (pn < 16) {
      const int ch = pn * 64 + wc * 16 + fq * 4;
#pragma unroll
      for (int ai = 0; ai < 2; ++ai)
#pragma unroll
        for (int m = 0; m < 4; ++m) {
          const size_t row = row0 + ai * HALF + m * 16;
          const f32x4 b = acc[ai][0][m][0], c = acc[ai][0][m][1], h = acc[ai][1][m][0], z = acc[ai][1][m][1];
          u32x2 pp, gg;
          pp.x = pk2(c[0] * h[0], c[1] * h[1]); pp.y = pk2(c[2] * h[2], c[3] * h[3]);
          gg.x = pk2(siluf(z[0]) * b[0], siluf(z[1]) * b[1]); gg.y = pk2(siluf(z[2]) * b[2], siluf(z[3]) * b[3]);
          *(u32x2*)(p.P + row * DM + ch) = pp;
          *(u32x2*)(p.GATE + row * DM + ch) = gg;
        }
    } else {
      const int kind = pn < 28 ? 0 : (pn < 32 ? 1 : 2);
      bf16_t* dst; int ld, colt;
      if (kind == 0) { dst = p.QKV; ld = QW; colt = (pn - 16) * 256; }
      else if (kind == 1) { dst = p.SBZ; ld = DM; colt = (pn - 28) * 256; }
      else { dst = pn < 36 ? p.SGA : p.SGB; ld = DM; colt = ((pn - 32) & 3) * 256; }
      const int col0 = colt + wc * 32 + 8 * fq;
#pragma unroll
      for (int ai = 0; ai < 2; ++ai)
#pragma unroll
        for (int m = 0; m < 4; ++m) {
          const int row = row0 + ai * HALF + m * 16;
#pragma unroll
          for (int bj = 0; bj < 2; ++bj) {
            f32x4 v0 = acc[ai][bj][m][0], v1 = acc[ai][bj][m][1];
            if (kind == 1) { for (int j = 0; j < 4; ++j) { v0[j] = siluf(v0[j]); v1[j] = siluf(v1[j]); } }
            if (kind == 2) { for (int j = 0; j < 4; ++j) { v0[j] = sigmf(v0[j]); v1[j] = sigmf(v1[j]); } }
            u32x4 w; w.x = pk2(v0[0], v0[1]); w.y = pk2(v0[2], v0[3]); w.z = pk2(v1[0], v1[1]); w.w = pk2(v1[2], v1[3]);
            *(u32x4*)(dst + (size_t)row * ld + col0 + bj * HALF) = w;
            if (kind == 0 && row < NTP && (row & 63) >= 61)
              *(u32x4*)(p.HALO + ((size_t)(row >> 6) * 3 + ((row & 63) - 61)) * QW + col0 + bj * HALF) = w;
          }
        }
    }
  } else {
    const int col0 = pn * BM + wc * 32 + 8 * fq;
#pragma unroll
    for (int ai = 0; ai < 2; ++ai)
#pragma unroll
      for (int m = 0; m < 4; ++m) {
        const size_t row = row0 + ai * HALF + m * 16;
#pragma unroll
        for (int bj = 0; bj < 2; ++bj) {
          const f32x4 v0 = acc[ai][bj][m][0], v1 = acc[ai][bj][m][1];
          const size_t o = row * DM + col0 + bj * HALF;
          if (EPI == 1) {
            float s[8]; unpack8(*(const u32x4*)(p.SGA + o), s);
            u32x4 w; w.x = pk2(s[0] * v0[0], s[1] * v0[1]); w.y = pk2(s[2] * v0[2], s[3] * v0[3]); w.z = pk2(s[4] * v1[0], s[5] * v1[1]); w.w = pk2(s[6] * v1[2], s[7] * v1[3]);
            *(u32x4*)(p.SGA + o) = w;
          } else if (EPI == 2) {
            float s[8], a[8]; unpack8(*(const u32x4*)(p.SGB + o), s); unpack8(*(const u32x4*)(p.SGA + o), a);
            u32x4 w; w.x = pk2(a[0] + s[0] * v0[0], a[1] + s[1] * v0[1]); w.y = pk2(a[2] + s[2] * v0[2], a[3] + s[3] * v0[3]);
            w.z = pk2(a[4] + s[4] * v1[0], a[5] + s[5] * v1[1]); w.w = pk2(a[6] + s[6] * v1[2], a[7] + s[7] * v1[3]);
            *(u32x4*)(p.UW + o) = w;
          } else {
            const float* xr = row < NTP ? p.x_p + row * DM : p.x_s + (row - NTP) * DM;
            const f32x4 x0 = *(const f32x4*)(xr + col0 + bj * HALF), x1 = *(const f32x4*)(xr + col0 + bj * HALF + 4);
            *(f32x4*)(p.out + o) = x0 + v0; *(f32x4*)(p.out + o + 4) = x1 + v1;
          }
        }
      }
  }
}

#define LAS __attribute__((address_space(3)))
struct Sched {
  int mode, nM, nN, nwg, G, c, start, stride, count;
  DI void init_static(int M, int N, int G_, int c_) { mode = 0; nM = M / BM; nN = N / BM; nwg = nM * nN; G = G_; c = c_; start = stride = count = 0; }
  DI void init_strided(int start_, int stride_, int count_) { mode = 1; start = start_; stride = stride_; count = count_; nM = nN = nwg = G = c = 0; }
  DI bool next(int i, int& pm, int& pn) const {
    if (mode == 0) {
      const long L = (long)i * G + c; if (L >= nwg) return false;
      int wgid = (int)L; { const int q = nwg / NXCD, r = nwg % NXCD, xcd = wgid % NXCD, off = wgid / NXCD; wgid = (xcd < r ? xcd * (q + 1) : r * (q + 1) + (xcd - r) * q) + off; }
      const int nig = WGM * nN, gid = wgid / nig, fm = gid * WGM, gsz = (nM - fm) < WGM ? (nM - fm) : WGM;
      pm = fm + ((wgid % nig) % gsz); pn = (wgid % nig) / gsz; return true;
    }
    const int t = start + i * stride; if (t >= count) return false;
    pm = t >> 2; pn = t & 3; return true;
  }
};

template <int EPI>
DI void gemm_phase(const Params& p, LAS unsigned char* lds, const bf16_t* A, int lda, const bf16_t* Bt, const Sched& S) {
  constexpr int K = 1024, nt = K / BK, HTB = HALF * BK * 2;
  const int tid = launder(threadIdx.x), wid = __builtin_amdgcn_readfirstlane(tid >> 6), lane = tid & 63, wr = wid >> 2, wc = wid & 3, fr = lane & 15, fq = lane >> 4;
  unsigned voffA[2], voffB[2];
#pragma unroll
  for (int i = 0; i < 2; ++i) { int R, C; stage_rc(tid * 16 + i * 8192, R, C); voffA[i] = (unsigned)(R * lda + C) * 2u; voffB[i] = (unsigned)(R * K + C) * 2u; }
  const size_t kstep = (size_t)(BK * 2);
  const size_t hstepA = (size_t)HALF * lda * 2, tstepA = 2 * hstepA, hstepB = (size_t)HALF * K * 2, tstepB = 2 * hstepB;
  const unsigned ldsw = (unsigned)wid * 1024u;
  const int aoff = lds_byte(wr * 64 + fr, fq * 8), boff = lds_byte(wc * 32 + fr, fq * 8);
#define PG8_SA(b, h) (((b) * 2 + (h)) * HTB)
#define PG8_SB(b, h) ((4 + (b) * 2 + (h)) * HTB)
#define PG8_STAGE(bufoff, gbase, voff) do { _Pragma("unroll") for (int _i = 0; _i < 2; ++_i) \
    __builtin_amdgcn_global_load_lds((const unsigned*)((const char*)(gbase) + (voff)[_i]), (LAS unsigned*)(lds + (bufoff) + ldsw + _i * 8192), 16, 0, 0); } while (0)
#define PG8_LDA(dst, b, h) do { _Pragma("unroll") for (int m = 0; m < 4; ++m) _Pragma("unroll") for (int k = 0; k < 2; ++k) dst[m][k] = *(const LAS bf16x8*)(lds + PG8_SA(b, h) + aoff + m * 2048 + k * 1024); } while (0)
#define PG8_LDB(dst, b, h) do { _Pragma("unroll") for (int n = 0; n < 2; ++n) _Pragma("unroll") for (int k = 0; k < 2; ++k) dst[n][k] = *(const LAS bf16x8*)(lds + PG8_SB(b, h) + boff + n * 2048 + k * 1024); } while (0)
#define PG8_MMA(ai, bj, At, Bt_) do { __builtin_amdgcn_s_setprio(1); _Pragma("unroll") for (int m = 0; m < 4; ++m) _Pragma("unroll") for (int n = 0; n < 2; ++n) _Pragma("unroll") for (int k = 0; k < 2; ++k) \
    acc[ai][bj][m][n] = __builtin_amdgcn_mfma_f32_16x16x32_bf16(Bt_[n][k], At[m][k], acc[ai][bj][m][n], 0, 0, 0); __builtin_amdgcn_s_setprio(0); } while (0)
#define PG8_WAIT_V(n) asm volatile("s_waitcnt vmcnt(" #n ")" ::: "memory")
#define PG8_WAIT_L(n) asm volatile("s_waitcnt lgkmcnt(" #n ")" ::: "memory")
#define PG8_BAR __builtin_amdgcn_s_barrier()
#define PG8_SCHED __builtin_amdgcn_sched_barrier(0)
  int cpm, cpn, npm = 0, npn = 0; int ui = 0;
  if (!S.next(0, cpm, cpn)) return;
  f32x4 acc[2][2][4][2];
#pragma unroll
  for (int a = 0; a < 2; ++a)
#pragma unroll
    for (int b = 0; b < 2; ++b)
#pragma unroll
      for (int m = 0; m < 4; ++m)
#pragma unroll
        for (int n = 0; n < 2; ++n) acc[a][b][m][n] = (f32x4){0.f, 0.f, 0.f, 0.f};
  bf16x8 At[4][2], B0[2][2], B1[2][2];
  const char* cA = (const char*)A + (size_t)cpm * tstepA; const char* cB = (const char*)Bt + (size_t)cpn * tstepB;
  PG8_STAGE(PG8_SB(0, 0), cB, voffB); PG8_STAGE(PG8_SB(0, 1), cB + hstepB, voffB); PG8_STAGE(PG8_SA(0, 0), cA, voffA); PG8_STAGE(PG8_SA(0, 1), cA + hstepA, voffA);
  if (wr == 1) PG8_BAR;
  PG8_WAIT_V(2); PG8_BAR;
  PG8_STAGE(PG8_SB(1, 0), cB + kstep, voffB); PG8_STAGE(PG8_SA(1, 0), cA + kstep, voffA); PG8_STAGE(PG8_SB(1, 1), cB + hstepB + kstep, voffB);
  PG8_WAIT_V(6); PG8_BAR;
  for (;;) {
    const bool has_next = S.next(ui + 1, npm, npn);
    const char* nA = has_next ? (const char*)A + (size_t)npm * tstepA : cA; const char* nB = has_next ? (const char*)Bt + (size_t)npn * tstepB : cB;
#pragma unroll 1
    for (int t = 0; t < nt; t += 2) {
      const bool last = (t == nt - 2);
      const char* a1 = cA + (size_t)(t + 1) * kstep;
      const char* a2 = last ? nA : cA + (size_t)(t + 2) * kstep; const char* b2 = last ? nB : cB + (size_t)(t + 2) * kstep;
      const char* a3 = a2 + kstep; const char* b3 = b2 + kstep;
      PG8_LDB(B0, 0, 0); PG8_LDB(B1, 0, 1); PG8_SCHED; PG8_LDA(At, 0, 0); PG8_STAGE(PG8_SA(1, 1), a1 + hstepA, voffA);
      PG8_WAIT_V(8); PG8_WAIT_L(0); PG8_BAR; PG8_MMA(0, 0, At, B0); PG8_MMA(0, 1, At, B1); PG8_BAR; PG8_SCHED;
      PG8_LDA(At, 0, 1); PG8_STAGE(PG8_SB(0, 0), b2, voffB); PG8_STAGE(PG8_SB(0, 1), b2 + hstepB, voffB); PG8_STAGE(PG8_SA(0, 0), a2, voffA);
      PG8_WAIT_V(8); PG8_WAIT_L(0); PG8_BAR; PG8_MMA(1, 0, At, B0); PG8_MMA(1, 1, At, B1); PG8_BAR; PG8_SCHED;
      PG8_LDB(B0, 1, 0); PG8_LDB(B1, 1, 1); PG8_SCHED; PG8_LDA(At, 1, 0); PG8_STAGE(PG8_SA(0, 1), a2 + hstepA, voffA);
      PG8_WAIT_V(8); PG8_WAIT_L(0); PG8_BAR; PG8_MMA(0, 0, At, B0); PG8_MMA(0, 1, At, B1); PG8_BAR; PG8_SCHED;
      PG8_LDA(At, 1, 1); PG8_STAGE(PG8_SB(1, 0), b3, voffB); PG8_STAGE(PG8_SB(1, 1), b3 + hstepB, voffB); PG8_STAGE(PG8_SA(1, 0), a3, voffA);
      PG8_WAIT_V(8); PG8_WAIT_L(0); PG8_BAR; PG8_MMA(1, 0, At, B0); PG8_MMA(1, 1, At, B1); PG8_BAR; PG8_SCHED;
    }
    if (wr == 0) PG8_BAR;
    if (!(EPI == 4 && gridDim.x == 256)) epilogue<EPI == 4 ? 3 : EPI>(p, acc, cpm, cpn, wr, wc, fr, fq);
    if (!has_next) break;
#pragma unroll
    for (int a = 0; a < 2; ++a)
#pragma unroll
      for (int b = 0; b < 2; ++b)
#pragma unroll
        for (int m = 0; m < 4; ++m)
#pragma unroll
          for (int n = 0; n < 2; ++n) acc[a][b][m][n] = (f32x4){0.f, 0.f, 0.f, 0.f};
    cpm = npm; cpn = npn; cA = nA; cB = nB; ++ui;
    if (wr == 1) PG8_BAR;
  }
  PG8_WAIT_V(0);
  PG8_BAR;
  if (EPI == 4 && gridDim.x == 256) epilogue_final(p, acc, cpm, cpn, wr, wc, fr, fq, (unsigned char*)lds, tid);
#undef PG8_SA
#undef PG8_SB
#undef PG8_STAGE
#undef PG8_LDA
#undef PG8_LDB
#undef PG8_MMA
}

template <int EPI>
DI void gemm_tail(const Params& p, const bf16_t* A, int lda, const bf16_t* Bt, int tile0, int ntiles) {
  const int tid = launder(threadIdx.x), wid = tid >> 6, lane = tid & 63, fr = lane & 15, fq = lane >> 4;
  for (int q = blockIdx.x; q < ntiles * 32; q += gridDim.x) {
    const int t = tile0 + (q >> 5), sub = q & 31, pm = t >> 2, pn = t & 3;
    const int row0 = pm * 256 + (sub >> 3) * 64 + (wid >> 1) * 16, R0 = pn * 256 + (sub & 7) * 32 + (wid & 1) * 16;
    const bf16_t* ap = A + (size_t)(row0 + fr) * lda + fq * 8; const bf16_t* bp = Bt + (size_t)(R0 + fr) * DM + fq * 8;
    f32x4 acc = {0.f, 0.f, 0.f, 0.f};
#pragma unroll 16
    for (int ks = 0; ks < 32; ++ks) { const bf16x8 a = *(const bf16x8*)(ap + ks * 32), b = *(const bf16x8*)(bp + ks * 32); acc = __builtin_amdgcn_mfma_f32_16x16x32_bf16(b, a, acc, 0, 0, 0); }
    const size_t row = row0 + fr; const int col0 = (R0 & ~31) + 8 * fq + 4 * ((R0 >> 4) & 1);
    const size_t o = row * DM + col0;
    if (EPI == 2) {
      const u32x2 sw = *(const u32x2*)(p.SGB + o), aw = *(const u32x2*)(p.SGA + o);
      u32x2 w; w.x = pk2(bflo(aw.x) + bflo(sw.x) * acc[0], bfhi(aw.x) + bfhi(sw.x) * acc[1]); w.y = pk2(bflo(aw.y) + bflo(sw.y) * acc[2], bfhi(aw.y) + bfhi(sw.y) * acc[3]);
      *(u32x2*)(p.UW + o) = w;
    } else {
      const float* xr = row < NTP ? p.x_p + row * DM : p.x_s + (row - NTP) * DM;
      *(f32x4*)(p.out + o) = *(const f32x4*)(xr + col0) + acc;
    }
  }
}

DI void wtile_desc(const Params& p, int tile, const float*& src, bf16_t*& dst, int& N, int& kt, int& R0, int& kind) {
  if (tile < 2560) { src = p.w_in; dst = p.WIN; N = NIN; kt = tile & 15; R0 = (tile >> 4) * 64; kind = 0; }
  else { const int t2 = tile - 2560, mat = t2 >> 8; src = mat == 0 ? p.w_oa : (mat == 1 ? p.w_ob : p.w_o); dst = mat == 0 ? p.WOA : (mat == 1 ? p.WOB : p.WO); N = DM; kt = t2 & 15; R0 = ((t2 & 255) >> 4) * 64; kind = 1; }
}
DI void convert_tiles(const Params& p, int first, int end, int stride) {
  extern __shared__ __attribute__((aligned(16))) unsigned char smem[];
  float* lds = (float*)smem;
  const int tid = launder(threadIdx.x);
#pragma unroll 1
  for (int t0 = first; t0 < end; t0 += 4 * stride) {
    f32x4 v[4][2];
#pragma unroll
    for (int q = 0; q < 4; ++q) {
      const int tile = t0 + q * stride;
      if (tile < end) {
        const float* src; bf16_t* dst; int N, kt, R0, kind; wtile_desc(p, tile, src, dst, N, kt, R0, kind);
        const int r4 = tid & 15, R = R0 + r4 * 4, c = kind == 0 ? colmap_in(R) : colmap_sq(R);
#pragma unroll
        for (int ps = 0; ps < 2; ++ps) v[q][ps] = ldnt4(src + (size_t)(kt * 64 + ps * 32 + (tid >> 4)) * N + c);
      }
    }
#pragma unroll
    for (int q = 0; q < 4; ++q) {
      if (t0 + q * stride < end) {
#pragma unroll
        for (int ps = 0; ps < 2; ++ps) { float* d = lds + q * (64 * 65) + (ps * 32 + (tid >> 4)) * 65 + (tid & 15) * 4; d[0] = v[q][ps].x; d[1] = v[q][ps].y; d[2] = v[q][ps].z; d[3] = v[q][ps].w; }
      }
    }
    lds_barrier();
#pragma unroll
    for (int q = 0; q < 4; ++q) {
      const int tile = t0 + q * stride;
      if (tile < end) {
        const float* src; bf16_t* dst; int N, kt, R0, kind; wtile_desc(p, tile, src, dst, N, kt, R0, kind);
        const int R = tid >> 3, kg = tid & 7; float f[8];
#pragma unroll
        for (int i = 0; i < 8; ++i) f[i] = lds[q * (64 * 65) + (kg * 8 + i) * 65 + R];
        *(u32x4*)(dst + (size_t)(R0 + R) * DM + kt * 64 + kg * 8) = pack8(f);
      }
    }
    lds_barrier();
  }
}

__device__ void phase0(const Params& p) {
  extern __shared__ __attribute__((aligned(16))) unsigned char smem[];
  float* lds = (float*)smem;
  const int tid = threadIdx.x, wid = tid >> 6, lane = tid & 63, G = gridDim.x;
  {
    f32x4 w[4];
#pragma unroll
    for (int i = 0; i < 4; ++i) w[i] = *(const f32x4*)(p.nw + i * 256 + lane * 4);
#pragma unroll 1
    for (int row = (blockIdx.x * 8 + wid) * 4; row < NT; row += G * 8 * 4) {
      f32x4 v[4][4];
#pragma unroll
      for (int q = 0; q < 4; ++q) { const int r = row + q; const float* xr = r < NTP ? p.x_p + (size_t)r * DM : p.x_s + (size_t)(r - NTP) * DM;
#pragma unroll
        for (int i = 0; i < 4; ++i) v[q][i] = ldnt4(xr + i * 256 + lane * 4); }
#pragma unroll
      for (int q = 0; q < 4; ++q) {
        float ss = 0.f;
#pragma unroll
        for (int i = 0; i < 4; ++i) ss += (v[q][i].x * v[q][i].x + v[q][i].y * v[q][i].y) + (v[q][i].z * v[q][i].z + v[q][i].w * v[q][i].w);
        ss = wave_sum(ss);
        const float rstd = rsqrtf(ss * (1.f / DM) + EPS);
#pragma unroll
        for (int i = 0; i < 4; ++i) { u32x2 o; o.x = pk2(v[q][i].x * rstd * w[i].x, v[q][i].y * rstd * w[i].y); o.y = pk2(v[q][i].z * rstd * w[i].z, v[q][i].w * rstd * w[i].w);
          *(u32x2*)(p.UW + (size_t)(row + q) * DM + i * 256 + lane * 4) = o; }
      }
    }
  }
  convert_tiles(p, blockIdx.x, 2560, G);
  for (int idx = blockIdx.x * 512 + tid; idx < 16 * DM; idx += G * 512) { const int c = idx >> 10, k = idx & 1023; p.WB16[idx] = (bf16_t)(pk2(p.w_in[(size_t)k * NIN + 8192 + c], 0.f) & 0xffffu); }
}

__device__ void phase1(const Params& p) {
  const int G = gridDim.x;
  { extern __shared__ __attribute__((aligned(16))) unsigned char smem[];
    Sched S; S.init_static(NT, 10240, G, blockIdx.x); gemm_phase<0>(p, (LAS unsigned char*)smem, p.UW, DM, p.WIN, S); }
  const int nfull = G == 256 ? 80 : 0, nside = G - nfull, sidx = (int)blockIdx.x - nfull;
  if (sidx >= 0) convert_tiles(p, 2560 + sidx, 2560 + 768, nside);
  const int tid = launder(threadIdx.x), wid = tid >> 6, lane = tid & 63, fr = lane & 15, fq = lane >> 4;
  if (sidx >= 0)
  for (int task = sidx * 8 + wid; task < NT / 16; task += nside * 8) {
    const int base = task * 16; f32x4 acc = {0.f, 0.f, 0.f, 0.f};
    const bf16_t* ap = p.UW + (size_t)(base + fr) * DM + fq * 8; const bf16_t* bp = p.WB16 + fr * DM + fq * 8;
#pragma unroll 8
    for (int ks = 0; ks < 32; ++ks) { const bf16x8 a = *(const bf16x8*)(ap + ks * 32), b = *(const bf16x8*)(bp + ks * 32); acc = __builtin_amdgcn_mfma_f32_16x16x32_bf16(a, b, acc, 0, 0, 0); }
    const int c = fr, h = c & 7; const float na = -__expf(p.a_log[h]), db = p.dt_bias[h];
#pragma unroll
    for (int j = 0; j < 4; ++j) {
      const int tok = base + fq * 4 + j; const float v = acc[j]; float r;
      if (c < 8) r = sigmf(v); else { const float xx = v + db; r = na * (xx > 20.f ? xx : log1pf(__expf(xx))); }
      p.BG[(size_t)tok * 16 + c] = r;
    }
  }
}

DI u32x4 raw_unit_load(const Params& p, int cgi, int h, int u) {
  const int r = u / 48, rem = u % 48, part = rem >> 4, c8 = rem & 15;
  u32x4 v = {0u, 0u, 0u, 0u};
  if (r < 3) { if ((cgi & 31) > 0) v = *(const u32x4*)(p.HALO + ((size_t)(cgi - 1) * 3 + r) * QW + part * 1024 + h * 128 + c8 * 8); }
  else v = *(const u32x4*)(p.QKV + (size_t)(cgi * 64 + r - 3) * QW + part * 1024 + h * 128 + c8 * 8);
  return v;
}
DI int crow(int r, int lh) { return (r & 3) + 8 * (r >> 2) + 4 * lh; }
DI bf16x8 packfrag(const f32x16& x, int s) {
  u32x4 w; w.x = pk2(x[8 * s], x[8 * s + 1]); w.y = pk2(x[8 * s + 2], x[8 * s + 3]); w.z = pk2(x[8 * s + 4], x[8 * s + 5]); w.w = pk2(x[8 * s + 6], x[8 * s + 7]);
  return __builtin_bit_cast(bf16x8, w);
}
DI bf16x8 ld_permk(const bf16_t* rowp, int s, int lh) {
  const u32x2 a = *(const u32x2*)(rowp + 16 * s + 4 * lh), b = *(const u32x2*)(rowp + 16 * s + 8 + 4 * lh);
  u32x4 w; w.x = a.x; w.y = a.y; w.z = b.x; w.w = b.y; return __builtin_bit_cast(bf16x8, w);
}

DI void conv_unit(const Params& p, int part, int c8, int row, const bf16_t* raw, const float* cw, bf16_t* qh, bf16_t* kh, bf16_t* vh, const float* gcs, int T0, int h) {
    f32x2 w2[4][4];
#pragma unroll
    for (int j = 0; j < 4; ++j) { const f32x4 wa = *(const f32x4*)(cw + (part * 4 + j) * 128 + c8 * 8), wb = *(const f32x4*)(cw + (part * 4 + j) * 128 + c8 * 8 + 4);
      w2[j][0] = (f32x2){wa.x, wa.y}; w2[j][1] = (f32x2){wa.z, wa.w}; w2[j][2] = (f32x2){wb.x, wb.y}; w2[j][3] = (f32x2){wb.z, wb.w}; }
    f32x2 a2[2][4];
#pragma unroll
    for (int k = 0; k < 4; ++k) { a2[0][k] = (f32x2){0.f, 0.f}; a2[1][k] = (f32x2){0.f, 0.f}; }
#pragma unroll
    for (int rr = 0; rr < 5; ++rr) {
      const u32x4 xw = *(const u32x4*)(raw + (row + rr) * 392 + part * 128 + c8 * 8);
      f32x2 x2[4]; x2[0] = (f32x2){bflo(xw.x), bfhi(xw.x)}; x2[1] = (f32x2){bflo(xw.y), bfhi(xw.y)}; x2[2] = (f32x2){bflo(xw.z), bfhi(xw.z)}; x2[3] = (f32x2){bflo(xw.w), bfhi(xw.w)};
#pragma unroll
      for (int q = 0; q < 2; ++q) { const int j = rr - q; if (j >= 0 && j < 4) {
#pragma unroll
        for (int k = 0; k < 4; ++k) a2[q][k] = x2[k] * w2[j][k] + a2[q][k]; } }
    }
#pragma unroll
    for (int q = 0; q < 2; ++q) {
      f32x2 s2 = {0.f, 0.f};
#pragma unroll
      for (int k = 0; k < 4; ++k) {
        const f32x2 t = a2[q][k] * (-1.4426950408889634f);
        f32x2 d; d.x = __builtin_amdgcn_exp2f(t.x); d.y = __builtin_amdgcn_exp2f(t.y); d = d + 1.0f;
        f32x2 r; r.x = __builtin_amdgcn_rcpf(d.x); r.y = __builtin_amdgcn_rcpf(d.y);
        a2[q][k] = a2[q][k] * r; s2 = a2[q][k] * a2[q][k] + s2;
      }
      float ss = s2.x + s2.y;
      ss += __shfl_xor(ss, 1); ss += __shfl_xor(ss, 2); ss += __shfl_xor(ss, 4); ss += __shfl_xor(ss, 8);
      if (part < 2) { const float sc = rsqrtf(ss + EPS) * (part == 0 ? 0.08838834764831845f : 1.f);
#pragma unroll
        for (int k = 0; k < 4; ++k) a2[q][k] = a2[q][k] * sc; }
      bf16_t* dstl = part == 0 ? qh : (part == 1 ? kh : vh);
      { u32x4 o; o.x = pk2(a2[q][0].x, a2[q][0].y); o.y = pk2(a2[q][1].x, a2[q][1].y); o.z = pk2(a2[q][2].x, a2[q][2].y); o.w = pk2(a2[q][3].x, a2[q][3].y);
        *(u32x4*)(dstl + (row + q) * 136 + c8 * 8) = o; }
      if (part == 0) { const float eg = __expf(gcs[row + q]);
#pragma unroll
        for (int k = 0; k < 4; ++k) a2[q][k] = a2[q][k] * eg;
        u32x4 o; o.x = pk2(a2[q][0].x, a2[q][0].y); o.y = pk2(a2[q][1].x, a2[q][1].y); o.z = pk2(a2[q][2].x, a2[q][2].y); o.w = pk2(a2[q][3].x, a2[q][3].y);
        *(u32x4*)(p.QKV + (size_t)(T0 + row + q) * QW + h * 128 + c8 * 8) = o; }
    }
  }

DI void chunk_stageA(const Params& p, u32x4 (&pre)[7], float& pg, float& pb, int set, int next_cgi, int next_h, bool has_next) {
  extern __shared__ __attribute__((aligned(16))) unsigned char smem[];
  bf16_t* raw = (bf16_t*)smem;
  float* gcs = (float*)(smem + (set ? 135936 : 129024));
  float* bet = gcs + 64;
  float* rsk = gcs + 128;
  const int tid = launder(threadIdx.x), wid = tid >> 6, lane = tid & 63;
#pragma unroll
  for (int k = 0; k < 7; ++k) { const int u = k * 512 + tid; if (u < 67 * 48) { const int r = u / 48, rem = u % 48; *(u32x4*)(raw + r * 392 + (rem >> 4) * 128 + (rem & 15) * 8) = pre[k]; } }
  if (has_next) {
#pragma unroll
    for (int k = 0; k < 7; ++k) { const int u = k * 512 + tid; if (u < 67 * 48) pre[k] = raw_unit_load(p, next_cgi, next_h, u); }
  }
  if (wid == 7) {
    float g = pg; const float be = pb;
    if (has_next) { pg = p.BG[(size_t)(next_cgi * 64 + lane) * 16 + 8 + next_h]; pb = p.BG[(size_t)(next_cgi * 64 + lane) * 16 + next_h]; }
#pragma unroll
    for (int o = 1; o < 64; o <<= 1) { const float t = __shfl_up(g, o); if (lane >= o) g += t; }
    gcs[lane] = g; bet[lane] = be; rsk[lane] = be * __expf(g);
  }
}

DI void chunk_task(const Params& p, int cgi, int h, int set, u32x4 (&pre)[7], float& pg, float& pb, bool doA, int nn_cgi, int nn_h, bool has_nn) {
  extern __shared__ __attribute__((aligned(16))) unsigned char smem[];
  bf16_t* raw = (bf16_t*)smem;
  bf16_t* qh = (bf16_t*)(smem + 52736);
  bf16_t* kh = (bf16_t*)(smem + 70144);
  bf16_t* vh = (bf16_t*)(smem + 87552);
  float* Mm = (float*)(smem + 104960);
  bf16_t* M10n = (bf16_t*)(smem + 121344);
  bf16_t* Tb = (bf16_t*)(smem + 123904);
  float* gcs = (float*)(smem + (set ? 135936 : 129024));
  float* bet = gcs + 64;
  float* rsk = gcs + 128;
  const float* cw = (const float*)(smem + 129792);
  const int tid = launder(threadIdx.x), wid = tid >> 6, lane = tid & 63;
  const int n = cgi & 31, b = cgi >> 5, T0 = cgi * 64, ci = cgi * 8 + h;
  const float glast = gcs[63];
#pragma unroll 1
  for (int part = 0; part < 2; ++part) conv_unit(p, part, tid & 15, (tid >> 4) * 2, raw, cw, qh, kh, vh, gcs, T0, h);
  if (n == 31) {
    for (int u = tid; u < 3 * 384; u += 512) { const int j = u / 384, cc = u % 384, part = cc >> 7, col = cc & 127;
      p.out[OFF_NCQ_P + ((size_t)b * 3 + j) * QW + part * 1024 + h * 128 + col] = bf2f(raw[(64 + j) * 392 + cc]); }
  }
  lds_barrier();
#define KQ_BLOCK(bidx, isq) do { \
      const int ib = (bidx) >= 6 ? 3 : ((bidx) >= 3 ? 2 : ((bidx) >= 1 ? 1 : 0)), jb = (bidx) - (ib * (ib + 1)) / 2; \
      const bf16_t* Y = (isq) ? qh : kh; \
      const int i = ib * 16 + fr; const float gi = gcs[i], bi = bet[i]; \
      f32x4 d = {0.f, 0.f, 0.f, 0.f}; \
      _Pragma("unroll") for (int ks = 0; ks < 4; ++ks) { \
        const bf16x8 xa = *(const bf16x8*)(kh + (jb * 16 + fr) * 136 + ks * 32 + fq * 8), yb = *(const bf16x8*)(Y + (ib * 16 + fr) * 136 + ks * 32 + fq * 8); \
        d = __builtin_amdgcn_mfma_f32_16x16x32_bf16(xa, yb, d, 0, 0, 0); } \
      const int j0 = jb * 16 + fq * 4; float r[4]; \
      _Pragma("unroll") for (int jj = 0; jj < 4; ++jj) { const int j = j0 + jj; const bool keep = (isq) ? (i >= j) : (i > j); r[jj] = keep ? d[jj] * __expf(gi - gcs[j]) * ((isq) ? 1.f : bi) : 0.f; } \
      if (isq) { u32x2 w; w.x = pk2(r[0], r[1]); w.y = pk2(r[2], r[3]); *(u32x2*)(p.AQK + (size_t)ci * 4096 + i * 64 + j0) = w; } \
      else { \
        *(f32x4*)(Mm + i * 64 + j0) = (f32x4){r[0], r[1], r[2], r[3]}; \
        if (ib >= 2 && jb < 2) { u32x2 w; w.x = pk2(-r[0], -r[1]); w.y = pk2(-r[2], -r[3]); *(u32x2*)(M10n + (i - 32) * 40 + j0) = w; } \
      } } while (0)
  {
    const int fr = lane & 15, fq = lane >> 4;
#pragma unroll 1
    for (int bidx = wid; bidx < 10; bidx += 8) KQ_BLOCK(bidx, false);
  }
  lds_barrier();
  if (wid == 0) {
    const int blk = lane >> 5, c = lane & 31; const float* Mb = Mm + (blk * 32) * 64 + blk * 32;
    float X[32];
    f32x4 mb[2][8];
#pragma unroll
    for (int r = 0; r < 32; ++r) {
      if (r + 1 < 32) {
#pragma unroll
        for (int j4 = 0; j4 < (r + 4) / 4; ++j4) mb[(r + 1) & 1][j4] = *(const f32x4*)(Mb + (r + 1) * 64 + j4 * 4);
      }
      float s0 = (r == c) ? 1.f : 0.f, s1 = 0.f;
#pragma unroll
      for (int j4 = 0; j4 < (r + 3) / 4; ++j4) {
        const f32x4 m = mb[r & 1][j4];
        if (j4 * 4 + 0 < r) s0 -= m.x * X[j4 * 4 + 0];
        if (j4 * 4 + 1 < r) s1 -= m.y * X[j4 * 4 + 1];
        if (j4 * 4 + 2 < r) s0 -= m.z * X[j4 * 4 + 2];
        if (j4 * 4 + 3 < r) s1 -= m.w * X[j4 * 4 + 3];
      }
      X[r] = s0 + s1;
    }
#pragma unroll
    for (int r = 0; r < 32; ++r) Tb[(blk * 32 + r) * 40 + c] = (bf16_t)(pk2(X[r], 0.f) & 0xffffu);
  } else {
    {
      const int fr = lane & 15, fq = lane >> 4;
#pragma unroll 1
      for (int bidx = wid - 1; bidx < 10; bidx += 7) KQ_BLOCK(bidx, true);
      for (int u = wid - 1; u < 6; u += 7) { const int ib = u < 3 ? 0 : (u < 5 ? 1 : 2), jb = u < 3 ? u + 1 : (u < 5 ? u - 1 : 3);
        *(u32x2*)(p.AQK + (size_t)ci * 4096 + (ib * 16 + fr) * 64 + jb * 16 + fq * 4) = (u32x2){0u, 0u}; }
    }
    for (int u = tid - 64; u < 512; u += 448) conv_unit(p, 2, u & 15, (u >> 4) * 2, raw, cw, qh, kh, vh, gcs, T0, h);
    for (int u = tid - 64; u < 1024; u += 448) {
      const int i8 = u & 7, d = u >> 3; float f[8];
#pragma unroll
      for (int e = 0; e < 8; ++e) { const int i = i8 * 8 + e; f[e] = bf2f(kh[i * 136 + d]) * __expf(glast - gcs[i]); }
      *(u32x4*)(p.QKV + (size_t)(T0 + (d >> 1)) * QW + 1024 + h * 128 + (d & 1) * 64 + i8 * 8) = pack8(f);
    }
    if (tid == 64) p.DL[ci] = __expf(glast);
  }
  lds_barrier();
  {
    const int l32 = lane & 31, lh = lane >> 5; const bool isV = wid >= 4;
    const bf16_t* srcl = (isV ? vh : kh) + (wid & 3) * 32 + l32; const float* rs = isV ? bet : rsk;
    bf16x8 r0[2];
#pragma unroll
    for (int s = 0; s < 2; ++s) { float f[8];
#pragma unroll
      for (int e = 0; e < 8; ++e) { const int k = 16 * s + 8 * lh + e; f[e] = bf2f(srcl[k * 136]) * rs[k]; }
      r0[s] = __builtin_bit_cast(bf16x8, pack8(f)); }
    f32x16 x0 = {};
#pragma unroll
    for (int s = 0; s < 2; ++s) x0 = __builtin_amdgcn_mfma_f32_32x32x16_bf16(*(const bf16x8*)(Tb + l32 * 40 + 16 * s + 8 * lh), r0[s], x0, 0, 0, 0);
    f32x16 y1;
#pragma unroll
    for (int r = 0; r < 16; ++r) { const int k = 32 + crow(r, lh); y1[r] = bf2f(srcl[k * 136]) * rs[k]; }
#pragma unroll
    for (int s = 0; s < 2; ++s) y1 = __builtin_amdgcn_mfma_f32_32x32x16_bf16(ld_permk(M10n + l32 * 40, s, lh), packfrag(x0, s), y1, 0, 0, 0);
    f32x16 x1 = {};
#pragma unroll
    for (int s = 0; s < 2; ++s) x1 = __builtin_amdgcn_mfma_f32_32x32x16_bf16(ld_permk(Tb + (32 + l32) * 40, s, lh), packfrag(y1, s), x1, 0, 0, 0);
    const int col = (wid & 3) * 32 + l32;
    if (!isV) {
      bf16_t* wp = p.UW + (size_t)ci * 8192 + col;
#pragma unroll
      for (int r = 0; r < 16; ++r) { const int i = crow(r, lh); wp[i * 128] = (bf16_t)(pk2(-x0[r], 0.f) & 0xffffu); wp[(32 + i) * 128] = (bf16_t)(pk2(-x1[r], 0.f) & 0xffffu); }
    } else {
      bf16_t* up = p.QKV + (size_t)(T0 + (col >> 1)) * QW + 2048 + h * 128 + (col & 1) * 64;
#pragma unroll
      for (int q = 0; q < 4; ++q) {
        u32x2 w0, w1; w0.x = pk2(x0[q * 4], x0[q * 4 + 1]); w0.y = pk2(x0[q * 4 + 2], x0[q * 4 + 3]); w1.x = pk2(x1[q * 4], x1[q * 4 + 1]); w1.y = pk2(x1[q * 4 + 2], x1[q * 4 + 3]);
        *(u32x2*)(up + q * 8 + lh * 4) = w0; *(u32x2*)(up + 32 + q * 8 + lh * 4) = w1;
      }
    }
  }
  if (doA) chunk_stageA(p, pre, pg, pb, set ^ 1, nn_cgi, nn_h, has_nn);
  lds_barrier();
}

__device__ void phase2(const Params& p) {
  const int G = gridDim.x;
  const int tid = launder(threadIdx.x);
  {
    const int c8 = (tid & 127) * 8;
    float w0[8], w1[8], w2[8];
#pragma unroll
    for (int e = 0; e < 8; ++e) { w0[e] = p.caw[c8 + e]; w1[e] = p.caw[DM + c8 + e]; w2[e] = p.caw[2 * DM + c8 + e]; }
#pragma unroll 1
    for (int grp = blockIdx.x * 4 + (tid >> 7); grp < NT / 8; grp += G * 4) {
      const int r0 = grp * 8;
      u32x4 pw[10], gw[8];
#pragma unroll
      for (int k = 0; k < 10; ++k) { const int r = r0 - 2 + k; pw[k] = (u32x4){0u, 0u, 0u, 0u}; if (r >= 0) pw[k] = *(const u32x4*)(p.P + (size_t)r * DM + c8); }
#pragma unroll
      for (int k = 0; k < 8; ++k) gw[k] = *(const u32x4*)(p.GATE + (size_t)(r0 + k) * DM + c8);
#pragma unroll
      for (int k = 0; k < 8; ++k) {
        const int r = r0 + k;
        float cur[8], p1[8], p2[8], g[8];
        unpack8(pw[k + 2], cur); unpack8(pw[k + 1], p1); unpack8(pw[k], p2); unpack8(gw[k], g);
        if (r < NTP) {
          const int t = r & 2047;
          if (t < 1) { for (int e = 0; e < 8; ++e) p1[e] = 0.f; }
          if (t < 2) { for (int e = 0; e < 8; ++e) p2[e] = 0.f; }
          if (t >= 2046) { float* o = p.out + OFF_NCA_P + ((size_t)(r >> 11) * 2 + (t - 2046)) * DM + c8; *(f32x4*)o = (f32x4){cur[0], cur[1], cur[2], cur[3]}; *(f32x4*)(o + 4) = (f32x4){cur[4], cur[5], cur[6], cur[7]}; }
        } else {
          const int bs = (r - NTP) >> 2, t = (r - NTP) & 3;
          const float* past = p.sca + (size_t)bs * 2 * DM + c8;
          if (t < 1) { for (int e = 0; e < 8; ++e) p1[e] = past[DM + e]; }
          if (t < 2) { for (int e = 0; e < 8; ++e) p2[e] = past[(t == 1 ? DM : 0) + e]; }
          if (t >= 2) { float* o = p.out + OFF_NCA_S + ((size_t)bs * 2 + (t - 2)) * DM + c8; *(f32x4*)o = (f32x4){cur[0], cur[1], cur[2], cur[3]}; *(f32x4*)(o + 4) = (f32x4){cur[4], cur[5], cur[6], cur[7]}; }
        }
        float o8[8];
#pragma unroll
        for (int e = 0; e < 8; ++e) o8[e] = g[e] * (w0[e] * p2[e] + w1[e] * p1[e] + w2[e] * cur[e]);
        *(u32x4*)(p.GATE + (size_t)r * DM + c8) = pack8(o8);
      }
    }
  }
  {
    extern __shared__ __attribute__((aligned(16))) unsigned char smem[];
    float* cw = (float*)(smem + 129792);
    const int tid0 = launder(threadIdx.x);
    int cur_h = -1; u32x4 pre[7];
    int task = blockIdx.x;
#pragma unroll
    for (int k = 0; k < 7; ++k) { const int u = k * 512 + tid0; pre[k] = (u32x4){0u, 0u, 0u, 0u}; if (task < 2048 && u < 67 * 48) pre[k] = raw_unit_load(p, task >> 3, task & 7, u); }
    float pg = 0.f, pb = 0.f;
    if (task < 2048 && tid0 >= 448) { pg = p.BG[(size_t)((task >> 3) * 64 + (tid0 & 63)) * 16 + 8 + (task & 7)]; pb = p.BG[(size_t)((task >> 3) * 64 + (tid0 & 63)) * 16 + (task & 7)]; }
    if (task < 2048) { const int nt = task + G; chunk_stageA(p, pre, pg, pb, 0, nt >> 3, nt & 7, nt < 2048); }
    lds_barrier();
    int kidx = 0;
    for (; task < 2048; task += G, ++kidx) {
      const int h = task & 7;
      if (h != cur_h) {
        lds_barrier();
        for (int u = tid0; u < 3 * 4 * 128; u += 512) { const int part = u / 512, j = (u >> 7) & 3, col = u & 127; cw[u] = p.cbw[(size_t)j * QW + part * 1024 + h * 128 + col]; }
        cur_h = h;
        lds_barrier();
      }
      const int nt = task + G, nn = nt + G;
      chunk_task(p, task >> 3, h, kidx & 1, pre, pg, pb, nt < 2048, nn >> 3, nn & 7, nn < 2048);
    }
  }
}

DI void cvt16(f32x16& a, int q, u32x2 w) { a[q * 4 + 0] = bflo(w.x); a[q * 4 + 1] = bfhi(w.x); a[q * 4 + 2] = bflo(w.y); a[q * 4 + 3] = bfhi(w.y); }
__device__ __forceinline__ void scan_seq(const Params& p, int seq) {
  extern __shared__ __attribute__((aligned(16))) unsigned char smem[];
  bf16_t* A1 = (bf16_t*)smem;
  bf16_t* AQ = (bf16_t*)(smem + 34816);
  bf16_t* KT = (bf16_t*)(smem + 44032);
  bf16_t* ST = (bf16_t*)(smem + 62464);
  bf16_t* UT = (bf16_t*)(smem + 97280);
  float* OS = (float*)(smem + 115712);
  const int tid = launder(threadIdx.x), wid = tid >> 6, lane = tid & 63, vb = wid & 3, hw = wid >> 2, l32 = lane & 31, lh = lane >> 5;
  const int b = seq >> 3, h = seq & 7;
  f32x16 S0 = {}, S1 = {};
  for (int i = tid; i < 128 * 136 / 8; i += 512) ((u32x4*)ST)[i] = (u32x4){0u, 0u, 0u, 0u};
  const int v = vb * 32 + l32;
  u32x4 pA[4], pQ, pK[2]; u32x2 pU[8]; float pdl;
  float onw16[16];
  { const int seg = tid & 7;
#pragma unroll
    for (int e = 0; e < 16; ++e) onw16[e] = p.onw[seg * 16 + e]; }
#define SCAN_SRC_A(nn, it) ({ const int ci_ = (b * 32 + (nn)) * 8 + h, T0_ = (b * 32 + (nn)) * 64; const int u_ = (it) * 512 + tid, r_ = u_ >> 4, c_ = (u_ & 15) * 8; \
    (const u32x4*)(r_ < 64 ? p.UW + ((size_t)ci_ * 64 + r_) * 128 + c_ : p.QKV + (size_t)(T0_ + r_ - 64) * QW + h * 128 + c_); })
#define SCAN_LOAD_A(nn) do { _Pragma("unroll") for (int it = 0; it < 4; ++it) pA[it] = *SCAN_SRC_A(nn, it); } while (0)
#define SCAN_LOAD_QK(nn) do { const int ci_ = (b * 32 + (nn)) * 8 + h, T0_ = (b * 32 + (nn)) * 64; \
    { const int r = tid >> 3, c = (tid & 7) * 8; pQ = *(const u32x4*)(p.AQK + (size_t)ci_ * 4096 + r * 64 + c); } \
    _Pragma("unroll") for (int it = 0; it < 2; ++it) { const int u = it * 512 + tid, d = u >> 3, c = (u & 7) * 8; \
      pK[it] = *(const u32x4*)(p.QKV + (size_t)(T0_ + (d >> 1)) * QW + 1024 + h * 128 + (d & 1) * 64 + c); } } while (0)
#define SCAN_LOAD_U(nn) do { const int ci_ = (b * 32 + (nn)) * 8 + h, T0_ = (b * 32 + (nn)) * 64; \
    if (hw == 0) { const bf16_t* base_ = p.QKV + (size_t)(T0_ + (v >> 1)) * QW + 2048 + h * 128 + (v & 1) * 64; \
      _Pragma("unroll") for (int q = 0; q < 4; ++q) { pU[q] = *(const u32x2*)(base_ + q * 8 + lh * 4); pU[4 + q] = *(const u32x2*)(base_ + 32 + q * 8 + lh * 4); } } \
    pdl = p.DL[ci_]; } while (0)
#define SCAN_FILL_A() do { _Pragma("unroll") for (int it = 0; it < 4; ++it) { const int u = it * 512 + tid, r = u >> 4, c = (u & 15) * 8; *(u32x4*)(A1 + r * 136 + c) = pA[it]; } } while (0)
#define SCAN_FILL_QK() do { { const int r = tid >> 3, c = (tid & 7) * 8; *(u32x4*)(AQ + r * 72 + c) = pQ; } \
    _Pragma("unroll") for (int it = 0; it < 2; ++it) { const int u = it * 512 + tid, d = u >> 3, c = (u & 7) * 8; *(u32x4*)(KT + d * 72 + c) = pK[it]; } } while (0)
  SCAN_LOAD_A(0); SCAN_LOAD_QK(0); SCAN_LOAD_U(0);
  SCAN_FILL_A(); SCAN_FILL_QK();
  SCAN_LOAD_A(1); SCAN_LOAD_QK(1);
  lds_barrier();
#pragma unroll 1
  for (int n = 0; n < 32; ++n) {
    const int cgi = b * 32 + n, T0 = cgi * 64;
    f32x16 a0 = {}, a1 = {};
    if (hw == 0) {
#pragma unroll
      for (int q = 0; q < 4; ++q) { cvt16(a0, q, pU[q]); cvt16(a1, q, pU[4 + q]); }
    }
    const float dl = pdl;
    if (n + 1 < 32) SCAN_LOAD_U(n + 1);
    u32x4 zz0, zz1;
    { const int i = tid >> 3, seg = tid & 7; const size_t tok = (size_t)T0 + i; zz0 = *(const u32x4*)(p.SBZ + tok * DM + h * 128 + seg * 16); zz1 = *(const u32x4*)(p.SBZ + tok * DM + h * 128 + seg * 16 + 8); }
#pragma unroll
    for (int ks = 0; ks < 8; ++ks) {
      const bf16x8 bfr = *(const bf16x8*)(ST + v * 136 + ks * 16 + lh * 8);
      const bf16x8 x0 = *(const bf16x8*)(A1 + (hw * 64 + l32) * 136 + ks * 16 + lh * 8), x1 = *(const bf16x8*)(A1 + (hw * 64 + 32 + l32) * 136 + ks * 16 + lh * 8);
      a0 = __builtin_amdgcn_mfma_f32_32x32x16_bf16(x0, bfr, a0, 0, 0, 0);
      a1 = __builtin_amdgcn_mfma_f32_32x32x16_bf16(x1, bfr, a1, 0, 0, 0);
    }
    if (hw == 0) {
#pragma unroll
      for (int q = 0; q < 4; ++q) {
        u32x2 w0, w1; w0.x = pk2(a0[q * 4], a0[q * 4 + 1]); w0.y = pk2(a0[q * 4 + 2], a0[q * 4 + 3]); w1.x = pk2(a1[q * 4], a1[q * 4 + 1]); w1.y = pk2(a1[q * 4 + 2], a1[q * 4 + 3]);
        *(u32x2*)(UT + v * 72 + q * 8 + lh * 4) = w0; *(u32x2*)(UT + v * 72 + 32 + q * 8 + lh * 4) = w1;
      }
    }
    lds_barrier();
    S0 *= dl; S1 *= dl;
#pragma unroll
    for (int ks = 0; ks < 4; ++ks) {
      const bf16x8 bfr = *(const bf16x8*)(UT + v * 72 + ks * 16 + lh * 8);
      if (hw == 1) {
        const bf16x8 x0 = *(const bf16x8*)(AQ + l32 * 72 + ks * 16 + lh * 8), x1 = *(const bf16x8*)(AQ + (32 + l32) * 72 + ks * 16 + lh * 8);
        a0 = __builtin_amdgcn_mfma_f32_32x32x16_bf16(x0, bfr, a0, 0, 0, 0);
        a1 = __builtin_amdgcn_mfma_f32_32x32x16_bf16(x1, bfr, a1, 0, 0, 0);
      }
      const bf16x8 k0 = *(const bf16x8*)(KT + ((2 * hw) * 32 + l32) * 72 + ks * 16 + lh * 8), k1 = *(const bf16x8*)(KT + ((2 * hw + 1) * 32 + l32) * 72 + ks * 16 + lh * 8);
      S0 = __builtin_amdgcn_mfma_f32_32x32x16_bf16(k0, bfr, S0, 0, 0, 0);
      S1 = __builtin_amdgcn_mfma_f32_32x32x16_bf16(k1, bfr, S1, 0, 0, 0);
    }
    if (n + 1 < 32) { SCAN_FILL_A(); if (n + 2 < 32) SCAN_LOAD_A(n + 2); }
#pragma unroll
    for (int q = 0; q < 4; ++q) {
      u32x2 w0, w1; w0.x = pk2(S0[q * 4], S0[q * 4 + 1]); w0.y = pk2(S0[q * 4 + 2], S0[q * 4 + 3]); w1.x = pk2(S1[q * 4], S1[q * 4 + 1]); w1.y = pk2(S1[q * 4 + 2], S1[q * 4 + 3]);
      *(u32x2*)(ST + v * 136 + (2 * hw) * 32 + q * 8 + lh * 4) = w0; *(u32x2*)(ST + v * 136 + (2 * hw + 1) * 32 + q * 8 + lh * 4) = w1;
    }
    if (hw == 1) {
#pragma unroll
      for (int r = 0; r < 16; ++r) { const int i = (r & 3) + 8 * (r >> 2) + 4 * lh; OS[i * 132 + v] = a0[r]; OS[(32 + i) * 132 + v] = a1[r]; }
    }
    lds_barrier();
    {
      const int i = tid >> 3, seg = tid & 7; const float* orow = OS + i * 132 + seg * 16; float o[16]; float ss = 0.f;
#pragma unroll
      for (int e4 = 0; e4 < 4; ++e4) { const f32x4 t = *(const f32x4*)(orow + e4 * 4); o[e4 * 4] = t.x; o[e4 * 4 + 1] = t.y; o[e4 * 4 + 2] = t.z; o[e4 * 4 + 3] = t.w; ss += (t.x * t.x + t.y * t.y) + (t.z * t.z + t.w * t.w); }
      ss += __shfl_xor(ss, 1); ss += __shfl_xor(ss, 2); ss += __shfl_xor(ss, 4);
      const float rstd = rsqrtf(ss * (1.f / 128.f) + EPS);
      const size_t tok = (size_t)T0 + i; float z[16];
      unpack8(zz0, z); unpack8(zz1, z + 8);
#pragma unroll
      for (int e = 0; e < 16; ++e) o[e] = o[e] * rstd * onw16[e] * z[e];
      bf16_t* dst = p.QKV + tok * QW + 2048 + h * 128 + seg * 16;
      *(u32x4*)dst = pack8(o); *(u32x4*)(dst + 8) = pack8(o + 8);
    }
    if (n + 1 < 32) { SCAN_FILL_QK(); if (n + 2 < 32) SCAN_LOAD_QK(n + 2); }
  }
  float* sp = p.out + OFF_ND_P + (size_t)(b * 8 + h) * 16384;
#pragma unroll
  for (int r = 0; r < 16; ++r) { const int dd = (r & 3) + 8 * (r >> 2) + 4 * lh; sp[(size_t)((2 * hw) * 32 + dd) * 128 + v] = S0[r]; sp[(size_t)((2 * hw + 1) * 32 + dd) * 128 + v] = S1[r]; }
  lds_barrier();
}

__device__ __forceinline__ void sample_seq(const Params& p, int s, f32x4 (&Sn)[8], int s_next) {
  extern __shared__ __attribute__((aligned(16))) unsigned char smem[];
  float* qs = (float*)smem;
  float* ks = qs + 512;
  float* vs = ks + 512;
  float* os = vs + 512;
  float* red = os + 512;
  const int tid = launder(threadIdx.x), bs = s >> 3, h = s & 7;
  const size_t Tb = (size_t)NTP + bs * 4;
  const int kg = tid >> 5, vg = tid & 31;
  f32x4 S[8];
#pragma unroll
  for (int kk = 0; kk < 8; ++kk) S[kk] = Sn[kk];
  if (s_next >= 0) { const float* sn = p.sd + ((size_t)s_next * 128 + kg * 8) * 128 + vg * 4;
#pragma unroll
    for (int kk = 0; kk < 8; ++kk) Sn[kk] = ldnt4(sn + kk * 128); }
  float ga[4], be[4];
#pragma unroll
  for (int t = 0; t < 4; ++t) { ga[t] = p.BG[(Tb + t) * 16 + 8 + h]; be[t] = p.BG[(Tb + t) * 16 + h]; }
  u32x4 zt = {0u, 0u, 0u, 0u}; float ow[8];
  { const int t = (tid >> 4) & 3, seg = tid & 15; zt = *(const u32x4*)(p.SBZ + (Tb + t) * DM + h * 128 + seg * 8);
#pragma unroll
    for (int e = 0; e < 8; ++e) ow[e] = p.onw[seg * 8 + e]; }
  if (tid < 192) {
    const int c8 = tid & 15, grp = tid >> 4, part = grp % 3, t = grp / 3;
    const int colw = part * 1024 + h * 128 + c8 * 8;
    float a[8] = {0.f, 0.f, 0.f, 0.f, 0.f, 0.f, 0.f, 0.f};
#pragma unroll
    for (int j = 0; j < 4; ++j) {
      const int e_ = t + j; float x[8];
      if (e_ < 3) { const float* ps = p.scq + ((size_t)bs * 3 + e_) * QW + colw; for (int e = 0; e < 8; ++e) x[e] = ps[e]; }
      else unpack8(*(const u32x4*)(p.QKV + (Tb + e_ - 3) * QW + colw), x);
      const float* w = p.cbw + j * QW + colw;
#pragma unroll
      for (int e = 0; e < 8; ++e) a[e] += x[e] * w[e];
      if (j == 3 && t >= 1) { float* o = p.out + OFF_NCQ_S + ((size_t)bs * 3 + (t - 1)) * QW + colw; for (int e = 0; e < 8; ++e) o[e] = x[e]; }
    }
    float ss = 0.f;
#pragma unroll
    for (int e = 0; e < 8; ++e) { a[e] = siluf(a[e]); ss += a[e] * a[e]; }
    ss += __shfl_xor(ss, 1); ss += __shfl_xor(ss, 2); ss += __shfl_xor(ss, 4); ss += __shfl_xor(ss, 8);
    if (part < 2) { const float sc = rsqrtf(ss + EPS) * (part == 0 ? 0.08838834764831845f : 1.f); for (int e = 0; e < 8; ++e) a[e] *= sc; }
    float* d = (part == 0 ? qs : (part == 1 ? ks : vs)) + t * 128 + c8 * 8;
#pragma unroll
    for (int e = 0; e < 8; ++e) d[e] = a[e];
  }
  lds_barrier();
#pragma unroll
  for (int t = 0; t < 4; ++t) {
    const float a = __expf(ga[t]), beta = be[t];
    f32x4 part = {0.f, 0.f, 0.f, 0.f};
#pragma unroll
    for (int kk = 0; kk < 8; ++kk) { S[kk] *= a; part += S[kk] * ks[t * 128 + kg * 8 + kk]; }
    *(f32x4*)(red + kg * 128 + vg * 4) = part;
    lds_barrier();
    f32x4 r = {0.f, 0.f, 0.f, 0.f};
#pragma unroll
    for (int g2 = 0; g2 < 16; ++g2) r += *(const f32x4*)(red + g2 * 128 + vg * 4);
    const f32x4 dlt = (*(const f32x4*)(vs + t * 128 + vg * 4) - r) * beta;
    f32x4 po = {0.f, 0.f, 0.f, 0.f};
#pragma unroll
    for (int kk = 0; kk < 8; ++kk) { S[kk] += dlt * ks[t * 128 + kg * 8 + kk]; po += S[kk] * qs[t * 128 + kg * 8 + kk]; }
    lds_barrier();
    *(f32x4*)(red + kg * 128 + vg * 4) = po;
    lds_barrier();
    if (tid < 128) { float o = 0.f; for (int g2 = 0; g2 < 16; ++g2) o += red[g2 * 128 + tid]; os[t * 128 + tid] = o; }
    lds_barrier();
  }
  float* so = p.out + OFF_ND_S + ((size_t)s * 128 + kg * 8) * 128 + vg * 4;
#pragma unroll
  for (int kk = 0; kk < 8; ++kk) stnt4(so + kk * 128, S[kk]);
  if (tid < 64) {
    const int t = tid >> 4, seg = tid & 15; float o[8]; float ss = 0.f;
#pragma unroll
    for (int e = 0; e < 8; ++e) { o[e] = os[t * 128 + seg * 8 + e]; ss += o[e] * o[e]; }
    ss += __shfl_xor(ss, 1); ss += __shfl_xor(ss, 2); ss += __shfl_xor(ss, 4); ss += __shfl_xor(ss, 8);
    const float rstd = rsqrtf(ss * (1.f / 128.f) + EPS); float z[8];
    unpack8(zt, z);
#pragma unroll
    for (int e = 0; e < 8; ++e) o[e] = o[e] * rstd * ow[e] * z[e];
    *(u32x4*)(p.QKV + (Tb + t) * QW + 2048 + h * 128 + seg * 8) = pack8(o);
  }
  lds_barrier();
}

__device__ void phase3(const Params& p) {
  const int G = gridDim.x, bid = blockIdx.x;
  const bool split = G > 64;
#ifndef P3_NO_SCAN
  if (!split || bid < 64) for (int seq = bid; seq < 64; seq += (split ? 64 : G)) scan_seq(p, seq);
#endif
  if (!split || bid >= 64) {
    const int wk = split ? bid - 64 : bid, NW = split ? G - 64 : G;
#ifndef P3_NO_GEMM
    { extern __shared__ __attribute__((aligned(16))) unsigned char smem[];
      Sched S; S.init_strided(wk, NW, 264); gemm_phase<1>(p, (LAS unsigned char*)smem, p.GATE, DM, p.WOA, S); }
#endif
#ifndef P3_NO_SAMPLE
    {
      const int n2 = (264 > NW && 264 < 2 * NW) ? 264 - NW : 0, n1 = NW - n2;
      const int s_first = wk < n2 ? 1024 : (wk - n2), s_step = n1, s_end = 1024;
      f32x4 Sn[8];
      if (s_first < s_end) { const int tid_ = launder(threadIdx.x); const float* sn = p.sd + ((size_t)s_first * 128 + (tid_ >> 5) * 8) * 128 + (tid_ & 31) * 4;
#pragma unroll
        for (int kk = 0; kk < 8; ++kk) Sn[kk] = ldnt4(sn + kk * 128); }
      for (int s = s_first; s < s_end; s += s_step) sample_seq(p, s, Sn, s + s_step < s_end ? s + s_step : -1);
    }
#endif
  }
}

__device__ void phase4(const Params& p) {
  extern __shared__ __attribute__((aligned(16))) unsigned char smem[];
  Sched S; S.init_strided(blockIdx.x, gridDim.x, 256); gemm_phase<2>(p, (LAS unsigned char*)smem, p.QKV + 2048, QW, p.WOB, S);
  gemm_tail<2>(p, p.QKV + 2048, QW, p.WOB, 256, 8);
}
__device__ void phase5(const Params& p) {
  extern __shared__ __attribute__((aligned(16))) unsigned char smem[];
  Sched S; S.init_strided(blockIdx.x, gridDim.x, 256);
  gemm_phase<4>(p, (LAS unsigned char*)smem, p.UW, DM, p.WO, S);
  gemm_tail<3>(p, p.UW, DM, p.WO, 256, 8);
}
__device__ void phase6(const Params& p) {
  const int tid = launder(threadIdx.x), wid = tid >> 6, lane = tid & 63, G = gridDim.x;
  f32x4 w[4];
#pragma unroll
  for (int i = 0; i < 4; ++i) w[i] = *(const f32x4*)(p.fnw + i * 256 + lane * 4);
  const int row_lo = (G == 256) ? NTP : 0;
#pragma unroll 1
  for (int row = row_lo + (blockIdx.x * 8 + wid) * 4; row < NT; row += G * 8 * 4) {
    f32x4 v[4][4];
#pragma unroll
    for (int q = 0; q < 4; ++q)
#pragma unroll
      for (int i = 0; i < 4; ++i) v[q][i] = *(const f32x4*)(p.out + (size_t)(row + q) * DM + i * 256 + lane * 4);
#pragma unroll
    for (int q = 0; q < 4; ++q) {
      float ss = 0.f;
#pragma unroll
      for (int i = 0; i < 4; ++i) ss += (v[q][i].x * v[q][i].x + v[q][i].y * v[q][i].y) + (v[q][i].z * v[q][i].z + v[q][i].w * v[q][i].w);
      ss = wave_sum(ss);
      const float rstd = rsqrtf(ss * (1.f / DM) + EPS);
#pragma unroll
      for (int i = 0; i < 4; ++i) *(f32x4*)(p.out + (size_t)(row + q) * DM + i * 256 + lane * 4) = v[q][i] * rstd * w[i];
    }
  }
}

#define XB_TMO      128
#define XB_XCNT(j)  (256  + 64 * (j))
#define XB_XSUB(j)  (1280 + 64 * (j))
#define XB_XGEN(j)  (2304 + 64 * (j))
#define XB_TOP      3328
#define XB_TOPGEN   3392
#define XCD_BAR_WORDS 3456
#define XB_SPIN_CAP (1u << 18)
DI unsigned xb_ld(unsigned* p) { return __hip_atomic_load(p, __ATOMIC_RELAXED, __HIP_MEMORY_SCOPE_AGENT); }
DI unsigned xb_add(unsigned* p, unsigned v) { return __hip_atomic_fetch_add(p, v, __ATOMIC_RELAXED, __HIP_MEMORY_SCOPE_AGENT); }
DI unsigned xb_xcc_id() { return (unsigned)__builtin_amdgcn_s_getreg((3 << 11) | 20) & 0xFu; }
#define XB_SPIN(cond, bar) do { unsigned _sp = 0; while (cond) { __builtin_amdgcn_s_sleep(1); \
    if ((++_sp & 255u) == 0u) { if (xb_ld(&(bar)[XB_TMO])) break; if (_sp > XB_SPIN_CAP) { atomicAdd(&(bar)[XB_TMO], 1u); break; } } } } while (0)
struct XcdBarrier { unsigned* bar; unsigned x; volatile LAS unsigned* st; };
DI XcdBarrier xcd_barrier_post(unsigned* bar, volatile LAS unsigned* st) {
  XcdBarrier b; b.bar = bar; b.x = xb_xcc_id(); b.st = st;
  if (threadIdx.x == 0) (void)xb_add(&bar[XB_XCNT(b.x)], 1u);
  return b;
}
DI void xcd_barrier_complete(unsigned* bar, unsigned x, unsigned& nloc, unsigned& nx) {
  const unsigned G = gridDim.x * gridDim.y * gridDim.z;
  unsigned sum, cnt, mine, sp = 0u;
  for (;;) {
    sum = 0u; cnt = 0u; mine = 0u;
#pragma unroll
    for (unsigned j = 0; j < 16; ++j) { const unsigned c = xb_ld(&bar[XB_XCNT(j)]); sum += c; cnt += (c > 0u) ? 1u : 0u; mine = (j == x) ? c : mine; }
    if (sum == G) break;
    __builtin_amdgcn_s_sleep(1);
    if ((++sp & 255u) == 0u) { if (xb_ld(&bar[XB_TMO])) break; if (sp > XB_SPIN_CAP) { atomicAdd(&bar[XB_TMO], 1u); break; } }
  }
  nloc = mine > 0u ? mine : 1u; nx = cnt > 0u ? cnt : 1u;
}
DI void xcd_barrier(const XcdBarrier& b) {
  asm volatile("s_waitcnt vmcnt(0)" ::: "memory");
  __syncthreads();
  if (threadIdx.x == 0) {
    unsigned* bar = b.bar;
    __builtin_amdgcn_s_waitcnt(0);
    unsigned nloc = b.st[0], nx = b.st[1];
    if (nloc == 0u) { xcd_barrier_complete(bar, b.x, nloc, nx); b.st[0] = nloc; b.st[1] = nx; }
    const unsigned old = xb_add(&bar[XB_XSUB(b.x)], 1u);
    const unsigned gen = old / nloc;
    if (old + 1u == (gen + 1u) * nloc) {
      __builtin_amdgcn_fence(__ATOMIC_RELEASE, "agent");
      asm volatile("s_waitcnt vmcnt(0)" ::: "memory");
      const unsigned og = xb_add(&bar[XB_TOP], 1u);
      const unsigned tg = og / nx;
      if (og + 1u == (tg + 1u) * nx) xb_add(&bar[XB_TOPGEN], 1u);
      else XB_SPIN(xb_ld(&bar[XB_TOPGEN]) == tg, bar);
      __builtin_amdgcn_fence(__ATOMIC_ACQUIRE, "agent");
      xb_add(&bar[XB_XGEN(b.x)], 1u);
      asm volatile("s_waitcnt vmcnt(0)" ::: "memory");
    } else {
      XB_SPIN(xb_ld(&bar[XB_XGEN(b.x)]) == gen, bar);
      __builtin_amdgcn_fence(__ATOMIC_ACQUIRE, "agent");
      asm volatile("s_waitcnt vmcnt(0)" ::: "memory");
    }
  }
  __syncthreads();
}

__global__ void __launch_bounds__(512, 2) mega(Params p, int ph_lo, int ph_hi) {
  cg::grid_group grid = cg::this_grid();
  const int lo = ph_lo, hi = ph_hi;
  extern __shared__ __attribute__((aligned(16))) unsigned char smem[];
  volatile LAS unsigned* st = (volatile LAS unsigned*)((LAS unsigned char*)smem + 149504);
  if (threadIdx.x < 4) st[threadIdx.x] = 0u;
  __syncthreads();
  XcdBarrier xb; xb.bar = p.bar; xb.x = 0; xb.st = st;
  if (hi - lo > 1) xb = xcd_barrier_post(p.bar, st);
  if (hi > 100) grid.sync();
#define GRID_SYNC() xcd_barrier(xb)
#define IN(k) (lo <= (k) && (k) < hi)
#define BOTH(k) (IN(k) && IN((k) + 1))
  if (IN(0)) { phase0(p); if (BOTH(0)) GRID_SYNC(); }
  if (IN(1)) { phase1(p); if (BOTH(1)) GRID_SYNC(); }
  if (IN(2)) { phase2(p); if (BOTH(2)) GRID_SYNC(); }
  if (IN(3)) { phase3(p); if (BOTH(3)) GRID_SYNC(); }
  if (IN(4)) { phase4(p); if (BOTH(4)) GRID_SYNC(); }
  if (IN(5)) { phase5(p); if (BOTH(5)) GRID_SYNC(); }
  if (IN(6)) { phase6(p); }
}

extern "C" void kernel_launch(void* const* d_in, const int* in_sizes, int n_in, void* d_out, int out_size, void* d_ws, size_t ws_size, hipStream_t stream) {
  static int grid = 0;
  if (grid == 0) {
    int dev = 0, cus = 0, per_cu = 0;
    hipGetDevice(&dev);
    hipDeviceGetAttribute(&cus, hipDeviceAttributeMultiprocessorCount, dev);
    if (hipFuncSetAttribute((const void*)mega, hipFuncAttributeMaxDynamicSharedMemorySize, LDS_BYTES) != hipSuccess) fprintf(stderr, "hipFuncSetAttribute failed\n");
    hipOccupancyMaxActiveBlocksPerMultiprocessor(&per_cu, (const void*)mega, 512, LDS_BYTES);
    if (per_cu < 1) { fprintf(stderr, "occupancy query says %d\n", per_cu); per_cu = 1; }
    (void)hipGetLastError();
    grid = cus;
  }
  Params p{};
  p.x_p = (const float*)d_in[0]; p.x_s = (const float*)d_in[1]; p.sca = (const float*)d_in[2]; p.scq = (const float*)d_in[3]; p.sd = (const float*)d_in[4];
  p.w_in = (const float*)d_in[5]; p.caw = (const float*)d_in[6]; p.cbw = (const float*)d_in[7]; p.a_log = (const float*)d_in[8]; p.dt_bias = (const float*)d_in[9];
  p.onw = (const float*)d_in[10]; p.w_oa = (const float*)d_in[11]; p.w_ob = (const float*)d_in[12]; p.w_o = (const float*)d_in[13]; p.nw = (const float*)d_in[14]; p.fnw = (const float*)d_in[15];
  p.out = (float*)d_out;
  unsigned char* ws = (unsigned char*)d_ws; size_t o = 0;
  auto take = [&](size_t bytes) { unsigned char* r = ws + o; o += (bytes + 255) & ~(size_t)255; return r; };
  p.QKV = (bf16_t*)take((size_t)NT * QW * 2);
  p.SBZ = (bf16_t*)take((size_t)NT * DM * 2);
  p.GATE = (bf16_t*)take((size_t)NT * DM * 2);
  p.UW = (bf16_t*)take((size_t)NT * DM * 2);
  p.AQK = (bf16_t*)take((size_t)2048 * 4096 * 2);
  p.WOA = (bf16_t*)take((size_t)DM * DM * 2); p.WOB = (bf16_t*)take((size_t)DM * DM * 2); p.WO = (bf16_t*)take((size_t)DM * DM * 2);
  p.WB16 = (bf16_t*)take(16 * DM * 2);
  p.BG = (float*)take((size_t)NT * 16 * 4);
  p.DL = (float*)take(2048 * 4);
  p.bar = (unsigned*)take((XCD_BAR_WORDS + 64 * 64) * 4);
  p.RS = (float*)take(64 * 4 * 256 * 4);
  if (o > ws_size) { fprintf(stderr, "workspace too small: need %zu have %zu\n", o, ws_size); return; }
  p.SGA = (bf16_t*)d_out; p.SGB = p.SGA + (size_t)NT * DM;
  unsigned char* nds = (unsigned char*)((float*)d_out + OFF_ND_S);
  p.WIN = (bf16_t*)nds; p.P = (bf16_t*)(nds + (size_t)10240 * DM * 2); p.HALO = (bf16_t*)(nds + (size_t)10240 * DM * 2 + (size_t)NT * DM * 2);
#if COOP
  if (hipMemsetAsync(p.bar, 0, (XCD_BAR_WORDS + 64 * 64) * 4, stream) != hipSuccess) fprintf(stderr, "memset of barrier words failed\n");
  int lo = 0, hi = 7; void* args[] = {&p, &lo, &hi};
  hipError_t e = hipLaunchCooperativeKernel((const void*)mega, dim3(grid), dim3(512), args, LDS_BYTES, stream);
  if (e != hipSuccess) fprintf(stderr, "cooperative launch failed: %s\n", hipGetErrorString(e));
#else
  for (int ph = 0; ph < 7; ++ph) { hipLaunchKernelGGL(mega, dim3(grid), dim3(512), LDS_BYTES, stream, p, ph, ph + 1); if (ph == DUP) hipLaunchKernelGGL(mega, dim3(grid), dim3(512), LDS_BYTES, stream, p, ph, ph + 1); }
#endif
}
```

```cpp
#include <hip/hip_runtime.h>
#include <hip/hip_cooperative_groups.h>
#include <cstdio>
#include <cstdint>
namespace cg = cooperative_groups;

#ifndef COOP
#define COOP 1
#endif
#ifndef DUP
#define DUP -1
#endif

typedef unsigned short bf16_t;
typedef short bf16x8 __attribute__((ext_vector_type(8)));
typedef float f32x4 __attribute__((ext_vector_type(4)));
typedef float f32x2 __attribute__((ext_vector_type(2)));
typedef float f32x16 __attribute__((ext_vector_type(16)));
typedef unsigned u32x4 __attribute__((ext_vector_type(4)));
typedef unsigned u32x2 __attribute__((ext_vector_type(2)));
typedef __bf16 bf16x2_t __attribute__((ext_vector_type(2)));

#define DI __device__ __forceinline__

constexpr int NT = 16896, NTP = 16384, DM = 1024, QW = 3072, NIN = 10256;
constexpr float EPS = 1e-6f;
constexpr size_t OFF_NCA_P = 17301504, OFF_NCQ_P = 17317888, OFF_ND_P = 17391616, OFF_NCA_S = 18440192, OFF_NCQ_S = 18702336, OFF_ND_S = 19881984;
constexpr int LDS_BYTES = 154112 + 16;

struct Params {
  const float *x_p, *x_s, *sca, *scq, *sd, *w_in, *caw, *cbw, *a_log, *dt_bias, *onw, *w_oa, *w_ob, *w_o, *nw, *fnw;
  float* out;
  bf16_t *QKV, *SBZ, *GATE, *UW, *AQK, *WOA, *WOB, *WO, *WB16;
  float *BG, *DL;
  bf16_t *SGA, *SGB, *WIN, *P, *HALO;
  unsigned* bar;
  float* RS;
};

DI unsigned pk2(float a, float b) { bf16x2_t v = __builtin_convertvector((f32x2){a, b}, bf16x2_t); return __builtin_bit_cast(unsigned, v); }
DI float bflo(unsigned w) { return __uint_as_float(w << 16); }
DI float bfhi(unsigned w) { return __uint_as_float(w & 0xffff0000u); }
DI float bf2f(bf16_t v) { return __uint_as_float(((unsigned)v) << 16); }
DI float siluf(float x) { return x * __builtin_amdgcn_rcpf(1.f + __expf(-x)); }
DI float sigmf(float x) { return __builtin_amdgcn_rcpf(1.f + __expf(-x)); }
DI f32x4 ldnt4(const float* q) { return __builtin_nontemporal_load((const f32x4*)q); }
DI void stnt4(float* q, f32x4 v) { __builtin_nontemporal_store(v, (f32x4*)q); }
DI float wave_sum(float v) {
#pragma unroll
  for (int o = 1; o < 64; o <<= 1) v += __shfl_xor(v, o);
  return v;
}
DI void unpack8(u32x4 w, float* f) { f[0] = bflo(w.x); f[1] = bfhi(w.x); f[2] = bflo(w.y); f[3] = bfhi(w.y); f[4] = bflo(w.z); f[5] = bfhi(w.z); f[6] = bflo(w.w); f[7] = bfhi(w.w); }
DI u32x4 pack8(const float* f) { u32x4 w; w.x = pk2(f[0], f[1]); w.y = pk2(f[2], f[3]); w.z = pk2(f[4], f[5]); w.w = pk2(f[6], f[7]); return w; }

DI int perm32(int rho) { const int n = rho >> 4, i = rho & 15; return 8 * (i >> 2) + 4 * n + (i & 3); }
DI int colmap_in(int R) {
  const int pn = R >> 8, l = R & 255, bj = l >> 7, wc = (l & 127) >> 5, rho = l & 31;
  if (pn < 16) { const int n = rho >> 4, i = rho & 15; return (bj * 2 + n) * 1024 + 64 * pn + wc * 16 + i; }
  const int base = pn < 32 ? 4096 + (pn - 16) * 256 : 8208 + (pn - 32) * 256;
  return base + bj * 128 + wc * 32 + perm32(rho);
}
DI int colmap_sq(int R) { return (R & ~31) + perm32(R & 31); }

constexpr int BM = 256, BK = 64, HALF = 128, NXCD = 8, WGM = 8, HT = HALF * BK;
DI void lds_barrier() { asm volatile("s_waitcnt lgkmcnt(0)" ::: "memory"); __builtin_amdgcn_s_barrier(); asm volatile("" ::: "memory"); }
DI int launder(int x) { asm volatile("" : "+v"(x)); return x; }
DI int lds_byte(int r, int c) { const int st = (r >> 4) * 2 + (c >> 5), rr = r & 15, cc = c & 31, ob = rr * 64 + cc * 2; return st * 1024 + (ob ^ (((ob >> 9) & 1) << 5)); }
DI void stage_rc(int b, int& R, int& C) { const int st = b / 1024, sb = b % 1024, swz = sb ^ (((sb >> 9) & 1) << 5); R = (st >> 1) * 16 + swz / 64; C = (st & 1) * 32 + (swz % 64) / 2; }

struct TileOrder {
  int nM, nN, nwg, G, c;
  DI void init(int M, int N, int G_, int c_) { nM = M / BM; nN = N / BM; nwg = nM * nN; G = G_; c = c_; }
  DI bool next(int i, int& pm, int& pn) const {
    const long L = (long)i * G + c; if (L >= nwg) return false;
    int wgid = (int)L; { const int q = nwg / NXCD, r = nwg % NXCD, xcd = wgid % NXCD, off = wgid / NXCD; wgid = (xcd < r ? xcd * (q + 1) : r * (q + 1) + (xcd - r) * q) + off; }
    const int nig = WGM * nN, gid = wgid / nig, fm = gid * WGM, gsz = (nM - fm) < WGM ? (nM - fm) : WGM;
    pm = fm + ((wgid % nig) % gsz); pn = (wgid % nig) / gsz; return true;
  }
};

#define FN_CNT(pm) (XCD_BAR_WORDS_C + 64 * (pm))
constexpr int XCD_BAR_WORDS_C = 3456;
DI void epilogue_final(const Params& p, f32x4 (&acc)[2][2][4][2], int pm, int pn, int wr, int wc, int fr, int fq, unsigned char* smem_, int tid) {
  float* PS = (float*)(smem_ + 131072);
  float* RSTD = (float*)(smem_ + 131072 + 4096);
  const int col0 = pn * BM + wc * 32 + 8 * fq;
#pragma unroll
  for (int ai = 0; ai < 2; ++ai)
#pragma unroll
    for (int m = 0; m < 4; ++m) {
      const int rl = ai * HALF + wr * 64 + m * 16 + fr; const size_t row = (size_t)pm * BM + rl;
      const float* xr = p.x_p + row * DM;
      float ss = 0.f;
#pragma unroll
      for (int bj = 0; bj < 2; ++bj) {
        const f32x4 x0 = ldnt4(xr + col0 + bj * HALF), x1 = ldnt4(xr + col0 + bj * HALF + 4);
        acc[ai][bj][m][0] += x0; acc[ai][bj][m][1] += x1;
        const f32x4 a = acc[ai][bj][m][0], b = acc[ai][bj][m][1];
        ss += (a.x * a.x + a.y * a.y) + (a.z * a.z + a.w * a.w) + (b.x * b.x + b.y * b.y) + (b.z * b.z + b.w * b.w);
      }
      ss += __shfl_xor(ss, 16); ss += __shfl_xor(ss, 32);
      if (fq == 0) PS[rl * 4 + wc] = ss;
      __builtin_amdgcn_sched_barrier(0);
    }
  lds_barrier();
  unsigned* cnt = p.bar + FN_CNT(pm);
  if (tid < 256) {
    const f32x4 s4 = *(const f32x4*)(PS + tid * 4);
    __hip_atomic_store((unsigned*)p.RS + ((size_t)(pm * 4 + pn) * 256 + tid), __float_as_uint((s4.x + s4.y) + (s4.z + s4.w)), __ATOMIC_RELAXED, __HIP_MEMORY_SCOPE_AGENT);
  }
  asm volatile("s_waitcnt vmcnt(0)" ::: "memory");
  lds_barrier();
  if (tid == 0) __hip_atomic_fetch_add(cnt, 1u, __ATOMIC_RELAXED, __HIP_MEMORY_SCOPE_AGENT);
  if (tid < 64) {
    unsigned sp = 0;
    while ((unsigned)__builtin_amdgcn_readfirstlane(__hip_atomic_load(cnt, __ATOMIC_RELAXED, __HIP_MEMORY_SCOPE_AGENT)) < 4u) { __builtin_amdgcn_s_sleep(2); if (++sp > (1u << 20)) break; }
    __builtin_amdgcn_fence(__ATOMIC_ACQUIRE, "agent");
  }
  asm volatile("s_waitcnt vmcnt(0) lgkmcnt(0)" ::: "memory");
  lds_barrier();
  if (tid < 256) {
    float tot = 0.f;
#pragma unroll
    for (int t = 0; t < 4; ++t) tot += __uint_as_float(__hip_atomic_load((unsigned*)p.RS + ((size_t)(pm * 4 + t) * 256 + tid), __ATOMIC_RELAXED, __HIP_MEMORY_SCOPE_AGENT));
    RSTD[tid] = rsqrtf(tot * (1.f / DM) + EPS);
  }
  lds_barrier();
#pragma unroll
  for (int bj = 0; bj < 2; ++bj) {
    const f32x4 fw0 = *(const f32x4*)(p.fnw + col0 + bj * HALF), fw1 = *(const f32x4*)(p.fnw + col0 + bj * HALF + 4);
#pragma unroll
    for (int ai = 0; ai < 2; ++ai)
#pragma unroll
      for (int m = 0; m < 4; ++m) {
        const int rl = ai * HALF + wr * 64 + m * 16 + fr; const size_t row = (size_t)pm * BM + rl; const float r = RSTD[rl];
        float* o = p.out + row * DM + col0 + bj * HALF;
        stnt4(o, acc[ai][bj][m][0] * r * fw0); stnt4(o + 4, acc[ai][bj][m][1] * r * fw1);
        __builtin_amdgcn_sched_barrier(0);
      }
  }
}

template <int EPI>
DI void epilogue(const Params& p, const f32x4 (&acc)[2][2][4][2], int pm, int pn, int wr, int wc, int fr, int fq) {
  const int row0 = pm * BM + wr * 64 + fr;
  if (EPI == 0) {
    if (pn < 16) {
      const int ch = pn * 64 + wc * 16 + fq * 4;
#pragma unroll
      for (int ai = 0; ai < 2; ++ai)
#pragma unroll
        for (int m = 0; m < 4; ++m) {
          const size_t row = row0 + ai * HALF + m * 16;
          const f32x4 b = acc[ai][0][m][0], c = acc[ai][0][m][1], h = acc[ai][1][m][0], z = acc[ai][1][m][1];
          u32x2 pp, gg;
          pp.x = pk2(c[0] * h[0], c[1] * h[1]); pp.y = pk2(c[2] * h[2], c[3] * h[3]);
          gg.x = pk2(siluf(z[0]) * b[0], siluf(z[1]) * b[1]); gg.y = pk2(siluf(z[2]) * b[2], siluf(z[3]) * b[3]);
          *(u32x2*)(p.P + row * DM + ch) = pp;
          *(u32x2*)(p.GATE + row * DM + ch) = gg;
        }
    } else {
      const int kind = pn < 28 ? 0 : (pn < 32 ? 1 : 2);
      bf16_t* dst; int ld, colt;
      if (kind == 0) { dst = p.QKV; ld = QW; colt = (pn - 16) * 256; }
      else if (kind == 1) { dst = p.SBZ; ld = DM; colt = (pn - 28) * 256; }
      else { dst = pn < 36 ? p.SGA : p.SGB; ld = DM; colt = ((pn - 32) & 3) * 256; }
      const int col0 = colt + wc * 32 + 8 * fq;
#pragma unroll
      for (int ai = 0; ai < 2; ++ai)
#pragma unroll
        for (int m = 0; m < 4; ++m) {
          const int row = row0 + ai * HALF + m * 16;
#pragma unroll
          for (int bj = 0; bj < 2; ++bj) {
            f32x4 v0 = acc[ai][bj][m][0], v1 = acc[ai][bj][m][1];
            if (kind == 1) { for (int j = 0; j < 4; ++j) { v0[j] = siluf(v0[j]); v1[j] = siluf(v1[j]); } }
            if (kind == 2) { for (int j = 0; j < 4; ++j) { v0[j] = sigmf(v0[j]); v1[j] = sigmf(v1[j]); } }
            u32x4 w; w.x = pk2(v0[0], v0[1]); w.y = pk2(v0[2], v0[3]); w.z = pk2(v1[0], v1[1]); w.w = pk2(v1[2], v1[3]);
            *(u32x4*)(dst + (size_t)row * ld + col0 + bj * HALF) = w;
            if (kind == 0 && row < NTP && (row & 63) >= 61)
              *(u32x4*)(p.HALO + ((size_t)(row >> 6) * 3 + ((row & 63) - 61)) * QW + col0 + bj * HALF) = w;
          }
        }
    }
  } else {
    const int col0 = pn * BM + wc * 32 + 8 * fq;
#pragma unroll
    for (int ai = 0; ai < 2; ++ai)
#pragma unroll
      for (int m = 0; m < 4; ++m) {
        const size_t row = row0 + ai * HALF + m * 16;
#pragma unroll
        for (int bj = 0; bj < 2; ++bj) {
          const f32x4 v0 = acc[ai][bj][m][0], v1 = acc[ai][bj][m][1];
          const size_t o = row * DM + col0 + bj * HALF;
          if (EPI == 1) {
            float s[8]; unpack8(*(const u32x4*)(p.SGA + o), s);
            u32x4 w; w.x = pk2(s[0] * v0[0], s[1] * v0[1]); w.y = pk2(s[2] * v0[2], s[3] * v0[3]); w.z = pk2(s[4] * v1[0], s[5] * v1[1]); w.w = pk2(s[6] * v1[2], s[7] * v1[3]);
            *(u32x4*)(p.SGA + o) = w;
          } else if (EPI == 2) {
            float s[8], a[8]; unpack8(*(const u32x4*)(p.SGB + o), s); unpack8(*(const u32x4*)(p.SGA + o), a);
            u32x4 w; w.x = pk2(a[0] + s[0] * v0[0], a[1] + s[1] * v0[1]); w.y = pk2(a[2] + s[2] * v0[2], a[3] + s[3] * v0[3]);
            w.z = pk2(a[4] + s[4] * v1[0], a[5] + s[5] * v1[1]); w.w = pk2(a[6] + s[6] * v1[2], a[7] + s[7] * v1[3]);
            *(u32x4*)(p.UW + o) = w;
          } else {
            const float* xr = row < NTP ? p.x_p + row * DM : p.x_s + (row - NTP) * DM;
            const f32x4 x0 = *(const f32x4*)(xr + col0 + bj * HALF), x1 = *(const f32x4*)(xr + col0 + bj * HALF + 4);
            *(f32x4*)(p.out + o) = x0 + v0; *(f32x4*)(p.out + o + 4) = x1 + v1;
          }
        }
      }
  }
}

#define LAS __attribute__((address_space(3)))
struct Sched {
  int mode, nM, nN, nwg, G, c, start, stride, count;
  DI void init_static(int M, int N, int G_, int c_) { mode = 0; nM = M / BM; nN = N / BM; nwg = nM * nN; G = G_; c = c_; start = stride = count = 0; }
  DI void init_strided(int start_, int stride_, int count_) { mode = 1; start = start_; stride = stride_; count = count_; nM = nN = nwg = G = c = 0; }
  DI bool next(int i, int& pm, int& pn) const {
    if (mode == 0) {
      const long L = (long)i * G + c; if (L >= nwg) return false;
      int wgid = (int)L; { const int q = nwg / NXCD, r = nwg % NXCD, xcd = wgid % NXCD, off = wgid / NXCD; wgid = (xcd < r ? xcd * (q + 1) : r * (q + 1) + (xcd - r) * q) + off; }
      const int nig = WGM * nN, gid = wgid / nig, fm = gid * WGM, gsz = (nM - fm) < WGM ? (nM - fm) : WGM;
      pm = fm + ((wgid % nig) % gsz); pn = (wgid % nig) / gsz; return true;
    }
    const int t = start + i * stride; if (t >= count) return false;
    pm = t >> 2; pn = t & 3; return true;
  }
};

template <int EPI>
DI void gemm_phase(const Params& p, LAS unsigned char* lds, const bf16_t* A, int lda, const bf16_t* Bt, const Sched& S) {
  constexpr int K = 1024, nt = K / BK, HTB = HALF * BK * 2;
  const int tid = launder(threadIdx.x), wid = __builtin_amdgcn_readfirstlane(tid >> 6), lane = tid & 63, wr = wid >> 2, wc = wid & 3, fr = lane & 15, fq = lane >> 4;
  unsigned voffA[2], voffB[2];
#pragma unroll
  for (int i = 0; i < 2; ++i) { int R, C; stage_rc(tid * 16 + i * 8192, R, C); voffA[i] = (unsigned)(R * lda + C) * 2u; voffB[i] = (unsigned)(R * K + C) * 2u; }
  const size_t kstep = (size_t)(BK * 2);
  const size_t hstepA = (size_t)HALF * lda * 2, tstepA = 2 * hstepA, hstepB = (size_t)HALF * K * 2, tstepB = 2 * hstepB;
  const unsigned ldsw = (unsigned)wid * 1024u;
  const int aoff = lds_byte(wr * 64 + fr, fq * 8), boff = lds_byte(wc * 32 + fr, fq * 8);
#define PG8_SA(b, h) (((b) * 2 + (h)) * HTB)
#define PG8_SB(b, h) ((4 + (b) * 2 + (h)) * HTB)
#define PG8_STAGE(bufoff, gbase, voff) do { _Pragma("unroll") for (int _i = 0; _i < 2; ++_i) \
    __builtin_amdgcn_global_load_lds((const unsigned*)((const char*)(gbase) + (voff)[_i]), (LAS unsigned*)(lds + (bufoff) + ldsw + _i * 8192), 16, 0, 0); } while (0)
#define PG8_LDA(dst, b, h) do { _Pragma("unroll") for (int m = 0; m < 4; ++m) _Pragma("unroll") for (int k = 0; k < 2; ++k) dst[m][k] = *(const LAS bf16x8*)(lds + PG8_SA(b, h) + aoff + m * 2048 + k * 1024); } while (0)
#define PG8_LDB(dst, b, h) do { _Pragma("unroll") for (int n = 0; n < 2; ++n) _Pragma("unroll") for (int k = 0; k < 2; ++k) dst[n][k] = *(const LAS bf16x8*)(lds + PG8_SB(b, h) + boff + n * 2048 + k * 1024); } while (0)
#define PG8_MMA(ai, bj, At, Bt_) do { __builtin_amdgcn_s_setprio(1); _Pragma("unroll") for (int m = 0; m < 4; ++m) _Pragma("unroll") for (int n = 0; n < 2; ++n) _Pragma("unroll") for (int k = 0; k < 2; ++k) \
    acc[ai][bj][m][n] = __builtin_amdgcn_mfma_f32_16x16x32_bf16(Bt_[n][k], At[m][k], acc[ai][bj][m][n], 0, 0, 0); __builtin_amdgcn_s_setprio(0); } while (0)
#define PG8_WAIT_V(n) asm volatile("s_waitcnt vmcnt(" #n ")" ::: "memory")
#define PG8_WAIT_L(n) asm volatile("s_waitcnt lgkmcnt(" #n ")" ::: "memory")
#define PG8_BAR __builtin_amdgcn_s_barrier()
#define PG8_SCHED __builtin_amdgcn_sched_barrier(0)
  int cpm, cpn, npm = 0, npn = 0; int ui = 0;
  if (!S.next(0, cpm, cpn)) return;
  f32x4 acc[2][2][4][2];
#pragma unroll
  for (int a = 0; a < 2; ++a)
#pragma unroll
    for (int b = 0; b < 2; ++b)
#pragma unroll
      for (int m = 0; m < 4; ++m)
#pragma unroll
        for (int n = 0; n < 2; ++n) acc[a][b][m][n] = (f32x4){0.f, 0.f, 0.f, 0.f};
  bf16x8 At[4][2], B0[2][2], B1[2][2];
  const char* cA = (const char*)A + (size_t)cpm * tstepA; const char* cB = (const char*)Bt + (size_t)cpn * tstepB;
  PG8_STAGE(PG8_SB(0, 0), cB, voffB); PG8_STAGE(PG8_SB(0, 1), cB + hstepB, voffB); PG8_STAGE(PG8_SA(0, 0), cA, voffA); PG8_STAGE(PG8_SA(0, 1), cA + hstepA, voffA);
  if (wr == 1) PG8_BAR;
  PG8_WAIT_V(2); PG8_BAR;
  PG8_STAGE(PG8_SB(1, 0), cB + kstep, voffB); PG8_STAGE(PG8_SA(1, 0), cA + kstep, voffA); PG8_STAGE(PG8_SB(1, 1), cB + hstepB + kstep, voffB);
  PG8_WAIT_V(6); PG8_BAR;
  for (;;) {
    const bool has_next = S.next(ui + 1, npm, npn);
    const char* nA = has_next ? (const char*)A + (size_t)npm * tstepA : cA; const char* nB = has_next ? (const char*)Bt + (size_t)npn * tstepB : cB;
#pragma unroll 1
    for (int t = 0; t < nt; t += 2) {
      const bool last = (t == nt - 2);
      const char* a1 = cA + (size_t)(t + 1) * kstep;
      const char* a2 = last ? nA : cA + (size_t)(t + 2) * kstep; const char* b2 = last ? nB : cB + (size_t)(t + 2) * kstep;
      const char* a3 = a2 + kstep; const char* b3 = b2 + kstep;
      PG8_LDB(B0, 0, 0); PG8_LDB(B1, 0, 1); PG8_SCHED; PG8_LDA(At, 0, 0); PG8_STAGE(PG8_SA(1, 1), a1 + hstepA, voffA);
      PG8_WAIT_V(8); PG8_WAIT_L(0); PG8_BAR; PG8_MMA(0, 0, At, B0); PG8_MMA(0, 1, At, B1); PG8_BAR; PG8_SCHED;
      PG8_LDA(At, 0, 1); PG8_STAGE(PG8_SB(0, 0), b2, voffB); PG8_STAGE(PG8_SB(0, 1), b2 + hstepB, voffB); PG8_STAGE(PG8_SA(0, 0), a2, voffA);
      PG8_WAIT_V(8); PG8_WAIT_L(0); PG8_BAR; PG8_MMA(1, 0, At, B0); PG8_MMA(1, 1, At, B1); PG8_BAR; PG8_SCHED;
      PG8_LDB(B0, 1, 0); PG8_LDB(B1, 1, 1); PG8_SCHED; PG8_LDA(At, 1, 0); PG8_STAGE(PG8_SA(0, 1), a2 + hstepA, voffA);
      PG8_WAIT_V(8); PG8_WAIT_L(0); PG8_BAR; PG8_MMA(0, 0, At, B0); PG8_MMA(0, 1, At, B1); PG8_BAR; PG8_SCHED;
      PG8_LDA(At, 1, 1); PG8_STAGE(PG8_SB(1, 0), b3, voffB); PG8_STAGE(PG8_SB(1, 1), b3 + hstepB, voffB); PG8_STAGE(PG8_SA(1, 0), a3, voffA);
      PG8_WAIT_V(8); PG8_WAIT_L(0); PG8_BAR; PG8_MMA(1, 0, At, B0); PG8_MMA(1, 1, At, B1); PG8_BAR; PG8_SCHED;
    }
    if (wr == 0) PG8_BAR;
    if (!(EPI == 4 && gridDim.x == 256)) epilogue<EPI == 4 ? 3 : EPI>(p, acc, cpm, cpn, wr, wc, fr, fq);
    if (!has_next) break;
#pragma unroll
    for (int a = 0; a < 2; ++a)
#pragma unroll
      for (int b = 0; b < 2; ++b)
#pragma unroll
        for (int m = 0; m < 4; ++m)
#pragma unroll
          for (int n = 0; n < 2; ++n) acc[a][b][m][n] = (f32x4){0.f, 0.f, 0.f, 0.f};
    cpm = npm; cpn = npn; cA = nA; cB = nB; ++ui;
    if (wr == 1) PG8_BAR;
  }
  PG8_WAIT_V(0);
  PG8_BAR;
  if (EPI == 4 && gridDim.x == 256) epilogue_final(p, acc, cpm, cpn, wr, wc, fr, fq, (unsigned char*)lds, tid);
#undef PG8_SA
#undef PG8_SB
#undef PG8_STAGE
#undef PG8_LDA
#undef PG8_LDB
#undef PG8_MMA
}

template <int EPI>
DI void gemm_tail(const Params& p, const bf16_t* A, int lda, const bf16_t* Bt, int tile0, int ntiles) {
  const int tid = launder(threadIdx.x), wid = tid >> 6, lane = tid & 63, fr = lane & 15, fq = lane >> 4;
  for (int q = blockIdx.x; q < ntiles * 32; q += gridDim.x) {
    const int t = tile0 + (q >> 5), sub = q & 31, pm = t >> 2, pn = t & 3;
    const int row0 = pm * 256 + (sub >> 3) * 64 + (wid >> 1) * 16, R0 = pn * 256 + (sub & 7) * 32 + (wid & 1) * 16;
    const bf16_t* ap = A + (size_t)(row0 + fr) * lda + fq * 8; const bf16_t* bp = Bt + (size_t)(R0 + fr) * DM + fq * 8;
    f32x4 acc = {0.f, 0.f, 0.f, 0.f};
#pragma unroll 16
    for (int ks = 0; ks < 32; ++ks) { const bf16x8 a = *(const bf16x8*)(ap + ks * 32), b = *(const bf16x8*)(bp + ks * 32); acc = __builtin_amdgcn_mfma_f32_16x16x32_bf16(b, a, acc, 0, 0, 0); }
    const size_t row = row0 + fr; const int col0 = (R0 & ~31) + 8 * fq + 4 * ((R0 >> 4) & 1);
    const size_t o = row * DM + col0;
    if (EPI == 2) {
      const u32x2 sw = *(const u32x2*)(p.SGB + o), aw = *(const u32x2*)(p.SGA + o);
      u32x2 w; w.x = pk2(bflo(aw.x) + bflo(sw.x) * acc[0], bfhi(aw.x) + bfhi(sw.x) * acc[1]); w.y = pk2(bflo(aw.y) + bflo(sw.y) * acc[2], bfhi(aw.y) + bfhi(sw.y) * acc[3]);
      *(u32x2*)(p.UW + o) = w;
    } else {
      const float* xr = row < NTP ? p.x_p + row * DM : p.x_s + (row - NTP) * DM;
      *(f32x4*)(p.out + o) = *(const f32x4*)(xr + col0) + acc;
    }
  }
}

DI void wtile_desc(const Params& p, int tile, const float*& src, bf16_t*& dst, int& N, int& kt, int& R0, int& kind) {
  if (tile < 2560) { src = p.w_in; dst = p.WIN; N = NIN; kt = tile & 15; R0 = (tile >> 4) * 64; kind = 0; }
  else { const int t2 = tile - 2560, mat = t2 >> 8; src = mat == 0 ? p.w_oa : (mat == 1 ? p.w_ob : p.w_o); dst = mat == 0 ? p.WOA : (mat == 1 ? p.WOB : p.WO); N = DM; kt = t2 & 15; R0 = ((t2 & 255) >> 4) * 64; kind = 1; }
}
DI void convert_tiles(const Params& p, int first, int end, int stride) {
  extern __shared__ __attribute__((aligned(16))) unsigned char smem[];
  float* lds = (float*)smem;
  const int tid = launder(threadIdx.x);
#pragma unroll 1
  for (int t0 = first; t0 < end; t0 += 4 * stride) {
    f32x4 v[4][2];
#pragma unroll
    for (int q = 0; q < 4; ++q) {
      const int tile = t0 + q * stride;
      if (tile < end) {
        const float* src; bf16_t* dst; int N, kt, R0, kind; wtile_desc(p, tile, src, dst, N, kt, R0, kind);
        const int r4 = tid & 15, R = R0 + r4 * 4, c = kind == 0 ? colmap_in(R) : colmap_sq(R);
#pragma unroll
        for (int ps = 0; ps < 2; ++ps) v[q][ps] = ldnt4(src + (size_t)(kt * 64 + ps * 32 + (tid >> 4)) * N + c);
      }
    }
#pragma unroll
    for (int q = 0; q < 4; ++q) {
      if (t0 + q * stride < end) {
#pragma unroll
        for (int ps = 0; ps < 2; ++ps) { float* d = lds + q * (64 * 65) + (ps * 32 + (tid >> 4)) * 65 + (tid & 15) * 4; d[0] = v[q][ps].x; d[1] = v[q][ps].y; d[2] = v[q][ps].z; d[3] = v[q][ps].w; }
      }
    }
    lds_barrier();
#pragma unroll
    for (int q = 0; q < 4; ++q) {
      const int tile = t0 + q * stride;
      if (tile < end) {
        const float* src; bf16_t* dst; int N, kt, R0, kind; wtile_desc(p, tile, src, dst, N, kt, R0, kind);
        const int R = tid >> 3, kg = tid & 7; float f[8];
#pragma unroll
        for (int i = 0; i < 8; ++i) f[i] = lds[q * (64 * 65) + (kg * 8 + i) * 65 + R];
        *(u32x4*)(dst + (size_t)(R0 + R) * DM + kt * 64 + kg * 8) = pack8(f);
      }
    }
    lds_barrier();
  }
}

__device__ void phase0(const Params& p) {
  extern __shared__ __attribute__((aligned(16))) unsigned char smem[];
  float* lds = (float*)smem;
  const int tid = threadIdx.x, wid = tid >> 6, lane = tid & 63, G = gridDim.x;
  {
    f32x4 w[4];
#pragma unroll
    for (int i = 0; i < 4; ++i) w[i] = *(const f32x4*)(p.nw + i * 256 + lane * 4);
#pragma unroll 1
    for (int row = (blockIdx.x * 8 + wid) * 4; row < NT; row += G * 8 * 4) {
      f32x4 v[4][4];
#pragma unroll
      for (int q = 0; q < 4; ++q) { const int r = row + q; const float* xr = r < NTP ? p.x_p + (size_t)r * DM : p.x_s + (size_t)(r - NTP) * DM;
#pragma unroll
        for (int i = 0; i < 4; ++i) v[q][i] = ldnt4(xr + i * 256 + lane * 4); }
#pragma unroll
      for (int q = 0; q < 4; ++q) {
        float ss = 0.f;
#pragma unroll
        for (int i = 0; i < 4; ++i) ss += (v[q][i].x * v[q][i].x + v[q][i].y * v[q][i].y) + (v[q][i].z * v[q][i].z + v[q][i].w * v[q][i].w);
        ss = wave_sum(ss);
        const float rstd = rsqrtf(ss * (1.f / DM) + EPS);
#pragma unroll
        for (int i = 0; i < 4; ++i) { u32x2 o; o.x = pk2(v[q][i].x * rstd * w[i].x, v[q][i].y * rstd * w[i].y); o.y = pk2(v[q][i].z * rstd * w[i].z, v[q][i].w * rstd * w[i].w);
          *(u32x2*)(p.UW + (size_t)(row + q) * DM + i * 256 + lane * 4) = o; }
      }
    }
  }
  convert_tiles(p, blockIdx.x, 2560, G);
  for (int idx = blockIdx.x * 512 + tid; idx < 16 * DM; idx += G * 512) { const int c = idx >> 10, k = idx & 1023; p.WB16[idx] = (bf16_t)(pk2(p.w_in[(size_t)k * NIN + 8192 + c], 0.f) & 0xffffu); }
}

__device__ void phase1(const Params& p) {
  const int G = gridDim.x;
  { extern __shared__ __attribute__((aligned(16))) unsigned char smem[];
    Sched S; S.init_static(NT, 10240, G, blockIdx.x); gemm_phase<0>(p, (LAS unsigned char*)smem, p.UW, DM, p.WIN, S); }
  const int nfull = G == 256 ? 80 : 0, nside = G - nfull, sidx = (int)blockIdx.x - nfull;
  if (sidx >= 0) convert_tiles(p, 2560 + sidx, 2560 + 768, nside);
  const int tid = launder(threadIdx.x), wid = tid >> 6, lane = tid & 63, fr = lane & 15, fq = lane >> 4;
  if (sidx >= 0)
  for (int task = sidx * 8 + wid; task < NT / 16; task += nside * 8) {
    const int base = task * 16; f32x4 acc = {0.f, 0.f, 0.f, 0.f};
    const bf16_t* ap = p.UW + (size_t)(base + fr) * DM + fq * 8; const bf16_t* bp = p.WB16 + fr * DM + fq * 8;
#pragma unroll 8
    for (int ks = 0; ks < 32; ++ks) { const bf16x8 a = *(const bf16x8*)(ap + ks * 32), b = *(const bf16x8*)(bp + ks * 32); acc = __builtin_amdgcn_mfma_f32_16x16x32_bf16(a, b, acc, 0, 0, 0); }
    const int c = fr, h = c & 7; const float na = -__expf(p.a_log[h]), db = p.dt_bias[h];
#pragma unroll
    for (int j = 0; j < 4; ++j) {
      const int tok = base + fq * 4 + j; const float v = acc[j]; float r;
      if (c < 8) r = sigmf(v); else { const float xx = v + db; r = na * (xx > 20.f ? xx : log1pf(__expf(xx))); }
      p.BG[(size_t)tok * 16 + c] = r;
    }
  }
}

DI u32x4 raw_unit_load(const Params& p, int cgi, int h, int u) {
  const int r = u / 48, rem = u % 48, part = rem >> 4, c8 = rem & 15;
  u32x4 v = {0u, 0u, 0u, 0u};
  if (r < 3) { if ((cgi & 31) > 0) v = *(const u32x4*)(p.HALO + ((size_t)(cgi - 1) * 3 + r) * QW + part * 1024 + h * 128 + c8 * 8); }
  else v = *(const u32x4*)(p.QKV + (size_t)(cgi * 64 + r - 3) * QW + part * 1024 + h * 128 + c8 * 8);
  return v;
}
DI int crow(int r, int lh) { return (r & 3) + 8 * (r >> 2) + 4 * lh; }
DI bf16x8 packfrag(const f32x16& x, int s) {
  u32x4 w; w.x = pk2(x[8 * s], x[8 * s + 1]); w.y = pk2(x[8 * s + 2], x[8 * s + 3]); w.z = pk2(x[8 * s + 4], x[8 * s + 5]); w.w = pk2(x[8 * s + 6], x[8 * s + 7]);
  return __builtin_bit_cast(bf16x8, w);
}
DI bf16x8 ld_permk(const bf16_t* rowp, int s, int lh) {
  const u32x2 a = *(const u32x2*)(rowp + 16 * s + 4 * lh), b = *(const u32x2*)(rowp + 16 * s + 8 + 4 * lh);
  u32x4 w; w.x = a.x; w.y = a.y; w.z = b.x; w.w = b.y; return __builtin_bit_cast(bf16x8, w);
}

DI void conv_unit(const Params& p, int part, int c8, int row, const bf16_t* raw, const float* cw, bf16_t* qh, bf16_t* kh, bf16_t* vh, const float* gcs, int T0, int h) {
    f32x2 w2[4][4];
#pragma unroll
    for (int j = 0; j < 4; ++j) { const f32x4 wa = *(const f32x4*)(cw + (part * 4 + j) * 128 + c8 * 8), wb = *(const f32x4*)(cw + (part * 4 + j) * 128 + c8 * 8 + 4);
      w2[j][0] = (f32x2){wa.x, wa.y}; w2[j][1] = (f32x2){wa.z, wa.w}; w2[j][2] = (f32x2){wb.x, wb.y}; w2[j][3] = (f32x2){wb.z, wb.w}; }
    f32x2 a2[2][4];
#pragma unroll
    for (int k = 0; k < 4; ++k) { a2[0][k] = (f32x2){0.f, 0.f}; a2[1][k] = (f32x2){0.f, 0.f}; }
#pragma unroll
    for (int rr = 0; rr < 5; ++rr) {
      const u32x4 xw = *(const u32x4*)(raw + (row + rr) * 392 + part * 128 + c8 * 8);
      f32x2 x2[4]; x2[0] = (f32x2){bflo(xw.x), bfhi(xw.x)}; x2[1] = (f32x2){bflo(xw.y), bfhi(xw.y)}; x2[2] = (f32x2){bflo(xw.z), bfhi(xw.z)}; x2[3] = (f32x2){bflo(xw.w), bfhi(xw.w)};
#pragma unroll
      for (int q = 0; q < 2; ++q) { const int j = rr - q; if (j >= 0 && j < 4) {
#pragma unroll
        for (int k = 0; k < 4; ++k) a2[q][k] = x2[k] * w2[j][k] + a2[q][k]; } }
    }
#pragma unroll
    for (int q = 0; q < 2; ++q) {
      f32x2 s2 = {0.f, 0.f};
#pragma unroll
      for (int k = 0; k < 4; ++k) {
        const f32x2 t = a2[q][k] * (-1.4426950408889634f);
        f32x2 d; d.x = __builtin_amdgcn_exp2f(t.x); d.y = __builtin_amdgcn_exp2f(t.y); d = d + 1.0f;
        f32x2 r; r.x = __builtin_amdgcn_rcpf(d.x); r.y = __builtin_amdgcn_rcpf(d.y);
        a2[q][k] = a2[q][k] * r; s2 = a2[q][k] * a2[q][k] + s2;
      }
      float ss = s2.x + s2.y;
      ss += __shfl_xor(ss, 1); ss += __shfl_xor(ss, 2); ss += __shfl_xor(ss, 4); ss += __shfl_xor(ss, 8);
      if (part < 2) { const float sc = rsqrtf(ss + EPS) * (part == 0 ? 0.08838834764831845f : 1.f);
#pragma unroll
        for (int k = 0; k < 4; ++k) a2[q][k] = a2[q][k] * sc; }
      bf16_t* dstl = part == 0 ? qh : (part == 1 ? kh : vh);
      { u32x4 o; o.x = pk2(a2[q][0].x, a2[q][0].y); o.y = pk2(a2[q][1].x, a2[q][1].y); o.z = pk2(a2[q][2].x, a2[q][2].y); o.w = pk2(a2[q][3].x, a2[q][3].y);
        *(u32x4*)(dstl + (row + q) * 136 + c8 * 8) = o; }
      if (part == 0) { const float eg = __expf(gcs[row + q]);
#pragma unroll
        for (int k = 0; k < 4; ++k) a2[q][k] = a2[q][k] * eg;
        u32x4 o; o.x = pk2(a2[q][0].x, a2[q][0].y); o.y = pk2(a2[q][1].x, a2[q][1].y); o.z = pk2(a2[q][2].x, a2[q][2].y); o.w = pk2(a2[q][3].x, a2[q][3].y);
        *(u32x4*)(p.QKV + (size_t)(T0 + row + q) * QW + h * 128 + c8 * 8) = o; }
    }
  }

DI void chunk_stageA(const Params& p, u32x4 (&pre)[7], float& pg, float& pb, int set, int next_cgi, int next_h, bool has_next) {
  extern __shared__ __attribute__((aligned(16))) unsigned char smem[];
  bf16_t* raw = (bf16_t*)smem;
  float* gcs = (float*)(smem + (set ? 135936 : 129024));
  float* bet = gcs + 64;
  float* rsk = gcs + 128;
  const int tid = launder(threadIdx.x), wid = tid >> 6, lane = tid & 63;
#pragma unroll
  for (int k = 0; k < 7; ++k) { const int u = k * 512 + tid; if (u < 67 * 48) { const int r = u / 48, rem = u % 48; *(u32x4*)(raw + r * 392 + (rem >> 4) * 128 + (rem & 15) * 8) = pre[k]; } }
  if (has_next) {
#pragma unroll
    for (int k = 0; k < 7; ++k) { const int u = k * 512 + tid; if (u < 67 * 48) pre[k] = raw_unit_load(p, next_cgi, next_h, u); }
  }
  if (wid == 7) {
    float g = pg; const float be = pb;
    if (has_next) { pg = p.BG[(size_t)(next_cgi * 64 + lane) * 16 + 8 + next_h]; pb = p.BG[(size_t)(next_cgi * 64 + lane) * 16 + next_h]; }
#pragma unroll
    for (int o = 1; o < 64; o <<= 1) { const float t = __shfl_up(g, o); if (lane >= o) g += t; }
    gcs[lane] = g; bet[lane] = be; rsk[lane] = be * __expf(g);
  }
}

DI void chunk_B(const Params& p, int cgi, int h, int set) {
  extern __shared__ __attribute__((aligned(16))) unsigned char smem[];
  const int tid = launder(threadIdx.x);
  const float* gcs = (const float*)(smem + (set ? 135936 : 129024));
#pragma unroll 1
  for (int part = 0; part < 2; ++part)
    conv_unit(p, part, tid & 15, (tid >> 4) * 2, (const bf16_t*)smem, (const float*)(smem + 129792), (bf16_t*)(smem + 52736), (bf16_t*)(smem + (set ? 136704 : 70144)), (bf16_t*)(smem + 87552), gcs, cgi * 64, h);
}

DI void chunk_task(const Params& p, int cgi, int h, int set, u32x4 (&pre)[7], float& pg, float& pb, bool doA, int n1_cgi, int n1_h, bool pipeB, int nn_cgi, int nn_h, bool has_nn) {
  extern __shared__ __attribute__((aligned(16))) unsigned char smem[];
  bf16_t* raw = (bf16_t*)smem;
  bf16_t* qh = (bf16_t*)(smem + 52736);
  bf16_t* kh = (bf16_t*)(smem + (set ? 136704 : 70144));
  bf16_t* vh = (bf16_t*)(smem + 87552);
  float* Mm = (float*)(smem + 104960);
  bf16_t* M10n = (bf16_t*)(smem + 121344);
  bf16_t* Tb = (bf16_t*)(smem + 123904);
  float* gcs = (float*)(smem + (set ? 135936 : 129024));
  float* bet = gcs + 64;
  float* rsk = gcs + 128;
  const float* cw = (const float*)(smem + 129792);
  const int tid = launder(threadIdx.x), wid = tid >> 6, lane = tid & 63;
  const int n = cgi & 31, b = cgi >> 5, T0 = cgi * 64, ci = cgi * 8 + h;
  const float glast = gcs[63];
  if (n == 31) {
    for (int u = tid; u < 3 * 384; u += 512) { const int j = u / 384, cc = u % 384, part = cc >> 7, col = cc & 127;
      p.out[OFF_NCQ_P + ((size_t)b * 3 + j) * QW + part * 1024 + h * 128 + col] = bf2f(raw[(64 + j) * 392 + cc]); }
  }
#define KQ_BLOCK(bidx, isq) do { \
      const int ib = (bidx) >= 6 ? 3 : ((bidx) >= 3 ? 2 : ((bidx) >= 1 ? 1 : 0)), jb = (bidx) - (ib * (ib + 1)) / 2; \
      const bf16_t* Y = (isq) ? qh : kh; \
      const int i = ib * 16 + fr; const float gi = gcs[i], bi = bet[i]; \
      f32x4 d = {0.f, 0.f, 0.f, 0.f}; \
      _Pragma("unroll") for (int ks = 0; ks < 4; ++ks) { \
        const bf16x8 xa = *(const bf16x8*)(kh + (jb * 16 + fr) * 136 + ks * 32 + fq * 8), yb = *(const bf16x8*)(Y + (ib * 16 + fr) * 136 + ks * 32 + fq * 8); \
        d = __builtin_amdgcn_mfma_f32_16x16x32_bf16(xa, yb, d, 0, 0, 0); } \
      const int j0 = jb * 16 + fq * 4; float r[4]; \
      _Pragma("unroll") for (int jj = 0; jj < 4; ++jj) { const int j = j0 + jj; const bool keep = (isq) ? (i >= j) : (i > j); r[jj] = keep ? d[jj] * __expf(gi - gcs[j]) * ((isq) ? 1.f : bi) : 0.f; } \
      if (isq) { u32x2 w; w.x = pk2(r[0], r[1]); w.y = pk2(r[2], r[3]); *(u32x2*)(p.AQK + (size_t)ci * 4096 + i * 64 + j0) = w; } \
      else { \
        *(f32x4*)(Mm + i * 64 + j0) = (f32x4){r[0], r[1], r[2], r[3]}; \
        if (ib >= 2 && jb < 2) { u32x2 w; w.x = pk2(-r[0], -r[1]); w.y = pk2(-r[2], -r[3]); *(u32x2*)(M10n + (i - 32) * 40 + j0) = w; } \
      } } while (0)
  {
    const int fr = lane & 15, fq = lane >> 4;
#pragma unroll 1
    for (int bidx = wid; bidx < 10; bidx += 8) KQ_BLOCK(bidx, false);
  }
  conv_unit(p, 2, tid & 15, (tid >> 4) * 2, raw, cw, qh, kh, vh, gcs, T0, h);
  lds_barrier();
  if (wid == 0) {
    const int blk = lane >> 5, c = lane & 31; const float* Mb = Mm + (blk * 32) * 64 + blk * 32;
    float X[32];
    f32x4 mb[2][8];
#pragma unroll
    for (int r = 0; r < 32; ++r) {
      if (r + 1 < 32) {
#pragma unroll
        for (int j4 = 0; j4 < (r + 4) / 4; ++j4) mb[(r + 1) & 1][j4] = *(const f32x4*)(Mb + (r + 1) * 64 + j4 * 4);
      }
      float s0 = (r == c) ? 1.f : 0.f, s1 = 0.f;
#pragma unroll
      for (int j4 = 0; j4 < (r + 3) / 4; ++j4) {
        const f32x4 m = mb[r & 1][j4];
        if (j4 * 4 + 0 < r) s0 -= m.x * X[j4 * 4 + 0];
        if (j4 * 4 + 1 < r) s1 -= m.y * X[j4 * 4 + 1];
        if (j4 * 4 + 2 < r) s0 -= m.z * X[j4 * 4 + 2];
        if (j4 * 4 + 3 < r) s1 -= m.w * X[j4 * 4 + 3];
      }
      X[r] = s0 + s1;
    }
#pragma unroll
    for (int r = 0; r < 32; ++r) Tb[(blk * 32 + r) * 40 + c] = (bf16_t)(pk2(X[r], 0.f) & 0xffffu);
  } else {
    {
      const int fr = lane & 15, fq = lane >> 4;
#pragma unroll 1
      for (int bidx = wid - 1; bidx < 10; bidx += 7) KQ_BLOCK(bidx, true);
      for (int u = wid - 1; u < 6; u += 7) { const int ib = u < 3 ? 0 : (u < 5 ? 1 : 2), jb = u < 3 ? u + 1 : (u < 5 ? u - 1 : 3);
        *(u32x2*)(p.AQK + (size_t)ci * 4096 + (ib * 16 + fr) * 64 + jb * 16 + fq * 4) = (u32x2){0u, 0u}; }
    }
    for (int u = tid - 64; u < 1024; u += 448) {
      const int i8 = u & 7, d = u >> 3; float f[8];
#pragma unroll
      for (int e = 0; e < 8; ++e) { const int i = i8 * 8 + e; f[e] = bf2f(kh[i * 136 + d]) * __expf(glast - gcs[i]); }
      *(u32x4*)(p.QKV + (size_t)(T0 + (d >> 1)) * QW + 1024 + h * 128 + (d & 1) * 64 + i8 * 8) = pack8(f);
    }
    if (tid == 64) p.DL[ci] = __expf(glast);
  }
  if (doA) chunk_stageA(p, pre, pg, pb, set ^ 1, nn_cgi, nn_h, has_nn);
  lds_barrier();
  {
    const int l32 = lane & 31, lh = lane >> 5; const bool isV = wid >= 4;
    const bf16_t* srcl = (isV ? vh : kh) + (wid & 3) * 32 + l32; const float* rs = isV ? bet : rsk;
    bf16x8 r0[2];
#pragma unroll
    for (int s = 0; s < 2; ++s) { float f[8];
#pragma unroll
      for (int e = 0; e < 8; ++e) { const int k = 16 * s + 8 * lh + e; f[e] = bf2f(srcl[k * 136]) * rs[k]; }
      r0[s] = __builtin_bit_cast(bf16x8, pack8(f)); }
    f32x16 x0 = {};
#pragma unroll
    for (int s = 0; s < 2; ++s) x0 = __builtin_amdgcn_mfma_f32_32x32x16_bf16(*(const bf16x8*)(Tb + l32 * 40 + 16 * s + 8 * lh), r0[s], x0, 0, 0, 0);
    f32x16 y1;
#pragma unroll
    for (int r = 0; r < 16; ++r) { const int k = 32 + crow(r, lh); y1[r] = bf2f(srcl[k * 136]) * rs[k]; }
#pragma unroll
    for (int s = 0; s < 2; ++s) y1 = __builtin_amdgcn_mfma_f32_32x32x16_bf16(ld_permk(M10n + l32 * 40, s, lh), packfrag(x0, s), y1, 0, 0, 0);
    f32x16 x1 = {};
#pragma unroll
    for (int s = 0; s < 2; ++s) x1 = __builtin_amdgcn_mfma_f32_32x32x16_bf16(ld_permk(Tb + (32 + l32) * 40, s, lh), packfrag(y1, s), x1, 0, 0, 0);
    const int col = (wid & 3) * 32 + l32;
    if (!isV) {
      bf16_t* wp = p.UW + (size_t)ci * 8192 + col;
#pragma unroll
      for (int r = 0; r < 16; ++r) { const int i = crow(r, lh); wp[i * 128] = (bf16_t)(pk2(-x0[r], 0.f) & 0xffffu); wp[(32 + i) * 128] = (bf16_t)(pk2(-x1[r], 0.f) & 0xffffu); }
    } else {
      bf16_t* up = p.QKV + (size_t)(T0 + (col >> 1)) * QW + 2048 + h * 128 + (col & 1) * 64;
#pragma unroll
      for (int q = 0; q < 4; ++q) {
        u32x2 w0, w1; w0.x = pk2(x0[q * 4], x0[q * 4 + 1]); w0.y = pk2(x0[q * 4 + 2], x0[q * 4 + 3]); w1.x = pk2(x1[q * 4], x1[q * 4 + 1]); w1.y = pk2(x1[q * 4 + 2], x1[q * 4 + 3]);
        *(u32x2*)(up + q * 8 + lh * 4) = w0; *(u32x2*)(up + 32 + q * 8 + lh * 4) = w1;
      }
    }
  }
  if (pipeB) chunk_B(p, n1_cgi, n1_h, set ^ 1);
  lds_barrier();
}

__device__ void phase2(const Params& p) {
  const int G = gridDim.x;
  const int tid = launder(threadIdx.x);
  {
    const int c8 = (tid & 127) * 8;
    float w0[8], w1[8], w2[8];
#pragma unroll
    for (int e = 0; e < 8; ++e) { w0[e] = p.caw[c8 + e]; w1[e] = p.caw[DM + c8 + e]; w2[e] = p.caw[2 * DM + c8 + e]; }
#pragma unroll 1
    for (int grp = blockIdx.x * 4 + (tid >> 7); grp < NT / 8; grp += G * 4) {
      const int r0 = grp * 8;
      u32x4 pw[10], gw[8];
#pragma unroll
      for (int k = 0; k < 10; ++k) { const int r = r0 - 2 + k; pw[k] = (u32x4){0u, 0u, 0u, 0u}; if (r >= 0) pw[k] = *(const u32x4*)(p.P + (size_t)r * DM + c8); }
#pragma unroll
      for (int k = 0; k < 8; ++k) gw[k] = *(const u32x4*)(p.GATE + (size_t)(r0 + k) * DM + c8);
#pragma unroll
      for (int k = 0; k < 8; ++k) {
        const int r = r0 + k;
        float cur[8], p1[8], p2[8], g[8];
        unpack8(pw[k + 2], cur); unpack8(pw[k + 1], p1); unpack8(pw[k], p2); unpack8(gw[k], g);
        if (r < NTP) {
          const int t = r & 2047;
          if (t < 1) { for (int e = 0; e < 8; ++e) p1[e] = 0.f; }
          if (t < 2) { for (int e = 0; e < 8; ++e) p2[e] = 0.f; }
          if (t >= 2046) { float* o = p.out + OFF_NCA_P + ((size_t)(r >> 11) * 2 + (t - 2046)) * DM + c8; *(f32x4*)o = (f32x4){cur[0], cur[1], cur[2], cur[3]}; *(f32x4*)(o + 4) = (f32x4){cur[4], cur[5], cur[6], cur[7]}; }
        } else {
          const int bs = (r - NTP) >> 2, t = (r - NTP) & 3;
          const float* past = p.sca + (size_t)bs * 2 * DM + c8;
          if (t < 1) { for (int e = 0; e < 8; ++e) p1[e] = past[DM + e]; }
          if (t < 2) { for (int e = 0; e < 8; ++e) p2[e] = past[(t == 1 ? DM : 0) + e]; }
          if (t >= 2) { float* o = p.out + OFF_NCA_S + ((size_t)bs * 2 + (t - 2)) * DM + c8; *(f32x4*)o = (f32x4){cur[0], cur[1], cur[2], cur[3]}; *(f32x4*)(o + 4) = (f32x4){cur[4], cur[5], cur[6], cur[7]}; }
        }
        float o8[8];
#pragma unroll
        for (int e = 0; e < 8; ++e) o8[e] = g[e] * (w0[e] * p2[e] + w1[e] * p1[e] + w2[e] * cur[e]);
        *(u32x4*)(p.GATE + (size_t)r * DM + c8) = pack8(o8);
      }
    }
  }
  {
    extern __shared__ __attribute__((aligned(16))) unsigned char smem[];
    float* cw = (float*)(smem + 129792);
    const int tid0 = launder(threadIdx.x);
    int cur_h = -1; u32x4 pre[7];
    int task = blockIdx.x;
#pragma unroll
    for (int k = 0; k < 7; ++k) { const int u = k * 512 + tid0; pre[k] = (u32x4){0u, 0u, 0u, 0u}; if (task < 2048 && u < 67 * 48) pre[k] = raw_unit_load(p, task >> 3, task & 7, u); }
    float pg = 0.f, pb = 0.f;
    if (task < 2048 && tid0 >= 448) { pg = p.BG[(size_t)((task >> 3) * 64 + (tid0 & 63)) * 16 + 8 + (task & 7)]; pb = p.BG[(size_t)((task >> 3) * 64 + (tid0 & 63)) * 16 + (task & 7)]; }
    if (task < 2048) { const int nt = task + G; chunk_stageA(p, pre, pg, pb, 0, nt >> 3, nt & 7, nt < 2048); }
    lds_barrier();
    int kidx = 0; bool b_done = false;
    for (; task < 2048; task += G, ++kidx) {
      const int h = task & 7;
      if (h != cur_h) {
        lds_barrier();
        for (int u = tid0; u < 3 * 4 * 128; u += 512) { const int part = u / 512, j = (u >> 7) & 3, col = u & 127; cw[u] = p.cbw[(size_t)j * QW + part * 1024 + h * 128 + col]; }
        cur_h = h;
        lds_barrier();
      }
      if (!b_done) { chunk_B(p, task >> 3, h, kidx & 1); lds_barrier(); }
      const int nt = task + G, nn = nt + G;
      const bool pipeB = nt < 2048 && (nt & 7) == h;
      chunk_task(p, task >> 3, h, kidx & 1, pre, pg, pb, nt < 2048, nt >> 3, nt & 7, pipeB, nn >> 3, nn & 7, nn < 2048);
      b_done = pipeB;
    }
  }
}

DI void cvt16(f32x16& a, int q, u32x2 w) { a[q * 4 + 0] = bflo(w.x); a[q * 4 + 1] = bfhi(w.x); a[q * 4 + 2] = bflo(w.y); a[q * 4 + 3] = bfhi(w.y); }
__device__ __forceinline__ void scan_seq(const Params& p, int seq) {
  extern __shared__ __attribute__((aligned(16))) unsigned char smem[];
  bf16_t* A1 = (bf16_t*)smem;
  bf16_t* AQ = (bf16_t*)(smem + 34816);
  bf16_t* KT = (bf16_t*)(smem + 44032);
  bf16_t* ST = (bf16_t*)(smem + 62464);
  bf16_t* UT = (bf16_t*)(smem + 97280);
  float* OS = (float*)(smem + 115712);
  const int tid = launder(threadIdx.x), wid = tid >> 6, lane = tid & 63, vb = wid & 3, hw = wid >> 2, l32 = lane & 31, lh = lane >> 5;
  const int b = seq >> 3, h = seq & 7;
  f32x16 S0 = {}, S1 = {};
  for (int i = tid; i < 128 * 136 / 8; i += 512) ((u32x4*)ST)[i] = (u32x4){0u, 0u, 0u, 0u};
  const int v = vb * 32 + l32;
  u32x4 pA[4], pQ, pK[2]; u32x2 pU[8]; float pdl;
  float onw16[16];
  { const int seg = tid & 7;
#pragma unroll
    for (int e = 0; e < 16; ++e) onw16[e] = p.onw[seg * 16 + e]; }
#define SCAN_SRC_A(nn, it) ({ const int ci_ = (b * 32 + (nn)) * 8 + h, T0_ = (b * 32 + (nn)) * 64; const int u_ = (it) * 512 + tid, r_ = u_ >> 4, c_ = (u_ & 15) * 8; \
    (const u32x4*)(r_ < 64 ? p.UW + ((size_t)ci_ * 64 + r_) * 128 + c_ : p.QKV + (size_t)(T0_ + r_ - 64) * QW + h * 128 + c_); })
#define SCAN_LOAD_A(nn) do { _Pragma("unroll") for (int it = 0; it < 4; ++it) pA[it] = *SCAN_SRC_A(nn, it); } while (0)
#define SCAN_LOAD_QK(nn) do { const int ci_ = (b * 32 + (nn)) * 8 + h, T0_ = (b * 32 + (nn)) * 64; \
    { const int r = tid >> 3, c = (tid & 7) * 8; pQ = *(const u32x4*)(p.AQK + (size_t)ci_ * 4096 + r * 64 + c); } \
    _Pragma("unroll") for (int it = 0; it < 2; ++it) { const int u = it * 512 + tid, d = u >> 3, c = (u & 7) * 8; \
      pK[it] = *(const u32x4*)(p.QKV + (size_t)(T0_ + (d >> 1)) * QW + 1024 + h * 128 + (d & 1) * 64 + c); } } while (0)
#define SCAN_LOAD_U(nn) do { const int ci_ = (b * 32 + (nn)) * 8 + h, T0_ = (b * 32 + (nn)) * 64; \
    if (hw == 0) { const bf16_t* base_ = p.QKV + (size_t)(T0_ + (v >> 1)) * QW + 2048 + h * 128 + (v & 1) * 64; \
      _Pragma("unroll") for (int q = 0; q < 4; ++q) { pU[q] = *(const u32x2*)(base_ + q * 8 + lh * 4); pU[4 + q] = *(const u32x2*)(base_ + 32 + q * 8 + lh * 4); } } \
    pdl = p.DL[ci_]; } while (0)
#define SCAN_FILL_A() do { _Pragma("unroll") for (int it = 0; it < 4; ++it) { const int u = it * 512 + tid, r = u >> 4, c = (u & 15) * 8; *(u32x4*)(A1 + r * 136 + c) = pA[it]; } } while (0)
#define SCAN_FILL_QK() do { { const int r = tid >> 3, c = (tid & 7) * 8; *(u32x4*)(AQ + r * 72 + c) = pQ; } \
    _Pragma("unroll") for (int it = 0; it < 2; ++it) { const int u = it * 512 + tid, d = u >> 3, c = (u & 7) * 8; *(u32x4*)(KT + d * 72 + c) = pK[it]; } } while (0)
  SCAN_LOAD_A(0); SCAN_LOAD_QK(0); SCAN_LOAD_U(0);
  SCAN_FILL_A(); SCAN_FILL_QK();
  SCAN_LOAD_A(1); SCAN_LOAD_QK(1);
  lds_barrier();
#pragma unroll 1
  for (int n = 0; n < 32; ++n) {
    const int cgi = b * 32 + n, T0 = cgi * 64;
    f32x16 a0 = {}, a1 = {};
    if (hw == 0) {
#pragma unroll
      for (int q = 0; q < 4; ++q) { cvt16(a0, q, pU[q]); cvt16(a1, q, pU[4 + q]); }
    }
    const float dl = pdl;
    if (n + 1 < 32) SCAN_LOAD_U(n + 1);
    u32x4 zz0, zz1;
    { const int i = tid >> 3, seg = tid & 7; const size_t tok = (size_t)T0 + i; zz0 = *(const u32x4*)(p.SBZ + tok * DM + h * 128 + seg * 16); zz1 = *(const u32x4*)(p.SBZ + tok * DM + h * 128 + seg * 16 + 8); }
#pragma unroll
    for (int ks = 0; ks < 8; ++ks) {
      const bf16x8 bfr = *(const bf16x8*)(ST + v * 136 + ks * 16 + lh * 8);
      const bf16x8 x0 = *(const bf16x8*)(A1 + (hw * 64 + l32) * 136 + ks * 16 + lh * 8), x1 = *(const bf16x8*)(A1 + (hw * 64 + 32 + l32) * 136 + ks * 16 + lh * 8);
      a0 = __builtin_amdgcn_mfma_f32_32x32x16_bf16(x0, bfr, a0, 0, 0, 0);
      a1 = __builtin_amdgcn_mfma_f32_32x32x16_bf16(x1, bfr, a1, 0, 0, 0);
    }
    if (hw == 0) {
#pragma unroll
      for (int q = 0; q < 4; ++q) {
        u32x2 w0, w1; w0.x = pk2(a0[q * 4], a0[q * 4 + 1]); w0.y = pk2(a0[q * 4 + 2], a0[q * 4 + 3]); w1.x = pk2(a1[q * 4], a1[q * 4 + 1]); w1.y = pk2(a1[q * 4 + 2], a1[q * 4 + 3]);
        *(u32x2*)(UT + v * 72 + q * 8 + lh * 4) = w0; *(u32x2*)(UT + v * 72 + 32 + q * 8 + lh * 4) = w1;
      }
    }
    lds_barrier();
    S0 *= dl; S1 *= dl;
#pragma unroll
    for (int ks = 0; ks < 4; ++ks) {
      const bf16x8 bfr = *(const bf16x8*)(UT + v * 72 + ks * 16 + lh * 8);
      if (hw == 1) {
        const bf16x8 x0 = *(const bf16x8*)(AQ + l32 * 72 + ks * 16 + lh * 8), x1 = *(const bf16x8*)(AQ + (32 + l32) * 72 + ks * 16 + lh * 8);
        a0 = __builtin_amdgcn_mfma_f32_32x32x16_bf16(x0, bfr, a0, 0, 0, 0);
        a1 = __builtin_amdgcn_mfma_f32_32x32x16_bf16(x1, bfr, a1, 0, 0, 0);
      }
      const bf16x8 k0 = *(const bf16x8*)(KT + ((2 * hw) * 32 + l32) * 72 + ks * 16 + lh * 8), k1 = *(const bf16x8*)(KT + ((2 * hw + 1) * 32 + l32) * 72 + ks * 16 + lh * 8);
      S0 = __builtin_amdgcn_mfma_f32_32x32x16_bf16(k0, bfr, S0, 0, 0, 0);
      S1 = __builtin_amdgcn_mfma_f32_32x32x16_bf16(k1, bfr, S1, 0, 0, 0);
    }
    if (n + 1 < 32) { SCAN_FILL_A(); if (n + 2 < 32) SCAN_LOAD_A(n + 2); }
#pragma unroll
    for (int q = 0; q < 4; ++q) {
      u32x2 w0, w1; w0.x = pk2(S0[q * 4], S0[q * 4 + 1]); w0.y = pk2(S0[q * 4 + 2], S0[q * 4 + 3]); w1.x = pk2(S1[q * 4], S1[q * 4 + 1]); w1.y = pk2(S1[q * 4 + 2], S1[q * 4 + 3]);
      *(u32x2*)(ST + v * 136 + (2 * hw) * 32 + q * 8 + lh * 4) = w0; *(u32x2*)(ST + v * 136 + (2 * hw + 1) * 32 + q * 8 + lh * 4) = w1;
    }
    if (hw == 1) {
#pragma unroll
      for (int r = 0; r < 16; ++r) { const int i = (r & 3) + 8 * (r >> 2) + 4 * lh; OS[i * 132 + v] = a0[r]; OS[(32 + i) * 132 + v] = a1[r]; }
    }
    lds_barrier();
    {
      const int i = tid >> 3, seg = tid & 7; const float* orow = OS + i * 132 + seg * 16; float o[16]; float ss = 0.f;
#pragma unroll
      for (int e4 = 0; e4 < 4; ++e4) { const f32x4 t = *(const f32x4*)(orow + e4 * 4); o[e4 * 4] = t.x; o[e4 * 4 + 1] = t.y; o[e4 * 4 + 2] = t.z; o[e4 * 4 + 3] = t.w; ss += (t.x * t.x + t.y * t.y) + (t.z * t.z + t.w * t.w); }
      ss += __shfl_xor(ss, 1); ss += __shfl_xor(ss, 2); ss += __shfl_xor(ss, 4);
      const float rstd = rsqrtf(ss * (1.f / 128.f) + EPS);
      const size_t tok = (size_t)T0 + i; float z[16];
      unpack8(zz0, z); unpack8(zz1, z + 8);
#pragma unroll
      for (int e = 0; e < 16; ++e) o[e] = o[e] * rstd * onw16[e] * z[e];
      bf16_t* dst = p.QKV + tok * QW + 2048 + h * 128 + seg * 16;
      *(u32x4*)dst = pack8(o); *(u32x4*)(dst + 8) = pack8(o + 8);
    }
    if (n + 1 < 32) { SCAN_FILL_QK(); if (n + 2 < 32) SCAN_LOAD_QK(n + 2); }
  }
  float* sp = p.out + OFF_ND_P + (size_t)(b * 8 + h) * 16384;
#pragma unroll
  for (int r = 0; r < 16; ++r) { const int dd = (r & 3) + 8 * (r >> 2) + 4 * lh; sp[(size_t)((2 * hw) * 32 + dd) * 128 + v] = S0[r]; sp[(size_t)((2 * hw + 1) * 32 + dd) * 128 + v] = S1[r]; }
  lds_barrier();
}

__device__ __forceinline__ void sample_seq(const Params& p, int s, f32x4 (&Sn)[8], int s_next) {
  extern __shared__ __attribute__((aligned(16))) unsigned char smem[];
  float* qs = (float*)smem;
  float* ks = qs + 512;
  float* vs = ks + 512;
  float* os = vs + 512;
  float* red = os + 512;
  const int tid = launder(threadIdx.x), bs = s >> 3, h = s & 7;
  const size_t Tb = (size_t)NTP + bs * 4;
  const int kg = tid >> 5, vg = tid & 31;
  f32x4 S[8];
#pragma unroll
  for (int kk = 0; kk < 8; ++kk) S[kk] = Sn[kk];
  if (s_next >= 0) { const float* sn = p.sd + ((size_t)s_next * 128 + kg * 8) * 128 + vg * 4;
#pragma unroll
    for (int kk = 0; kk < 8; ++kk) Sn[kk] = ldnt4(sn + kk * 128); }
  float ga[4], be[4];
#pragma unroll
  for (int t = 0; t < 4; ++t) { ga[t] = p.BG[(Tb + t) * 16 + 8 + h]; be[t] = p.BG[(Tb + t) * 16 + h]; }
  u32x4 zt = {0u, 0u, 0u, 0u}; float ow[8];
  { const int t = (tid >> 4) & 3, seg = tid & 15; zt = *(const u32x4*)(p.SBZ + (Tb + t) * DM + h * 128 + seg * 8);
#pragma unroll
    for (int e = 0; e < 8; ++e) ow[e] = p.onw[seg * 8 + e]; }
  if (tid < 192) {
    const int c8 = tid & 15, grp = tid >> 4, part = grp % 3, t = grp / 3;
    const int colw = part * 1024 + h * 128 + c8 * 8;
    float a[8] = {0.f, 0.f, 0.f, 0.f, 0.f, 0.f, 0.f, 0.f};
#pragma unroll
    for (int j = 0; j < 4; ++j) {
      const int e_ = t + j; float x[8];
      if (e_ < 3) { const float* ps = p.scq + ((size_t)bs * 3 + e_) * QW + colw; for (int e = 0; e < 8; ++e) x[e] = ps[e]; }
      else unpack8(*(const u32x4*)(p.QKV + (Tb + e_ - 3) * QW + colw), x);
      const float* w = p.cbw + j * QW + colw;
#pragma unroll
      for (int e = 0; e < 8; ++e) a[e] += x[e] * w[e];
      if (j == 3 && t >= 1) { float* o = p.out + OFF_NCQ_S + ((size_t)bs * 3 + (t - 1)) * QW + colw; for (int e = 0; e < 8; ++e) o[e] = x[e]; }
    }
    float ss = 0.f;
#pragma unroll
    for (int e = 0; e < 8; ++e) { a[e] = siluf(a[e]); ss += a[e] * a[e]; }
    ss += __shfl_xor(ss, 1); ss += __shfl_xor(ss, 2); ss += __shfl_xor(ss, 4); ss += __shfl_xor(ss, 8);
    if (part < 2) { const float sc = rsqrtf(ss + EPS) * (part == 0 ? 0.08838834764831845f : 1.f); for (int e = 0; e < 8; ++e) a[e] *= sc; }
    float* d = (part == 0 ? qs : (part == 1 ? ks : vs)) + t * 128 + c8 * 8;
#pragma unroll
    for (int e = 0; e < 8; ++e) d[e] = a[e];
  }
  lds_barrier();
#pragma unroll
  for (int t = 0; t < 4; ++t) {
    const float a = __expf(ga[t]), beta = be[t];
    f32x4 part = {0.f, 0.f, 0.f, 0.f};
#pragma unroll
    for (int kk = 0; kk < 8; ++kk) { S[kk] *= a; part += S[kk] * ks[t * 128 + kg * 8 + kk]; }
    *(f32x4*)(red + kg * 128 + vg * 4) = part;
    lds_barrier();
    f32x4 r = {0.f, 0.f, 0.f, 0.f};
#pragma unroll
    for (int g2 = 0; g2 < 16; ++g2) r += *(const f32x4*)(red + g2 * 128 + vg * 4);
    const f32x4 dlt = (*(const f32x4*)(vs + t * 128 + vg * 4) - r) * beta;
    f32x4 po = {0.f, 0.f, 0.f, 0.f};
#pragma unroll
    for (int kk = 0; kk < 8; ++kk) { S[kk] += dlt * ks[t * 128 + kg * 8 + kk]; po += S[kk] * qs[t * 128 + kg * 8 + kk]; }
    lds_barrier();
    *(f32x4*)(red + kg * 128 + vg * 4) = po;
    lds_barrier();
    if (tid < 128) { float o = 0.f; for (int g2 = 0; g2 < 16; ++g2) o += red[g2 * 128 + tid]; os[t * 128 + tid] = o; }
    lds_barrier();
  }
  float* so = p.out + OFF_ND_S + ((size_t)s * 128 + kg * 8) * 128 + vg * 4;
#pragma unroll
  for (int kk = 0; kk < 8; ++kk) stnt4(so + kk * 128, S[kk]);
  if (tid < 64) {
    const int t = tid >> 4, seg = tid & 15; float o[8]; float ss = 0.f;
#pragma unroll
    for (int e = 0; e < 8; ++e) { o[e] = os[t * 128 + seg * 8 + e]; ss += o[e] * o[e]; }
    ss += __shfl_xor(ss, 1); ss += __shfl_xor(ss, 2); ss += __shfl_xor(ss, 4); ss += __shfl_xor(ss, 8);
    const float rstd = rsqrtf(ss * (1.f / 128.f) + EPS); float z[8];
    unpack8(zt, z);
#pragma unroll
    for (int e = 0; e < 8; ++e) o[e] = o[e] * rstd * ow[e] * z[e];
    *(u32x4*)(p.QKV + (Tb + t) * QW + 2048 + h * 128 + seg * 8) = pack8(o);
  }
  lds_barrier();
}

__device__ void phase3(const Params& p) {
  const int G = gridDim.x, bid = blockIdx.x;
  const bool split = G > 64;
#ifndef P3_NO_SCAN
  if (!split || bid < 64) for (int seq = bid; seq < 64; seq += (split ? 64 : G)) scan_seq(p, seq);
#endif
  if (!split || bid >= 64) {
    const int wk = split ? bid - 64 : bid, NW = split ? G - 64 : G;
#ifndef P3_NO_GEMM
    { extern __shared__ __attribute__((aligned(16))) unsigned char smem[];
      Sched S; S.init_strided(wk, NW, 264); gemm_phase<1>(p, (LAS unsigned char*)smem, p.GATE, DM, p.WOA, S); }
#endif
#ifndef P3_NO_SAMPLE
    {
      const int n2 = (264 > NW && 264 < 2 * NW) ? 264 - NW : 0, n1 = NW - n2;
      const int s_first = wk < n2 ? 1024 : (wk - n2), s_step = n1, s_end = 1024;
      f32x4 Sn[8];
      if (s_first < s_end) { const int tid_ = launder(threadIdx.x); const float* sn = p.sd + ((size_t)s_first * 128 + (tid_ >> 5) * 8) * 128 + (tid_ & 31) * 4;
#pragma unroll
        for (int kk = 0; kk < 8; ++kk) Sn[kk] = ldnt4(sn + kk * 128); }
      for (int s = s_first; s < s_end; s += s_step) sample_seq(p, s, Sn, s + s_step < s_end ? s + s_step : -1);
    }
#endif
  }
}

__device__ void phase4(const Params& p) {
  extern __shared__ __attribute__((aligned(16))) unsigned char smem[];
  Sched S; S.init_strided(blockIdx.x, gridDim.x, 256); gemm_phase<2>(p, (LAS unsigned char*)smem, p.QKV + 2048, QW, p.WOB, S);
  gemm_tail<2>(p, p.QKV + 2048, QW, p.WOB, 256, 8);
}
__device__ void phase5(const Params& p) {
  extern __shared__ __attribute__((aligned(16))) unsigned char smem[];
  Sched S; S.init_strided(blockIdx.x, gridDim.x, 256);
  gemm_phase<4>(p, (LAS unsigned char*)smem, p.UW, DM, p.WO, S);
  gemm_tail<3>(p, p.UW, DM, p.WO, 256, 8);
}
__device__ void phase6(const Params& p) {
  const int tid = launder(threadIdx.x), wid = tid >> 6, lane = tid & 63, G = gridDim.x;
  f32x4 w[4];
#pragma unroll
  for (int i = 0; i < 4; ++i) w[i] = *(const f32x4*)(p.fnw + i * 256 + lane * 4);
  const int row_lo = (G == 256) ? NTP : 0;
#pragma unroll 1
  for (int row = row_lo + (blockIdx.x * 8 + wid) * 4; row < NT; row += G * 8 * 4) {
    f32x4 v[4][4];
#pragma unroll
    for (int q = 0; q < 4; ++q)
#pragma unroll
      for (int i = 0; i < 4; ++i) v[q][i] = *(const f32x4*)(p.out + (size_t)(row + q) * DM + i * 256 + lane * 4);
#pragma unroll
    for (int q = 0; q < 4; ++q) {
      float ss = 0.f;
#pragma unroll
      for (int i = 0; i < 4; ++i) ss += (v[q][i].x * v[q][i].x + v[q][i].y * v[q][i].y) + (v[q][i].z * v[q][i].z + v[q][i].w * v[q][i].w);
      ss = wave_sum(ss);
      const float rstd = rsqrtf(ss * (1.f / DM) + EPS);
#pragma unroll
      for (int i = 0; i < 4; ++i) *(f32x4*)(p.out + (size_t)(row + q) * DM + i * 256 + lane * 4) = v[q][i] * rstd * w[i];
    }
  }
}

#define XB_TMO      128
#define XB_XCNT(j)  (256  + 64 * (j))
#define XB_XSUB(j)  (1280 + 64 * (j))
#define XB_XGEN(j)  (2304 + 64 * (j))
#define XB_TOP      3328
#define XB_TOPGEN   3392
#define XCD_BAR_WORDS 3456
#define XB_SPIN_CAP (1u << 18)
DI unsigned xb_ld(unsigned* p) { return __hip_atomic_load(p, __ATOMIC_RELAXED, __HIP_MEMORY_SCOPE_AGENT); }
DI unsigned xb_add(unsigned* p, unsigned v) { return __hip_atomic_fetch_add(p, v, __ATOMIC_RELAXED, __HIP_MEMORY_SCOPE_AGENT); }
DI unsigned xb_xcc_id() { return (unsigned)__builtin_amdgcn_s_getreg((3 << 11) | 20) & 0xFu; }
#define XB_SPIN(cond, bar) do { unsigned _sp = 0; while (cond) { __builtin_amdgcn_s_sleep(1); \
    if ((++_sp & 255u) == 0u) { if (xb_ld(&(bar)[XB_TMO])) break; if (_sp > XB_SPIN_CAP) { atomicAdd(&(bar)[XB_TMO], 1u); break; } } } } while (0)
struct XcdBarrier { unsigned* bar; unsigned x; volatile LAS unsigned* st; };
DI XcdBarrier xcd_barrier_post(unsigned* bar, volatile LAS unsigned* st) {
  XcdBarrier b; b.bar = bar; b.x = xb_xcc_id(); b.st = st;
  if (threadIdx.x == 0) (void)xb_add(&bar[XB_XCNT(b.x)], 1u);
  return b;
}
DI void xcd_barrier_complete(unsigned* bar, unsigned x, unsigned& nloc, unsigned& nx) {
  const unsigned G = gridDim.x * gridDim.y * gridDim.z;
  unsigned sum, cnt, mine, sp = 0u;
  for (;;) {
    sum = 0u; cnt = 0u; mine = 0u;
#pragma unroll
    for (unsigned j = 0; j < 16; ++j) { const unsigned c = xb_ld(&bar[XB_XCNT(j)]); sum += c; cnt += (c > 0u) ? 1u : 0u; mine = (j == x) ? c : mine; }
    if (sum == G) break;
    __builtin_amdgcn_s_sleep(1);
    if ((++sp & 255u) == 0u) { if (xb_ld(&bar[XB_TMO])) break; if (sp > XB_SPIN_CAP) { atomicAdd(&bar[XB_TMO], 1u); break; } }
  }
  nloc = mine > 0u ? mine : 1u; nx = cnt > 0u ? cnt : 1u;
}
DI void xcd_barrier(const XcdBarrier& b) {
  asm volatile("s_waitcnt vmcnt(0)" ::: "memory");
  __syncthreads();
  if (threadIdx.x == 0) {
    unsigned* bar = b.bar;
    __builtin_amdgcn_s_waitcnt(0);
    unsigned nloc = b.st[0], nx = b.st[1];
    if (nloc == 0u) { xcd_barrier_complete(bar, b.x, nloc, nx); b.st[0] = nloc; b.st[1] = nx; }
    const unsigned old = xb_add(&bar[XB_XSUB(b.x)], 1u);
    const unsigned gen = old / nloc;
    if (old + 1u == (gen + 1u) * nloc) {
      __builtin_amdgcn_fence(__ATOMIC_RELEASE, "agent");
      asm volatile("s_waitcnt vmcnt(0)" ::: "memory");
      const unsigned og = xb_add(&bar[XB_TOP], 1u);
      const unsigned tg = og / nx;
      if (og + 1u == (tg + 1u) * nx) xb_add(&bar[XB_TOPGEN], 1u);
      else XB_SPIN(xb_ld(&bar[XB_TOPGEN]) == tg, bar);
      __builtin_amdgcn_fence(__ATOMIC_ACQUIRE, "agent");
      xb_add(&bar[XB_XGEN(b.x)], 1u);
      asm volatile("s_waitcnt vmcnt(0)" ::: "memory");
    } else {
      XB_SPIN(xb_ld(&bar[XB_XGEN(b.x)]) == gen, bar);
      __builtin_amdgcn_fence(__ATOMIC_ACQUIRE, "agent");
      asm volatile("s_waitcnt vmcnt(0)" ::: "memory");
    }
  }
  __syncthreads();
}

__global__ void __launch_bounds__(512, 2) mega(Params p, int ph_lo, int ph_hi) {
  cg::grid_group grid = cg::this_grid();
  const int lo = ph_lo, hi = ph_hi;
  extern __shared__ __attribute__((aligned(16))) unsigned char smem[];
  volatile LAS unsigned* st = (volatile LAS unsigned*)((LAS unsigned char*)smem + 154112);
  if (threadIdx.x < 4) st[threadIdx.x] = 0u;
  __syncthreads();
  XcdBarrier xb; xb.bar = p.bar; xb.x = 0; xb.st = st;
  if (hi - lo > 1) xb = xcd_barrier_post(p.bar, st);
  if (hi > 100) grid.sync();
#define GRID_SYNC() xcd_barrier(xb)
#define IN(k) (lo <= (k) && (k) < hi)
#define BOTH(k) (IN(k) && IN((k) + 1))
  if (IN(0)) { phase0(p); if (BOTH(0)) GRID_SYNC(); }
  if (IN(1)) { phase1(p); if (BOTH(1)) GRID_SYNC(); }
  if (IN(2)) { phase2(p); if (BOTH(2)) GRID_SYNC(); }
  if (IN(3)) { phase3(p); if (BOTH(3)) GRID_SYNC(); }
  if (IN(4)) { phase4(p); if (BOTH(4)) GRID_SYNC(); }
  if (IN(5)) { phase5(p); if (BOTH(5)) GRID_SYNC(); }
  if (IN(6)) { phase6(p); }
}

extern "C" void kernel_launch(void* const* d_in, const int* in_sizes, int n_in, void* d_out, int out_size, void* d_ws, size_t ws_size, hipStream_t stream) {
  static int grid = 0;
  if (grid == 0) {
    int dev = 0, cus = 0, per_cu = 0;
    hipGetDevice(&dev);
    hipDeviceGetAttribute(&cus, hipDeviceAttributeMultiprocessorCount, dev);
    if (hipFuncSetAttribute((const void*)mega, hipFuncAttributeMaxDynamicSharedMemorySize, LDS_BYTES) != hipSuccess) fprintf(stderr, "hipFuncSetAttribute failed\n");
    hipOccupancyMaxActiveBlocksPerMultiprocessor(&per_cu, (const void*)mega, 512, LDS_BYTES);
    if (per_cu < 1) { fprintf(stderr, "occupancy query says %d\n", per_cu); per_cu = 1; }
    (void)hipGetLastError();
    grid = cus;
  }
  Params p{};
  p.x_p = (const float*)d_in[0]; p.x_s = (const float*)d_in[1]; p.sca = (const float*)d_in[2]; p.scq = (const float*)d_in[3]; p.sd = (const float*)d_in[4];
  p.w_in = (const float*)d_in[5]; p.caw = (const float*)d_in[6]; p.cbw = (const float*)d_in[7]; p.a_log = (const float*)d_in[8]; p.dt_bias = (const float*)d_in[9];
  p.onw = (const float*)d_in[10]; p.w_oa = (const float*)d_in[11]; p.w_ob = (const float*)d_in[12]; p.w_o = (const float*)d_in[13]; p.nw = (const float*)d_in[14]; p.fnw = (const float*)d_in[15];
  p.out = (float*)d_out;
  unsigned char* ws = (unsigned char*)d_ws; size_t o = 0;
  auto take = [&](size_t bytes) { unsigned char* r = ws + o; o += (bytes + 255) & ~(size_t)255; return r; };
  p.QKV = (bf16_t*)take((size_t)NT * QW * 2);
  p.SBZ = (bf16_t*)take((size_t)NT * DM * 2);
  p.GATE = (bf16_t*)take((size_t)NT * DM * 2);
  p.UW = (bf16_t*)take((size_t)NT * DM * 2);
  p.AQK = (bf16_t*)take((size_t)2048 * 4096 * 2);
  p.WOA = (bf16_t*)take((size_t)DM * DM * 2); p.WOB = (bf16_t*)take((size_t)DM * DM * 2); p.WO = (bf16_t*)take((size_t)DM * DM * 2);
  p.WB16 = (bf16_t*)take(16 * DM * 2);
  p.BG = (float*)take((size_t)NT * 16 * 4);
  p.DL = (float*)take(2048 * 4);
  p.bar = (unsigned*)take((XCD_BAR_WORDS + 64 * 64) * 4);
  p.RS = (float*)take(64 * 4 * 256 * 4);
  if (o > ws_size) { fprintf(stderr, "workspace too small: need %zu have %zu\n", o, ws_size); return; }
  p.SGA = (bf16_t*)d_out; p.SGB = p.SGA + (size_t)NT * DM;
  unsigned char* nds = (unsigned char*)((float*)d_out + OFF_ND_S);
  p.WIN = (bf16_t*)nds; p.P = (bf16_t*)(nds + (size_t)10240 * DM * 2); p.HALO = (bf16_t*)(nds + (size_t)10240 * DM * 2 + (size_t)NT * DM * 2);
#if COOP
  if (hipMemsetAsync(p.bar, 0, (XCD_BAR_WORDS + 64 * 64) * 4, stream) != hipSuccess) fprintf(stderr, "memset of barrier words failed\n");
  int lo = 0, hi = 7; void* args[] = {&p, &lo, &hi};
  hipError_t e = hipLaunchCooperativeKernel((const void*)mega, dim3(grid), dim3(512), args, LDS_BYTES, stream);
  if (e != hipSuccess) fprintf(stderr, "cooperative launch failed: %s\n", hipGetErrorString(e));
#else
  for (int ph = 0; ph < 7; ++ph) { hipLaunchKernelGGL(mega, dim3(grid), dim3(512), LDS_BYTES, stream, p, ph, ph + 1); if (ph == DUP) hipLaunchKernelGGL(mega, dim3(grid), dim3(512), LDS_BYTES, stream, p, ph, ph + 1); }
#endif
}
```
